# Optimizing an MI355X kernel written in HIP

```python
import jax, jax.numpy as jnp
from jax import lax
import numpy as np

D_MODEL = 1024
BATCH = 8
SEQ = 2048
DEPTH = 1

PLE_DIM = 256
SG_GROUPS = 4
SG_CHUNK = 128
SG_WIDTH = D_MODEL // 2
SG_GROUP_DIM = SG_WIDTH // SG_GROUPS
GLA_HEADS = 4
GLA_DK = D_MODEL // 2
GLA_DV = D_MODEL
GLA_HEAD_K = GLA_DK // GLA_HEADS
GLA_HEAD_V = GLA_DV // GLA_HEADS
GLA_GATE_RANK = 16
GLA_GATE_TEMP = 16.0
GLA_CHUNK = 64
D_FF = 4 * D_MODEL
EPS = 1e-6

IN_SPLITS = (SG_WIDTH, SG_WIDTH, GLA_DK, GLA_DK, GLA_DV, GLA_GATE_RANK, GLA_DV, D_MODEL, D_MODEL)
IN_COLS = SG_WIDTH * 2 + GLA_DK * 2 + GLA_DV * 2 + GLA_GATE_RANK + D_MODEL * 2

kernel_name = "hybrid_gated_sgmlp_gla_block"


def rms_norm(x, g):
    xf = x.astype(jnp.float32)
    y = xf * lax.rsqrt(jnp.mean(xf * xf, axis=-1, keepdims=True) + EPS)
    return (y * g.astype(jnp.float32)).astype(x.dtype)


def layer_norm(x, g, b):
    xf = x.astype(jnp.float32)
    mu = jnp.mean(xf, axis=-1, keepdims=True)
    xc = xf - mu
    var = jnp.mean(xc * xc, axis=-1, keepdims=True)
    y = xc * lax.rsqrt(var + EPS) * g.astype(jnp.float32) + b.astype(jnp.float32)
    return y.astype(x.dtype)


def split_cols(t):
    idx = [int(i) for i in np.cumsum(np.array(IN_SPLITS))[:-1]]
    return jnp.split(t, idx, axis=-1)


def spatial_gating(u, v, w_s, b_s):
    B, S, _ = u.shape
    n = S // SG_CHUNK
    mask = jnp.tril(jnp.ones((SG_CHUNK, SG_CHUNK), dtype=bool))
    w = jnp.where(mask[None], w_s, jnp.zeros_like(w_s)).astype(v.dtype)
    vc = v.reshape(B, n, SG_CHUNK, SG_GROUPS, SG_GROUP_DIM)
    mixed = jnp.einsum('gts,bnsgc->bntgc', w, vc) + b_s.T.astype(v.dtype)[None, None, :, :, None]
    return u * mixed.reshape(B, S, SG_WIDTH)


def gla_chunked(q, k, v, log_a):
    B, S, H, dk = q.shape
    dv = v.shape[-1]
    C = GLA_CHUNK
    n = S // C

    def to_chunks(t):
        return t.astype(jnp.float32).reshape(B, n, C, H, t.shape[-1]).transpose(0, 1, 3, 2, 4)

    q, k, v, log_a = to_chunks(q), to_chunks(k), to_chunks(v), to_chunks(log_a)
    b = jnp.cumsum(log_a, axis=3)
    b_ref = b[:, :, :, C // 2 - 1:C // 2, :]
    q_in = q * jnp.exp(b - b_ref)
    k_in = k * jnp.exp(b_ref - b)
    scores = jnp.einsum('bnhid,bnhjd->bnhij', q_in, k_in)
    causal = jnp.tril(jnp.ones((C, C), dtype=bool))
    scores = jnp.where(causal, scores, 0.0)
    o_intra = jnp.einsum('bnhij,bnhjv->bnhiv', scores, v)

    b_last = b[:, :, :, -1:, :]
    k_dec = k * jnp.exp(b_last - b)
    chunk_kv = jnp.einsum('bnhjd,bnhjv->bnhdv', k_dec, v)
    chunk_decay = jnp.exp(b_last[:, :, :, 0, :])

    def step(state, inp):
        kv, dec = inp
        return dec[..., None] * state + kv, state

    s0 = jnp.zeros((B, H, dk, dv), jnp.float32)
    _, s_prev = lax.scan(step, s0, (chunk_kv.transpose(1, 0, 2, 3, 4), chunk_decay.transpose(1, 0, 2, 3)))
    s_prev = s_prev.transpose(1, 0, 2, 3, 4)
    o_inter = jnp.einsum('bnhid,bnhdv->bnhiv', q * jnp.exp(b), s_prev)
    o = o_intra + o_inter
    return o.transpose(0, 1, 3, 2, 4).reshape(B, S, H, dv)


def setup_inputs(seed: int = 0) -> dict:
    key = jax.random.key(seed)
    ks = jax.random.split(key, 24)
    L = DEPTH
    f32 = jnp.float32

    def nrm(k, shape, scale):
        return jax.random.normal(k, shape, f32) * scale

    def gain(k, shape):
        return 1.0 + 0.02 * jax.random.normal(k, shape, f32)

    return {
        "x": jax.random.normal(ks[0], (BATCH, SEQ, D_MODEL), f32),
        "p": jax.random.normal(ks[1], (DEPTH, BATCH, SEQ, PLE_DIM), f32),
        "norm_mix_g": gain(ks[2], (L, D_MODEL)),
        "w_in": nrm(ks[3], (L, D_MODEL, IN_COLS), D_MODEL ** -0.5),
        "sg_ln_g": gain(ks[4], (L, SG_WIDTH)),
        "sg_ln_b": nrm(ks[5], (L, SG_WIDTH), 0.02),
        "sg_w_s": nrm(ks[6], (L, SG_GROUPS, SG_CHUNK, SG_CHUNK), SG_CHUNK ** -0.5),
        "sg_b_s": gain(ks[7], (L, SG_GROUPS, SG_CHUNK)),
        "sg_w_out": nrm(ks[8], (L, SG_WIDTH, D_MODEL), SG_WIDTH ** -0.5),
        "gla_w_gate_up": nrm(ks[9], (L, GLA_GATE_RANK, GLA_DK), GLA_GATE_RANK ** -0.5),
        "gla_b_gate": nrm(ks[10], (L, GLA_DK), 0.01),
        "gla_norm_g": gain(ks[11], (L, GLA_HEAD_V)),
        "gla_w_out": nrm(ks[12], (L, GLA_DV, D_MODEL), GLA_DV ** -0.5),
        "w_o": nrm(ks[13], (L, D_MODEL, D_MODEL), D_MODEL ** -0.5),
        "norm_ffn_g": gain(ks[14], (L, D_MODEL)),
        "ffn_w_up": nrm(ks[15], (L, D_MODEL, D_FF), D_MODEL ** -0.5),
        "ffn_w_down": nrm(ks[16], (L, D_FF, D_MODEL), D_FF ** -0.5),
        "ple_norm_g": gain(ks[17], (L, D_MODEL)),
        "ple_w_gate": nrm(ks[18], (L, D_MODEL, D_MODEL), D_MODEL ** -0.5),
        "ple_w_proj": nrm(ks[19], (L, PLE_DIM, D_MODEL), PLE_DIM ** -0.5),
        "final_norm_g": gain(ks[20], (D_MODEL,)),
    }


def reference(x, p, norm_mix_g, w_in, sg_ln_g, sg_ln_b, sg_w_s, sg_b_s, sg_w_out,
              gla_w_gate_up, gla_b_gate, gla_norm_g, gla_w_out, w_o,
              norm_ffn_g, ffn_w_up, ffn_w_down, ple_norm_g, ple_w_gate, ple_w_proj,
              final_norm_g):
    B, S, _ = x.shape
    for i in range(DEPTH):
        h = rms_norm(x, norm_mix_g[i])
        proj = jnp.einsum('bsd,dc->bsc', h, w_in[i])
        sg_u, sg_v, q, k, v, gate_lr, out_gate, bg_a, bg_b = split_cols(proj)

        sg_u = jax.nn.gelu(sg_u)
        sg_v = layer_norm(jax.nn.gelu(sg_v), sg_ln_g[i], sg_ln_b[i])
        z = spatial_gating(sg_u, sg_v, sg_w_s[i], sg_b_s[i])
        y_a = jnp.einsum('bsc,cd->bsd', z, sg_w_out[i])

        log_a = jax.nn.log_sigmoid(
            (jnp.einsum('bsr,rk->bsk', gate_lr, gla_w_gate_up[i]) + gla_b_gate[i]).astype(jnp.float32)
        ) / GLA_GATE_TEMP
        qh = q.reshape(B, S, GLA_HEADS, GLA_HEAD_K) * (GLA_HEAD_K ** -0.5)
        kh = k.reshape(B, S, GLA_HEADS, GLA_HEAD_K)
        vh = v.reshape(B, S, GLA_HEADS, GLA_HEAD_V)
        ah = log_a.reshape(B, S, GLA_HEADS, GLA_HEAD_K)
        o = gla_chunked(qh, kh, vh, ah)
        o = rms_norm(o, gla_norm_g[i]).astype(x.dtype).reshape(B, S, GLA_DV)
        o = o * jax.nn.silu(out_gate)
        y_b = jnp.einsum('bsc,cd->bsd', o, gla_w_out[i])

        merged = jax.nn.sigmoid(bg_a) * y_a + jax.nn.sigmoid(bg_b) * y_b
        x = x + jnp.einsum('bsd,de->bse', merged, w_o[i])

        h2 = rms_norm(x, norm_ffn_g[i])
        up = jnp.square(jax.nn.relu(jnp.einsum('bsd,df->bsf', h2, ffn_w_up[i])))
        x = x + jnp.einsum('bsf,fd->bsd', up, ffn_w_down[i])

        h3 = rms_norm(x, ple_norm_g[i])
        gate = jax.nn.sigmoid(jnp.einsum('bsd,de->bse', h3, ple_w_gate[i]))
        ple = jnp.einsum('bsp,pd->bsd', p[i].astype(x.dtype), ple_w_proj[i])
        x = x + gate * ple
    return rms_norm(x, final_norm_g)
```

```cpp
#include <hip/hip_runtime.h>
#include <hip/hip_cooperative_groups.h>
#include <cstdio>
#include <cstdint>
namespace cg = cooperative_groups;
namespace pg8 {
#define PG8_LAS __attribute__((address_space(3)))
typedef unsigned short bf16_t;
typedef short bf16x8 __attribute__((ext_vector_type(8)));
typedef float f32x4 __attribute__((ext_vector_type(4)));
typedef unsigned u32x4 __attribute__((ext_vector_type(4)));
constexpr int BM = 256, BK = 64, HALF = 128, HTB = HALF * BK * 2  , STAGE_BYTES = 8 * HTB, NXCD = 8, WGM = 8;

__host__ __device__ __forceinline__ int lds_byte(int r, int c) { const int st = (r >> 4) * 2 + (c >> 5), rr = r & 15, cc = c & 31, ob = rr * 64 + cc * 2; return st * 1024 + (ob ^ (((ob >> 9) & 1) << 5)); }
__host__ __device__ __forceinline__ void stage_rc(int b, int& R, int& C) { const int st = b / 1024, sb = b % 1024, swz = sb ^ (((sb >> 9) & 1) << 5); R = (st >> 1) * 16 + swz / 64; C = (st & 1) * 32 + (swz % 64) / 2; }
__host__ __device__ __forceinline__ int perm32(int rho) { const int n = rho >> 4, i = rho & 15; return 8 * (i >> 2) + 4 * n + (i & 3); }

struct Unit { int pm, pn; };
struct Gemm { const bf16_t* A; const bf16_t* Bt; int M, N, K; };

struct StaticOrder {
    int nM, nN, nwg, G, c;
    __host__ __device__ void init(int M, int N, int G_, int c_) { nM = M / BM; nN = N / BM; nwg = nM * nN; G = G_; c = c_; }
    __host__ __device__ bool next(int i, Unit& u) const {
        const long L = (long)i * G + c; if (L >= nwg) return false;
        int wgid = (int)L; { const int q = nwg / NXCD, r = nwg % NXCD, xcd = wgid % NXCD, off = wgid / NXCD; wgid = (xcd < r ? xcd * (q + 1) : r * (q + 1) + (xcd - r) * q) + off; }
        const int nig = WGM * nN, gid = wgid / nig, fm = gid * WGM, gsz = (nM - fm) < WGM ? (nM - fm) : WGM;
        u.pm = fm + ((wgid % nig) % gsz); u.pn = (wgid % nig) / gsz; return true;
    }
    __device__ __forceinline__ void a_ready(const Unit&) const {}
    __device__ __forceinline__ void done(const Unit&) const {}
};
typedef float f32x2 __attribute__((ext_vector_type(2)));
typedef __bf16 bf16x2_t __attribute__((ext_vector_type(2)));
__device__ __forceinline__ unsigned cvt_pk_bf16(float lo, float hi) { f32x2 v = {lo, hi}; bf16x2_t b = __builtin_convertvector(v, bf16x2_t); return __builtin_bit_cast(unsigned, b); }
template <class Epi, class Sched, bool ALIGN_EPI = false, bool SP2 = false>
__device__ __forceinline__ void gemm_phase(PG8_LAS unsigned char* lds, const Gemm g, const Sched& S, const Epi& E) {
    int tid_ = threadIdx.x; asm volatile("" : "+v"(tid_));
    const int tid = tid_, wid = __builtin_amdgcn_readfirstlane(tid >> 6), lane = tid & 63, wr = wid >> 2, wc = wid & 3, fr = lane & 15, fq = lane >> 4;
    const int K = g.K, nt = K / BK;
    unsigned voffA[2], voffB[2];
#pragma unroll
    for (int i = 0; i < 2; ++i) { int R, C; stage_rc(tid * 16 + i * 8192, R, C); const int Rb = Epi::PERM ? ((R & ~31) + perm32(R & 31)) : R;
        voffA[i] = (unsigned)(R * K + C) * 2u; voffB[i] = (unsigned)(Rb * K + C) * 2u; }
    const size_t kstep = (size_t)(BK * 2);
    const size_t hstep = (size_t)HALF * K * 2;
    const size_t tstep = 2 * hstep;
    const unsigned ldsw = (unsigned)wid * 1024u;
    const int aoff = lds_byte(wr * 64 + fr, fq * 8), boff = lds_byte(wc * 32 + fr, fq * 8);
#define PG8_SA(b, h) (((b) * 2 + (h)) * HTB)
#define PG8_SB(b, h) ((4 + (b) * 2 + (h)) * HTB)
#define PG8_STAGE(bufoff, gbase, voff) do { _Pragma("unroll") for (int _i = 0; _i < 2; ++_i) \
        __builtin_amdgcn_global_load_lds((const unsigned*)((const char*)(gbase) + (voff)[_i]), (PG8_LAS unsigned*)(lds + (bufoff) + ldsw + _i * 8192), 16, 0, 0); } while (0)
#define PG8_LDA(dst, b, h) do { _Pragma("unroll") for (int m = 0; m < 4; ++m) _Pragma("unroll") for (int k = 0; k < 2; ++k) dst[m][k] = *(const PG8_LAS bf16x8*)(lds + PG8_SA(b, h) + aoff + m * 2048 + k * 1024); } while (0)
#define PG8_LDB(dst, b, h) do { _Pragma("unroll") for (int n = 0; n < 2; ++n) _Pragma("unroll") for (int k = 0; k < 2; ++k) dst[n][k] = *(const PG8_LAS bf16x8*)(lds + PG8_SB(b, h) + boff + n * 2048 + k * 1024); } while (0)
#define PG8_MMA(ai, bj, At, Bt) do { __builtin_amdgcn_s_setprio(1); _Pragma("unroll") for (int m = 0; m < 4; ++m) _Pragma("unroll") for (int n = 0; n < 2; ++n) _Pragma("unroll") for (int k = 0; k < 2; ++k) \
        acc[ai][bj][m][n] = __builtin_amdgcn_mfma_f32_16x16x32_bf16(Bt[n][k], At[m][k], acc[ai][bj][m][n], 0, 0, 0); __builtin_amdgcn_s_setprio(0); } while (0)
#define PG8_WAIT_V(n) asm volatile("s_waitcnt vmcnt(" #n ")" ::: "memory")
#define PG8_WAIT_L(n) asm volatile("s_waitcnt lgkmcnt(" #n ")" ::: "memory")
#define PG8_BAR __builtin_amdgcn_s_barrier()
#define PG8_SCHED __builtin_amdgcn_sched_barrier(0)
    Unit cur, nxt; int ui = 0;
    if (!S.next(0, cur)) return;
    f32x4 acc[2][2][4][2];
#pragma unroll
    for (int a = 0; a < 2; ++a)
#pragma unroll
        for (int b = 0; b < 2; ++b)
#pragma unroll
            for (int m = 0; m < 4; ++m)
#pragma unroll
                for (int n = 0; n < 2; ++n) acc[a][b][m][n] = (f32x4){0.f, 0.f, 0.f, 0.f};
    bf16x8 At[4][2], B0[2][2], B1[2][2];
    const char* cA = (const char*)g.A + (size_t)cur.pm * tstep; const char* cB = (const char*)g.Bt + (size_t)cur.pn * tstep;
    S.a_ready(cur);
    if constexpr (SP2) {
        PG8_STAGE(PG8_SB(0, 0), cB, voffB); PG8_STAGE(PG8_SB(0, 1), cB + hstep, voffB); PG8_STAGE(PG8_SA(0, 0), cA, voffA); PG8_STAGE(PG8_SA(0, 1), cA + hstep, voffA);
        if (wr == 1) PG8_BAR;
        PG8_WAIT_V(2); PG8_BAR;
        PG8_STAGE(PG8_SB(1, 0), cB + kstep, voffB); PG8_STAGE(PG8_SA(1, 0), cA + kstep, voffA); PG8_STAGE(PG8_SB(1, 1), cB + hstep + kstep, voffB);
        PG8_WAIT_V(6); PG8_BAR;
    } else {
        PG8_STAGE(PG8_SB(0, 0), cB, voffB); PG8_STAGE(PG8_SA(0, 0), cA, voffA); PG8_STAGE(PG8_SB(0, 1), cB + hstep, voffB); PG8_STAGE(PG8_SA(0, 1), cA + hstep, voffA);
        if (wr == 1) PG8_BAR;
        PG8_WAIT_V(4); PG8_BAR;
        PG8_STAGE(PG8_SB(1, 0), cB + kstep, voffB); PG8_STAGE(PG8_SA(1, 0), cA + kstep, voffA); PG8_STAGE(PG8_SB(1, 1), cB + hstep + kstep, voffB);
        PG8_WAIT_V(6); PG8_BAR;
    }
    for (;;) {
        const bool has_next = S.next(ui + 1, nxt);
        const char* nA = has_next ? (const char*)g.A + (size_t)nxt.pm * tstep : cA; const char* nB = has_next ? (const char*)g.Bt + (size_t)nxt.pn * tstep : cB;
        for (int t = 0; t < nt; t += 2) {
            const bool last = (t == nt - 2);
            const char* a1 = cA + (size_t)(t + 1) * kstep;
            const char* a2 = last ? nA : cA + (size_t)(t + 2) * kstep; const char* b2 = last ? nB : cB + (size_t)(t + 2) * kstep;
            const char* a3 = a2 + kstep; const char* b3 = b2 + kstep;
            if (last && has_next) S.a_ready(nxt);
            if constexpr (SP2) {
            PG8_LDB(B0, 0, 0); PG8_LDB(B1, 0, 1); PG8_SCHED; PG8_LDA(At, 0, 0); PG8_STAGE(PG8_SA(1, 1), a1 + hstep, voffA);
            PG8_WAIT_V(8); PG8_WAIT_L(0); PG8_BAR; PG8_MMA(0, 0, At, B0); PG8_MMA(0, 1, At, B1); PG8_BAR; PG8_SCHED;
            PG8_LDA(At, 0, 1); PG8_STAGE(PG8_SB(0, 0), b2, voffB); PG8_STAGE(PG8_SB(0, 1), b2 + hstep, voffB); PG8_STAGE(PG8_SA(0, 0), a2, voffA);
            PG8_WAIT_V(8); PG8_WAIT_L(0); PG8_BAR; PG8_MMA(1, 0, At, B0); PG8_MMA(1, 1, At, B1); PG8_BAR; PG8_SCHED;
            PG8_LDB(B0, 1, 0); PG8_LDB(B1, 1, 1); PG8_SCHED; PG8_LDA(At, 1, 0); PG8_STAGE(PG8_SA(0, 1), a2 + hstep, voffA);
            PG8_WAIT_V(8); PG8_WAIT_L(0); PG8_BAR; PG8_MMA(0, 0, At, B0); PG8_MMA(0, 1, At, B1); PG8_BAR; PG8_SCHED;
            PG8_LDA(At, 1, 1); PG8_STAGE(PG8_SB(1, 0), b3, voffB); PG8_STAGE(PG8_SB(1, 1), b3 + hstep, voffB); PG8_STAGE(PG8_SA(1, 0), a3, voffA);
            PG8_WAIT_V(8); PG8_WAIT_L(0); PG8_BAR; PG8_MMA(1, 0, At, B0); PG8_MMA(1, 1, At, B1); PG8_BAR; PG8_SCHED;
            } else {
            PG8_LDB(B0, 0, 0); PG8_SCHED; PG8_LDA(At, 0, 0); PG8_STAGE(PG8_SA(1, 1), a1 + hstep, voffA);
            PG8_WAIT_L(8); PG8_BAR; PG8_WAIT_L(0); PG8_MMA(0, 0, At, B0); PG8_BAR; PG8_SCHED;
            PG8_LDB(B1, 0, 1); PG8_STAGE(PG8_SB(0, 0), b2, voffB);
            PG8_BAR; PG8_WAIT_L(0); PG8_MMA(0, 1, At, B1); PG8_BAR;
            PG8_LDA(At, 0, 1); PG8_STAGE(PG8_SA(0, 0), a2, voffA);
            PG8_BAR; PG8_WAIT_L(0); PG8_MMA(1, 0, At, B0); PG8_BAR; PG8_SCHED;
            PG8_STAGE(PG8_SB(0, 1), b2 + hstep, voffB);
            PG8_WAIT_V(6); PG8_BAR; PG8_MMA(1, 1, At, B1); PG8_BAR;
            PG8_LDB(B0, 1, 0); PG8_SCHED; PG8_LDA(At, 1, 0); PG8_STAGE(PG8_SA(0, 1), a2 + hstep, voffA);
            PG8_WAIT_L(8); PG8_BAR; PG8_WAIT_L(0); PG8_MMA(0, 0, At, B0); PG8_BAR; PG8_SCHED;
            PG8_LDB(B1, 1, 1); PG8_STAGE(PG8_SB(1, 0), b3, voffB);
            PG8_BAR; PG8_WAIT_L(0); PG8_MMA(0, 1, At, B1); PG8_BAR;
            PG8_LDA(At, 1, 1); PG8_STAGE(PG8_SA(1, 0), a3, voffA);
            PG8_BAR; PG8_WAIT_L(0); PG8_MMA(1, 0, At, B0); PG8_BAR; PG8_SCHED;
            PG8_STAGE(PG8_SB(1, 1), b3 + hstep, voffB);
            PG8_WAIT_V(6); PG8_BAR; PG8_MMA(1, 1, At, B1); PG8_BAR;
            }
        }
        if constexpr (ALIGN_EPI) { if (wr == 0) PG8_BAR; }
        if constexpr (!Epi::AFTER_DRAIN) { E(acc, cur, wr, wc, fr, fq); S.done(cur); }
        if (!has_next) break;
#pragma unroll
        for (int a = 0; a < 2; ++a)
#pragma unroll
            for (int b = 0; b < 2; ++b)
#pragma unroll
                for (int m = 0; m < 4; ++m)
#pragma unroll
                    for (int n = 0; n < 2; ++n) acc[a][b][m][n] = (f32x4){0.f, 0.f, 0.f, 0.f};
        cur = nxt; cA = nA; cB = nB; ++ui;
        if constexpr (ALIGN_EPI) { if (wr == 1) PG8_BAR; }
    }
    PG8_WAIT_V(0);
    if constexpr (!ALIGN_EPI) { if (wr == 0) PG8_BAR; }
    PG8_BAR;
    if constexpr (Epi::AFTER_DRAIN) { E.fused(acc, cur, wr, wc, fr, fq, lds, wid, lane); S.done(cur); }
#undef PG8_SA
#undef PG8_SB
#undef PG8_STAGE
#undef PG8_LDA
#undef PG8_LDB
#undef PG8_MMA
#undef PG8_WAIT_V
#undef PG8_WAIT_L
#undef PG8_BAR
#undef PG8_SCHED
}
}

#ifndef MK_N_LAUNCHES
#define MK_N_LAUNCHES 1
#endif
#define LAS __attribute__((address_space(3)))
namespace mk {
using pg8::bf16_t; using pg8::bf16x8; using pg8::f32x4; using pg8::u32x4; using pg8::Unit;
typedef unsigned u32x2 __attribute__((ext_vector_type(2)));

constexpr int M = 16384, D = 1024, SEQ = 2048, FF = 4096, PLE = 256, NIN = 6656;
constexpr float EPS = 1e-6f;
constexpr size_t MiB = 1u << 20;
constexpr size_t WS_VSTAT = 0;
constexpr size_t WS_RSS2 = 128 * 1024;
constexpr size_t WS_RSS3 = 192 * 1024;
constexpr size_t WS_RSS4 = 256 * 1024;
constexpr size_t WS_RGLA = 320 * 1024;
constexpr size_t WS_BAR = 576 * 1024;
constexpr size_t WS_ZERO_END = 576 * 1024 + 256;
constexpr size_t WS_WSB = 1 * MiB;
constexpr size_t WS_WIN = 2 * MiB;
constexpr size_t WS_WA = 15 * MiB;
constexpr size_t WS_WB = 16 * MiB;
constexpr size_t WS_WO = 18 * MiB;
constexpr size_t WS_WUP = 20 * MiB;
constexpr size_t WS_WDN = 28 * MiB;
constexpr size_t WS_WPG = 36 * MiB;
constexpr size_t WS_WPP = 38 * MiB;
constexpr size_t WS_PB = 39 * MiB;
constexpr size_t WS_H = 47 * MiB;
constexpr size_t WS_U = 79 * MiB;
constexpr size_t WS_VSG = 95 * MiB;
constexpr size_t WS_V = 111 * MiB;
constexpr size_t WS_OG = 143 * MiB;
constexpr size_t WS_BGA = 175 * MiB;
constexpr size_t WS_BGB = 207 * MiB;
constexpr size_t WS_UP = 79 * MiB;
constexpr size_t WS_XB = 207 * MiB;
constexpr size_t WS_END = 239 * MiB;
constexpr size_t DO_Q = 0, DO_K = 16 * MiB, DO_LA = 32 * MiB;

constexpr int LDS_BYTES = 147456;

struct Params { const float* in[21]; float* out; unsigned char* ws; int ph_lo, ph_hi; };

__device__ __forceinline__ unsigned f2bf(float f) { unsigned u = __builtin_bit_cast(unsigned, f); return (u + 0x7fffu + ((u >> 16) & 1u)) >> 16; }
__device__ __forceinline__ unsigned pk2(float lo, float hi) { return pg8::cvt_pk_bf16(lo, hi); }
__device__ __forceinline__ float bf_lo(unsigned u) { return __uint_as_float(u << 16); }
__device__ __forceinline__ float bf_hi(unsigned u) { return __uint_as_float(u & 0xffff0000u); }
__device__ __forceinline__ u32x4 pack8(f32x4 a, f32x4 b) { u32x4 w; w.x = pk2(a[0], a[1]); w.y = pk2(a[2], a[3]); w.z = pk2(b[0], b[1]); w.w = pk2(b[2], b[3]); return w; }
__device__ __forceinline__ u32x2 pack4(f32x4 a) { u32x2 w; w.x = pk2(a[0], a[1]); w.y = pk2(a[2], a[3]); return w; }
__device__ __forceinline__ void unpack8(u32x4 w, f32x4& a, f32x4& b) { a[0] = bf_lo(w.x); a[1] = bf_hi(w.x); a[2] = bf_lo(w.y); a[3] = bf_hi(w.y); b[0] = bf_lo(w.z); b[1] = bf_hi(w.z); b[2] = bf_lo(w.w); b[3] = bf_hi(w.w); }
__device__ __forceinline__ f32x4 unpack4(u32x2 w) { f32x4 a; a[0] = bf_lo(w.x); a[1] = bf_hi(w.x); a[2] = bf_lo(w.y); a[3] = bf_hi(w.y); return a; }
__device__ __forceinline__ float sigmoid_f(float x) { return __builtin_amdgcn_rcpf(1.f + __expf(-x)); }
__device__ __forceinline__ float gelu_f(float x) { const float t = 1.5957691216057308f * (x + 0.044715f * x * x * x); return x * sigmoid_f(t); }
__device__ __forceinline__ float silu_f(float x) { return x * sigmoid_f(x); }
__device__ __forceinline__ float logsig_f(float x) { return fminf(x, 0.f) - __logf(1.f + __expf(-fabsf(x))); }
__device__ __forceinline__ float wave_sum(float v) {
#pragma unroll
    for (int o = 1; o < 64; o <<= 1) v += __shfl_xor(v, o);
    return v;
}
__device__ __forceinline__ void atomic_add_agent(float* p, float v) { (void)__hip_atomic_fetch_add(p, v, __ATOMIC_RELAXED, __HIP_MEMORY_SCOPE_AGENT); }
#define LDS_WAIT() asm volatile("s_waitcnt lgkmcnt(0)" ::: "memory")

enum { ACT_NONE = 0, ACT_GELU, ACT_SILU, ACT_SIGM, ACT_SCALE, ACT_LOGSIG };
enum { LAY_512 = 0, LAY_1024, LAY_BLK };
template <int ACT> __device__ __forceinline__ float act1(float x) {
    if (ACT == ACT_GELU) return gelu_f(x);
    if (ACT == ACT_SILU) return silu_f(x);
    if (ACT == ACT_SIGM) return sigmoid_f(x);
    if (ACT == ACT_SCALE) return x * 0.08838834764831845f;
    if (ACT == ACT_LOGSIG) return logsig_f(x) * 0.0625f;
    return x;
}
struct EpiIn {
    static constexpr bool PERM = true, AFTER_DRAIN = false;
    bf16_t *U, *VSG, *Q, *K, *V, *LA, *OG, *BGA, *BGB; float* vstat; const float* bgate;
    template <int ACT, int LAY, bool STATS, bool BIAS> __device__ __forceinline__ void run(const f32x4 (&acc)[2][2][4][2], bf16_t* base, int rowb, int colb, int fq) const {
        f32x4 b0[2], b1[2];
#pragma unroll
        for (int bj = 0; bj < 2; ++bj) { if (BIAS) { b0[bj] = *(const f32x4*)(bgate + colb + bj * 128); b1[bj] = *(const f32x4*)(bgate + colb + bj * 128 + 4); } else { b0[bj] = (f32x4){0.f, 0.f, 0.f, 0.f}; b1[bj] = b0[bj]; } }
#pragma unroll
        for (int ai = 0; ai < 2; ++ai)
#pragma unroll
            for (int m = 0; m < 4; ++m) {
                const int row = rowb + ai * 128 + m * 16; float s1 = 0.f, s2 = 0.f;
#pragma unroll
                for (int bj = 0; bj < 2; ++bj) {
                    const int col = colb + bj * 128; f32x4 v0 = acc[ai][bj][m][0] + b0[bj], v1 = acc[ai][bj][m][1] + b1[bj];
#pragma unroll
                    for (int j = 0; j < 4; ++j) { v0[j] = act1<ACT>(v0[j]); v1[j] = act1<ACT>(v1[j]); }
                    const u32x4 w = pack8(v0, v1);
                    if (STATS) { f32x4 r0, r1; unpack8(w, r0, r1);
#pragma unroll
                        for (int j = 0; j < 4; ++j) { s1 += r0[j] + r1[j]; s2 += r0[j] * r0[j] + r1[j] * r1[j]; } }
                    size_t off;
                    if (LAY == LAY_512) off = (size_t)row * 512 + col;
                    else if (LAY == LAY_1024) off = (size_t)row * 1024 + col;
                    else off = ((size_t)(row >> 6) * 4 + (col >> 7)) * 8192 + (size_t)(row & 63) * 128 + (col & 127);
                    *(u32x4*)(base + off) = w;
                }
                asm volatile("" ::: "memory");
                if (STATS) { s1 += __shfl_xor(s1, 16); s1 += __shfl_xor(s1, 32); s2 += __shfl_xor(s2, 16); s2 += __shfl_xor(s2, 32);
                    if (fq == 0) { atomic_add_agent(vstat + 2 * row, s1); atomic_add_agent(vstat + 2 * row + 1, s2); } }
            }
    }
    __device__ __forceinline__ void operator()(const f32x4 (&acc)[2][2][4][2], const Unit& u, int wr, int wc, int fr, int fq) const {
        const int rowb = u.pm * 256 + wr * 64 + fr, cw = wc * 32 + 8 * fq, pn = u.pn;
        if (pn < 2) run<ACT_GELU, LAY_512, false, false>(acc, U, rowb, pn * 256 + cw, fq);
        else if (pn < 4) run<ACT_GELU, LAY_512, true, false>(acc, VSG, rowb, (pn - 2) * 256 + cw, fq);
        else if (pn < 6) run<ACT_SCALE, LAY_BLK, false, false>(acc, Q, rowb, (pn - 4) * 256 + cw, fq);
        else if (pn < 8) run<ACT_NONE, LAY_BLK, false, false>(acc, K, rowb, (pn - 6) * 256 + cw, fq);
        else if (pn < 12) run<ACT_NONE, LAY_1024, false, false>(acc, V, rowb, (pn - 8) * 256 + cw, fq);
        else if (pn < 14) run<ACT_LOGSIG, LAY_BLK, false, true>(acc, LA, rowb, (pn - 12) * 256 + cw, fq);
        else if (pn < 18) run<ACT_SILU, LAY_1024, false, false>(acc, OG, rowb, (pn - 14) * 256 + cw, fq);
        else if (pn < 22) run<ACT_SIGM, LAY_1024, false, false>(acc, BGA, rowb, (pn - 18) * 256 + cw, fq);
        else run<ACT_SIGM, LAY_1024, false, false>(acc, BGB, rowb, (pn - 22) * 256 + cw, fq);
    }
};
template <bool ACCUM> struct EpiMerge {
    static constexpr bool PERM = true, AFTER_DRAIN = false;
    bf16_t* MG; const bf16_t* G;
    __device__ __forceinline__ void operator()(const f32x4 (&acc)[2][2][4][2], const Unit& u, int wr, int wc, int fr, int fq) const {
        const int rowb = u.pm * 256 + wr * 64 + fr, colb = u.pn * 256 + wc * 32 + 8 * fq;
#pragma unroll
        for (int ai = 0; ai < 2; ++ai)
#pragma unroll
            for (int m = 0; m < 4; ++m)
#pragma unroll
                for (int bj = 0; bj < 2; ++bj) {
                    const size_t off = (size_t)(rowb + ai * 128 + m * 16) * 1024 + colb + bj * 128;
                    f32x4 g0, g1; unpack8(*(const u32x4*)(G + off), g0, g1);
                    f32x4 v0 = acc[ai][bj][m][0] * g0, v1 = acc[ai][bj][m][1] * g1;
                    if (ACCUM) { f32x4 p0, p1; unpack8(*(const u32x4*)(MG + off), p0, p1); v0 += p0; v1 += p1; }
                    *(u32x4*)(MG + off) = pack8(v0, v1);
                    asm volatile("" ::: "memory");
                }
    }
};
struct EpiRes {
    static constexpr bool PERM = true, AFTER_DRAIN = false;
    const float* base; float* xo; bf16_t* xb; float* rss;
    __device__ __forceinline__ void operator()(const f32x4 (&acc)[2][2][4][2], const Unit& u, int wr, int wc, int fr, int fq) const {
        const int rowb = u.pm * 256 + wr * 64 + fr, colb = u.pn * 256 + wc * 32 + 8 * fq;
#pragma unroll
        for (int ai = 0; ai < 2; ++ai)
#pragma unroll
            for (int m = 0; m < 4; ++m) {
                const int row = rowb + ai * 128 + m * 16; float ss = 0.f;
#pragma unroll
                for (int bj = 0; bj < 2; ++bj) {
                    const size_t off = (size_t)row * 1024 + colb + bj * 128;
                    const f32x4 v0 = *(const f32x4*)(base + off) + acc[ai][bj][m][0], v1 = *(const f32x4*)(base + off + 4) + acc[ai][bj][m][1];
                    *(f32x4*)(xo + off) = v0; *(f32x4*)(xo + off + 4) = v1; *(u32x4*)(xb + off) = pack8(v0, v1);
#pragma unroll
                    for (int j = 0; j < 4; ++j) ss += v0[j] * v0[j] + v1[j] * v1[j];
                }
                ss += __shfl_xor(ss, 16); ss += __shfl_xor(ss, 32);
                if (fq == 0) atomic_add_agent(rss + row, ss);
                asm volatile("" ::: "memory");
            }
    }
};
struct EpiUp {
    static constexpr bool PERM = true, AFTER_DRAIN = false;
    bf16_t* UPB; const float* rss;
    __device__ __forceinline__ void operator()(const f32x4 (&acc)[2][2][4][2], const Unit& u, int wr, int wc, int fr, int fq) const {
        const int rowb = u.pm * 256 + wr * 64 + fr, colb = u.pn * 256 + wc * 32 + 8 * fq;
#pragma unroll
        for (int ai = 0; ai < 2; ++ai)
#pragma unroll
            for (int m = 0; m < 4; ++m) {
                const int row = rowb + ai * 128 + m * 16; const float rs = rsqrtf(rss[row] * (1.f / 1024.f) + EPS);
#pragma unroll
                for (int bj = 0; bj < 2; ++bj) {
                    f32x4 v0 = acc[ai][bj][m][0] * rs, v1 = acc[ai][bj][m][1] * rs;
#pragma unroll
                    for (int j = 0; j < 4; ++j) { const float a = fmaxf(v0[j], 0.f), b = fmaxf(v1[j], 0.f); v0[j] = a * a; v1[j] = b * b; }
                    *(u32x4*)(UPB + (size_t)row * 4096 + colb + bj * 128) = pack8(v0, v1);
                }
                asm volatile("" ::: "memory");
            }
    }
};
struct EpiPlain {
    static constexpr bool PERM = true, AFTER_DRAIN = false;
    bf16_t* O;
    __device__ __forceinline__ void operator()(const f32x4 (&acc)[2][2][4][2], const Unit& u, int wr, int wc, int fr, int fq) const {
        const int rowb = u.pm * 256 + wr * 64 + fr, colb = u.pn * 256 + wc * 32 + 8 * fq;
#pragma unroll
        for (int ai = 0; ai < 2; ++ai)
#pragma unroll
            for (int m = 0; m < 4; ++m)
#pragma unroll
                for (int bj = 0; bj < 2; ++bj)
                    *(u32x4*)(O + (size_t)(rowb + ai * 128 + m * 16) * 1024 + colb + bj * 128) = pack8(acc[ai][bj][m][0], acc[ai][bj][m][1]);
    }
};
struct EpiPleGate {
    static constexpr bool PERM = true, AFTER_DRAIN = false;
    float* x; const bf16_t* PLEB; const float* rss_in; float* rss_out;
    __device__ __forceinline__ void operator()(const f32x4 (&acc)[2][2][4][2], const Unit& u, int wr, int wc, int fr, int fq) const {
        const int rowb = u.pm * 256 + wr * 64 + fr, colb = u.pn * 256 + wc * 32 + 8 * fq;
#pragma unroll
        for (int ai = 0; ai < 2; ++ai)
#pragma unroll
            for (int m = 0; m < 4; ++m) {
                const int row = rowb + ai * 128 + m * 16; const float rs = rsqrtf(rss_in[row] * (1.f / 1024.f) + EPS); float ss = 0.f;
#pragma unroll
                for (int bj = 0; bj < 2; ++bj) {
                    const size_t off = (size_t)row * 1024 + colb + bj * 128;
                    f32x4 p0, p1; unpack8(*(const u32x4*)(PLEB + off), p0, p1);
                    f32x4 v0 = *(const f32x4*)(x + off), v1 = *(const f32x4*)(x + off + 4);
#pragma unroll
                    for (int j = 0; j < 4; ++j) { v0[j] += sigmoid_f(acc[ai][bj][m][0][j] * rs) * p0[j]; v1[j] += sigmoid_f(acc[ai][bj][m][1][j] * rs) * p1[j]; ss += v0[j] * v0[j] + v1[j] * v1[j]; }
                    *(f32x4*)(x + off) = v0; *(f32x4*)(x + off + 4) = v1;
                }
                ss += __shfl_xor(ss, 16); ss += __shfl_xor(ss, 32);
                if (fq == 0) atomic_add_agent(rss_out + row, ss);
                asm volatile("" ::: "memory");
            }
    }
};

struct EpiUpPlain {
    static constexpr bool PERM = true, AFTER_DRAIN = false;
    bf16_t* O;
    __device__ __forceinline__ void operator()(const f32x4 (&acc)[2][2][4][2], const Unit& u, int wr, int wc, int fr, int fq) const {
        const int rowb = u.pm * 256 + wr * 64 + fr, colb = u.pn * 256 + wc * 32 + 8 * fq;
#pragma unroll
        for (int ai = 0; ai < 2; ++ai)
#pragma unroll
            for (int m = 0; m < 4; ++m)
#pragma unroll
                for (int bj = 0; bj < 2; ++bj)
                    *(u32x4*)(O + (size_t)(rowb + ai * 128 + m * 16) * 4096 + colb + bj * 128) = pack8(acc[ai][bj][m][0], acc[ai][bj][m][1]);
    }
};
template <class Epi> __device__ __forceinline__ void run_gemm(LAS unsigned char* lds, const bf16_t* A, const bf16_t* Bt, int N, int K, const Epi& E) {
    asm volatile("" : "+s"(K));
    pg8::Gemm g{A, Bt, M, N, K}; pg8::StaticOrder S; S.init(M, N, (int)gridDim.x, (int)blockIdx.x);
    pg8::gemm_phase<Epi, pg8::StaticOrder, true, true>(lds, g, S, E);
}

__device__ __forceinline__ void tr_item(const float* W, int ldw, int K, int ncols, bf16_t* WT, int row_off, const float* kscale, LAS float* scr, int item, int lane) {
    const int nblk = ncols / 32, kb = item / nblk, nb = item % nblk, k0 = 64 * kb, n0 = 32 * nb;
#pragma unroll 8
    for (int i = 0; i < 32; ++i) { const int kk = 2 * i + (lane >> 5); float w = W[(size_t)(k0 + kk) * ldw + n0 + (lane & 31)]; if (kscale) w *= kscale[k0 + kk]; scr[kk * 33 + (lane & 31)] = w; }
    LDS_WAIT();
    const int c = lane & 7;
#pragma unroll
    for (int j = 0; j < 4; ++j) { const int n = (lane >> 3) + 8 * j; const LAS float* s = scr + (8 * c) * 33 + n;
        u32x4 o; o.x = pk2(s[0 * 33], s[1 * 33]); o.y = pk2(s[2 * 33], s[3 * 33]); o.z = pk2(s[4 * 33], s[5 * 33]); o.w = pk2(s[6 * 33], s[7 * 33]);
        *(u32x4*)(WT + (size_t)(row_off + n0 + n) * K + k0 + 8 * c) = o; }
    LDS_WAIT();
}
__device__ __forceinline__ void comb_item(const float* Win, const float* Wgu, bf16_t* WT, LAS float* scr, int item, int lane) {
    const int nblk = 512 / 32, kb = item / nblk, nb = item % nblk, k0 = 64 * kb, n0 = 32 * nb;
    float g[16];
#pragma unroll
    for (int r = 0; r < 16; ++r) g[r] = Wgu[r * 512 + n0 + (lane & 31)];
#pragma unroll 4
    for (int i = 0; i < 32; ++i) { const int kk = 2 * i + (lane >> 5); const float* wr_ = Win + (size_t)(k0 + kk) * 6160 + 3072; float s = 0.f;
#pragma unroll
        for (int r = 0; r < 16; ++r) s += wr_[r] * g[r];
        scr[kk * 33 + (lane & 31)] = s; }
    LDS_WAIT();
    const int c = lane & 7;
#pragma unroll
    for (int j = 0; j < 4; ++j) { const int n = (lane >> 3) + 8 * j; const LAS float* s = scr + (8 * c) * 33 + n;
        u32x4 o; o.x = pk2(s[0 * 33], s[1 * 33]); o.y = pk2(s[2 * 33], s[3 * 33]); o.z = pk2(s[4 * 33], s[5 * 33]); o.w = pk2(s[6 * 33], s[7 * 33]);
        *(u32x4*)(WT + (size_t)(3072 + n0 + n) * 1024 + k0 + 8 * c) = o; }
    LDS_WAIT();
}

__device__ __forceinline__ void phase_prologue(const Params& p, LAS unsigned char* lds) {
    int tid_ = threadIdx.x; asm volatile("" : "+v"(tid_)); const int tid = tid_, lane = tid & 63, wave = tid >> 6, G = gridDim.x;
    const int gw = blockIdx.x * 8 + wave, NGW = G * 8;
    const int gt = blockIdx.x * 512 + tid, NGT = G * 512;
    unsigned char* ws = p.ws;
    LAS float* scr = (LAS float*)(lds + wave * 16384);
    for (int i = gt; i < (int)(WS_ZERO_END / 4); i += NGT) ((float*)ws)[i] = 0.f;
    constexpr int I_IN1 = 16 * 96, I_IN2 = 16 * 96, I_C = 16 * 16, I_A = 8 * 32, I_B = 16 * 32, I_O = 16 * 32, I_UP = 16 * 128, I_DN = 64 * 32, I_PG = 16 * 32, I_PP = 4 * 32;
    constexpr int NITEMS = I_IN1 + I_IN2 + I_C + I_A + I_B + I_O + I_UP + I_DN + I_PG + I_PP;
    for (int it = gw; it < NITEMS; it += NGW) {
        int r = it; const float* W = p.in[3]; const float* ksc = nullptr; int ldw = 6160, K = 1024, ncols = 3072, row_off = 0; size_t wto = WS_WIN; bool comb = false;
        if (r < I_IN1) { }
        else if ((r -= I_IN1) < I_IN2) { W = p.in[3] + 3088; row_off = 3584; }
        else if ((r -= I_IN2) < I_C) { comb = true; }
        else if ((r -= I_C) < I_A) { W = p.in[8]; ldw = 1024; K = 512; ncols = 1024; wto = WS_WA; }
        else if ((r -= I_A) < I_B) { W = p.in[12]; ldw = 1024; ncols = 1024; wto = WS_WB; }
        else if ((r -= I_B) < I_O) { W = p.in[13]; ldw = 1024; ncols = 1024; wto = WS_WO; }
        else if ((r -= I_O) < I_UP) { W = p.in[15]; ldw = 4096; ncols = 4096; wto = WS_WUP; ksc = p.in[14]; }
        else if ((r -= I_UP) < I_DN) { W = p.in[16]; ldw = 1024; K = 4096; ncols = 1024; wto = WS_WDN; }
        else if ((r -= I_DN) < I_PG) { W = p.in[18]; ldw = 1024; ncols = 1024; wto = WS_WPG; ksc = p.in[17]; }
        else { r -= I_PG; W = p.in[19]; ldw = 1024; K = 256; ncols = 1024; wto = WS_WPP; }
        if (comb) comb_item(p.in[3], p.in[9], (bf16_t*)(ws + WS_WIN), scr, r, lane);
        else tr_item(W, ldw, K, ncols, (bf16_t*)(ws + wto), row_off, ksc, scr, r, lane);
    }
    for (int i = gt; i < 4 * 128 * 128; i += NGT) { const int t = (i >> 7) & 127, s = i & 127; ((bf16_t*)(ws + WS_WSB))[i] = (bf16_t)(s <= t ? f2bf(p.in[6][i]) : 0u); }
    for (int i = gt; i < M * PLE / 8; i += NGT) { const f32x4 a = ((const f32x4*)p.in[1])[2 * i], b = ((const f32x4*)p.in[1])[2 * i + 1]; ((u32x4*)(ws + WS_PB))[i] = pack8(a, b); }
    const f32x4* gm = (const f32x4*)p.in[2] + lane;
    const f32x4 g0 = gm[0], g1 = gm[64], g2 = gm[128], g3 = gm[192];
    for (int m = gw; m < M; m += NGW) {
        const f32x4* xr = (const f32x4*)(p.in[0] + (size_t)m * D) + lane;
        f32x4 v0 = xr[0], v1 = xr[64], v2 = xr[128], v3 = xr[192];
        float s = 0.f;
#pragma unroll
        for (int j = 0; j < 4; ++j) s += v0[j] * v0[j] + v1[j] * v1[j] + v2[j] * v2[j] + v3[j] * v3[j];
        const float rs = rsqrtf(wave_sum(s) * (1.f / 1024.f) + EPS);
        u32x2* o = (u32x2*)(ws + WS_H + (size_t)m * 2048) + lane;
        o[0] = pack4(v0 * rs * g0); o[64] = pack4(v1 * rs * g1); o[128] = pack4(v2 * rs * g2); o[192] = pack4(v3 * rs * g3);
    }
}

__device__ __forceinline__ void sg_item(const Params& p, LAS unsigned char* lds, int item) {
    int tid_ = threadIdx.x; asm volatile("" : "+v"(tid_)); const int tid = tid_, lane = tid & 63, w = tid >> 6, fr = lane & 15, fq = lane >> 4;
    const int g = item & 3, chunk = item >> 2, m0 = chunk * 128, c0 = g * 128;
    unsigned char* ws = p.ws;
    LAS bf16_t* VNT = (LAS bf16_t*)lds;
    LAS bf16_t* WL = (LAS bf16_t*)(lds + 34816);
    const bf16_t* WSB = (const bf16_t*)(ws + WS_WSB) + g * 16384;
    const bf16_t* VSG = (const bf16_t*)(ws + WS_VSG);
    bf16_t* U = (bf16_t*)(ws + WS_U);
    const float* vstat = (const float*)(ws + WS_VSTAT);
    const float* lng = p.in[4] + c0; const float* lnb = p.in[5] + c0;
#pragma unroll
    for (int k = 0; k < 4; ++k) { const int e = tid + 512 * k, t = e >> 4, sv = (e & 15) * 8; *(LAS u32x4*)(WL + t * 136 + sv) = *(const u32x4*)(WSB + t * 128 + sv); }
#pragma unroll
    for (int k = 0; k < 4; ++k) {
        const int e = tid + 512 * k, s = e >> 4, cv = (e & 15) * 8, m = m0 + s;
        f32x4 a, b; unpack8(*(const u32x4*)(VSG + (size_t)m * 512 + c0 + cv), a, b);
        const float mu = vstat[2 * m] * (1.f / 512.f), var = fmaxf(vstat[2 * m + 1] * (1.f / 512.f) - mu * mu, 0.f), rs = rsqrtf(var + EPS);
        const f32x4 ga = *(const f32x4*)(lng + cv), gb = *(const f32x4*)(lng + cv + 4), ba = *(const f32x4*)(lnb + cv), bb = *(const f32x4*)(lnb + cv + 4);
        a = (a - mu) * rs * ga + ba; b = (b - mu) * rs * gb + bb;
#pragma unroll
        for (int j = 0; j < 4; ++j) { VNT[(cv + j) * 136 + s] = (bf16_t)f2bf(a[j]); VNT[(cv + 4 + j) * 136 + s] = (bf16_t)f2bf(b[j]); }
    }
    __syncthreads();
    f32x4 acc[8];
#pragma unroll
    for (int tc = 0; tc < 8; ++tc) acc[tc] = (f32x4){0.f, 0.f, 0.f, 0.f};
    const int tt = w, ksn = (tt >> 1) + 1;
    for (int ks = 0; ks < ksn; ++ks) {
        const bf16x8 bf = *(const LAS bf16x8*)(WL + (16 * tt + fr) * 136 + 32 * ks + 8 * fq);
#pragma unroll
        for (int tc = 0; tc < 8; ++tc) { const bf16x8 af = *(const LAS bf16x8*)(VNT + (16 * tc + fr) * 136 + 32 * ks + 8 * fq); acc[tc] = __builtin_amdgcn_mfma_f32_16x16x32_bf16(af, bf, acc[tc], 0, 0, 0); }
    }
    const int t = 16 * tt + fr; const float bias = p.in[7][g * 128 + t];
#pragma unroll
    for (int tc = 0; tc < 8; ++tc) {
        bf16_t* up = U + (size_t)(m0 + t) * 512 + c0 + 16 * tc + 4 * fq;
        const f32x4 uu = unpack4(*(const u32x2*)up);
        *(u32x2*)up = pack4(uu * (acc[tc] + bias));
    }
    __syncthreads();
}

__device__ __forceinline__ void gla_prep_item(const Params& p, LAS unsigned char* lds, int it) {
    int tid_ = threadIdx.x; asm volatile("" : "+v"(tid_)); const int tid = tid_, lane = tid & 63, w = tid >> 6, fr = lane & 15, fq = lane >> 4;
    LAS float* BC = (LAS float*)lds;
    LAS bf16_t* QI = (LAS bf16_t*)(lds + 32768);
    LAS bf16_t* KI = (LAS bf16_t*)(lds + 32768 + 17408);
    LAS bf16_t* KDT = (LAS bf16_t*)(lds + 32768 + 2 * 17408);
    unsigned char* dob = (unsigned char*)p.out;
    bf16_t* Qg = (bf16_t*)(dob + DO_Q) + (size_t)it * 8192;
    bf16_t* Kg = (bf16_t*)(dob + DO_K) + (size_t)it * 8192;
    bf16_t* Lg = (bf16_t*)(dob + DO_LA) + (size_t)it * 8192;
#pragma unroll
    for (int k = 0; k < 2; ++k) { const int e = tid + 512 * k, i = e >> 4, dv = (e & 15) * 8; f32x4 a, b; unpack8(*(const u32x4*)(Lg + i * 128 + dv), a, b);
        *(LAS f32x4*)(BC + i * 128 + dv) = a; *(LAS f32x4*)(BC + i * 128 + dv + 4) = b; }
    __syncthreads();
    { const int d = tid & 127, seg = tid >> 7; float run = 0.f;
#pragma unroll
      for (int r = 0; r < 16; ++r) { const int idx = (16 * seg + r) * 128 + d; run += BC[idx]; BC[idx] = run; }
      __syncthreads();
      float offs = 0.f;
#pragma unroll
      for (int s = 0; s < 3; ++s) if (s < seg) offs += BC[(16 * s + 15) * 128 + d];
      __syncthreads();
#pragma unroll
      for (int r = 0; r < 16; ++r) BC[(16 * seg + r) * 128 + d] += offs;
    }
    __syncthreads();
#pragma unroll
    for (int k = 0; k < 2; ++k) {
        const int e = tid + 512 * k, i = e >> 4, dv = (e & 15) * 8;
        f32x4 q0, q1, k0, k1; unpack8(*(const u32x4*)(Qg + i * 128 + dv), q0, q1); unpack8(*(const u32x4*)(Kg + i * 128 + dv), k0, k1);
        f32x4 qd0, qd1, qi0, qi1, ki0, ki1;
#pragma unroll
        for (int j = 0; j < 4; ++j) {
            { const int d = dv + j; const float bi = BC[i * 128 + d], br = BC[31 * 128 + d], bl = BC[63 * 128 + d];
              qd0[j] = q0[j] * __expf(bi); qi0[j] = q0[j] * __expf(bi - br); ki0[j] = k0[j] * __expf(br - bi); KDT[d * 72 + i] = (bf16_t)f2bf(k0[j] * __expf(bl - bi)); }
            { const int d = dv + 4 + j; const float bi = BC[i * 128 + d], br = BC[31 * 128 + d], bl = BC[63 * 128 + d];
              qd1[j] = q1[j] * __expf(bi); qi1[j] = q1[j] * __expf(bi - br); ki1[j] = k1[j] * __expf(br - bi); KDT[d * 72 + i] = (bf16_t)f2bf(k1[j] * __expf(bl - bi)); }
        }
        *(u32x4*)(Qg + i * 128 + dv) = pack8(qd0, qd1);
        *(LAS u32x4*)(QI + i * 136 + dv) = pack8(qi0, qi1);
        *(LAS u32x4*)(KI + i * 136 + dv) = pack8(ki0, ki1);
    }
    if (tid < 128) ((float*)Lg)[2048 + tid] = __expf(BC[63 * 128 + tid]);
    __syncthreads();
    { const int ti = w >> 1;
#pragma unroll
      for (int tjj = 0; tjj < 2; ++tjj) {
          const int tj = 2 * (w & 1) + tjj; f32x4 acc = (f32x4){0.f, 0.f, 0.f, 0.f};
#pragma unroll
          for (int ks = 0; ks < 4; ++ks) { const bf16x8 af = *(const LAS bf16x8*)(KI + (16 * tj + fr) * 136 + 32 * ks + 8 * fq), bf = *(const LAS bf16x8*)(QI + (16 * ti + fr) * 136 + 32 * ks + 8 * fq);
              acc = __builtin_amdgcn_mfma_f32_16x16x32_bf16(af, bf, acc, 0, 0, 0); }
          const int i = 16 * ti + fr, j0 = 16 * tj + 4 * fq;
#pragma unroll
          for (int r = 0; r < 4; ++r) if (j0 + r > i) acc[r] = 0.f;
          *(u32x2*)(Lg + i * 64 + j0) = pack4(acc);
      } }
#pragma unroll
    for (int k = 0; k < 2; ++k) { const int e = tid + 512 * k, d = e >> 3, jv = (e & 7) * 8; *(u32x4*)(Kg + d * 64 + jv) = *(const LAS u32x4*)(KDT + d * 72 + jv); }
    __syncthreads();
}

__device__ __forceinline__ void gla_seq(const Params& p, LAS unsigned char* lds, int bh, int vs) {
    int tid_ = threadIdx.x; asm volatile("" : "+v"(tid_)); const int tid = tid_, lane = tid & 63, w = tid >> 6, fr = lane & 15, fq = lane >> 4;
    LAS bf16_t* PL = (LAS bf16_t*)lds;
    LAS bf16_t* QD = (LAS bf16_t*)(lds + 9216);
    LAS bf16_t* KD = (LAS bf16_t*)(lds + 26624);
    LAS bf16_t* VT = (LAS bf16_t*)(lds + 45056);
    LAS bf16_t* ST = (LAS bf16_t*)(lds + 49664);
    LAS float* DC = (LAS float*)(lds + 58368);
    const int b = bh >> 2, h = bh & 3;
    unsigned char* dob = (unsigned char*)p.out;
    const bf16_t* Qb = (const bf16_t*)(dob + DO_Q); const bf16_t* Kb = (const bf16_t*)(dob + DO_K); const bf16_t* Lb = (const bf16_t*)(dob + DO_LA);
    bf16_t* Vb = (bf16_t*)(p.ws + WS_V);
    float* rgla = (float*)(p.ws + WS_RGLA);
    for (int e = tid; e < 32 * 136 / 2; e += 512) ((LAS unsigned*)ST)[e] = 0u;
    f32x4 S[2]; S[0] = (f32x4){0.f, 0.f, 0.f, 0.f}; S[1] = S[0];
    u32x4 rP, rQ0, rQ1, rK0, rK1, rV; float rD = 0.f; rV = (u32x4){0u, 0u, 0u, 0u};
#define GLA_LOAD(n) do { const size_t ib_ = ((size_t)(b * 32 + (n)) * 4 + h) * 8192; \
        rP = *(const u32x4*)(Lb + ib_ + (size_t)tid * 8); \
        rQ0 = *(const u32x4*)(Qb + ib_ + (size_t)tid * 8); rQ1 = *(const u32x4*)(Qb + ib_ + (size_t)(tid + 512) * 8); \
        rK0 = *(const u32x4*)(Kb + ib_ + (size_t)tid * 8); rK1 = *(const u32x4*)(Kb + ib_ + (size_t)(tid + 512) * 8); \
        if (tid < 256) rV = *(const u32x4*)(Vb + (size_t)(b * 2048 + (n) * 64 + (tid >> 2)) * 1024 + h * 256 + vs * 32 + (tid & 3) * 8); \
        if (tid < 128) rD = ((const float*)(Lb + ib_))[2048 + tid]; } while (0)
    GLA_LOAD(0);
    for (int n = 0; n < 32; ++n) {
        *(LAS u32x4*)(PL + (tid >> 3) * 72 + (tid & 7) * 8) = rP;
        *(LAS u32x4*)(QD + (tid >> 4) * 136 + (tid & 15) * 8) = rQ0; *(LAS u32x4*)(QD + ((tid + 512) >> 4) * 136 + (tid & 15) * 8) = rQ1;
        *(LAS u32x4*)(KD + (tid >> 3) * 72 + (tid & 7) * 8) = rK0; *(LAS u32x4*)(KD + ((tid + 512) >> 3) * 72 + (tid & 7) * 8) = rK1;
        if (tid < 256) { const int j = tid >> 2, v0 = (tid & 3) * 8;
            VT[(v0 + 0) * 72 + j] = (bf16_t)(rV.x & 0xffffu); VT[(v0 + 1) * 72 + j] = (bf16_t)(rV.x >> 16);
            VT[(v0 + 2) * 72 + j] = (bf16_t)(rV.y & 0xffffu); VT[(v0 + 3) * 72 + j] = (bf16_t)(rV.y >> 16);
            VT[(v0 + 4) * 72 + j] = (bf16_t)(rV.z & 0xffffu); VT[(v0 + 5) * 72 + j] = (bf16_t)(rV.z >> 16);
            VT[(v0 + 6) * 72 + j] = (bf16_t)(rV.w & 0xffffu); VT[(v0 + 7) * 72 + j] = (bf16_t)(rV.w >> 16); }
        if (tid < 128) DC[tid] = rD;
        if (n + 1 < 32) GLA_LOAD(n + 1);
        __syncthreads();
        const int ti = w >> 1, tv = w & 1;
        f32x4 o = (f32x4){0.f, 0.f, 0.f, 0.f};
#pragma unroll
        for (int ks = 0; ks < 2; ++ks) { const bf16x8 af = *(const LAS bf16x8*)(VT + (16 * tv + fr) * 72 + 32 * ks + 8 * fq), bf = *(const LAS bf16x8*)(PL + (16 * ti + fr) * 72 + 32 * ks + 8 * fq);
            o = __builtin_amdgcn_mfma_f32_16x16x32_bf16(af, bf, o, 0, 0, 0); }
#pragma unroll
        for (int ks = 0; ks < 4; ++ks) { const bf16x8 af = *(const LAS bf16x8*)(ST + (16 * tv + fr) * 136 + 32 * ks + 8 * fq), bf = *(const LAS bf16x8*)(QD + (16 * ti + fr) * 136 + 32 * ks + 8 * fq);
            o = __builtin_amdgcn_mfma_f32_16x16x32_bf16(af, bf, o, 0, 0, 0); }
        const f32x4 dec = *(const LAS f32x4*)(DC + 16 * w + 4 * fq);
#pragma unroll
        for (int tvv = 0; tvv < 2; ++tvv) { f32x4 kv = (f32x4){0.f, 0.f, 0.f, 0.f};
#pragma unroll
            for (int ks = 0; ks < 2; ++ks) { const bf16x8 af = *(const LAS bf16x8*)(KD + (16 * w + fr) * 72 + 32 * ks + 8 * fq), bf = *(const LAS bf16x8*)(VT + (16 * tvv + fr) * 72 + 32 * ks + 8 * fq);
                kv = __builtin_amdgcn_mfma_f32_16x16x32_bf16(af, bf, kv, 0, 0, 0); }
            S[tvv] = dec * S[tvv] + kv; }
        __syncthreads();
#pragma unroll
        for (int tvv = 0; tvv < 2; ++tvv) *(LAS u32x2*)(ST + (16 * tvv + fr) * 136 + 16 * w + 4 * fq) = pack4(S[tvv]);
        const int m = b * 2048 + n * 64 + 16 * ti + fr;
        *(u32x2*)(Vb + (size_t)m * 1024 + h * 256 + vs * 32 + 16 * tv + 4 * fq) = pack4(o);
        float ss = o[0] * o[0] + o[1] * o[1] + o[2] * o[2] + o[3] * o[3];
        ss += __shfl_xor(ss, 16); ss += __shfl_xor(ss, 32);
        if (fq == 0) atomic_add_agent(rgla + (size_t)m * 4 + h, ss);
    }
#undef GLA_LOAD
    __syncthreads();
}

__device__ __forceinline__ void grid_bar(unsigned* cnt, unsigned target) {
    asm volatile("s_waitcnt vmcnt(0) lgkmcnt(0)" ::: "memory");
    __syncthreads();
    if (threadIdx.x == 0) {
        __builtin_amdgcn_fence(__ATOMIC_RELEASE, "agent");
        asm volatile("s_waitcnt vmcnt(0)" ::: "memory");
        __hip_atomic_fetch_add(cnt, 1u, __ATOMIC_RELAXED, __HIP_MEMORY_SCOPE_AGENT);
        while (__hip_atomic_load(cnt, __ATOMIC_RELAXED, __HIP_MEMORY_SCOPE_AGENT) < target) __builtin_amdgcn_s_sleep(1);
        __builtin_amdgcn_fence(__ATOMIC_ACQUIRE, "agent");
        asm volatile("s_waitcnt vmcnt(0)" ::: "memory");
    }
    __syncthreads();
}
constexpr int NPH = 11;
__global__ void __launch_bounds__(512, 2) mk_fwd(Params p) {
    extern __shared__ __attribute__((aligned(16))) unsigned char lds_raw[];
    LAS unsigned char* lds = (LAS unsigned char*)lds_raw;
    cg::grid_group grid = cg::this_grid();
    unsigned char* ws = p.ws; unsigned char* dob = (unsigned char*)p.out;
    const int lo = p.ph_lo, hi = p.ph_hi, G = gridDim.x;
#ifndef MK_PHASE_MASK
#define MK_PHASE_MASK 0x7ff
#endif
#define IN(k) ((((MK_PHASE_MASK) >> (k)) & 1) && lo <= (k) && (k) < hi)
#define SEAM(k) do { if (IN(k) && IN((k) + 1)) { if ((k) == 0) grid.sync(); else grid_bar((unsigned*)(ws + WS_BAR), (unsigned)(k) * (unsigned)G); } } while (0)
    if (IN(0)) phase_prologue(p, lds);
    SEAM(0);
    if (IN(1)) {
        EpiIn E{(bf16_t*)(ws + WS_U), (bf16_t*)(ws + WS_VSG), (bf16_t*)(dob + DO_Q), (bf16_t*)(dob + DO_K), (bf16_t*)(ws + WS_V), (bf16_t*)(dob + DO_LA),
                (bf16_t*)(ws + WS_OG), (bf16_t*)(ws + WS_BGA), (bf16_t*)(ws + WS_BGB), (float*)(ws + WS_VSTAT), p.in[10]};
#if defined(MK_DUMP) && MK_DUMP == 21
        (void)E; EpiUpPlain EP{(bf16_t*)(ws + WS_UP)};
        run_gemm(lds, (const bf16_t*)(ws + WS_H), (const bf16_t*)(ws + WS_WIN), 4096, 1024, EP);
#else
        run_gemm(lds, (const bf16_t*)(ws + WS_H), (const bf16_t*)(ws + WS_WIN), NIN, 1024, E);
#endif
    }
    SEAM(1);
    if (IN(2)) {
        for (int it = blockIdx.x; it < 1024; it += G) gla_prep_item(p, lds, it);
        for (int it = blockIdx.x; it < 512; it += G) sg_item(p, lds, it);
    }
    SEAM(2);
    if (IN(3)) {
        for (int it = blockIdx.x; it < 256; it += G) { const int xcd = it & 7, j = it >> 3; gla_seq(p, lds, xcd + 8 * (j >> 3), j & 7); }
        EpiMerge<false> E{(bf16_t*)(ws + WS_H), (const bf16_t*)(ws + WS_BGA)};
        run_gemm(lds, (const bf16_t*)(ws + WS_U), (const bf16_t*)(ws + WS_WA), 1024, 512, E);
    }
    SEAM(3);
    if (IN(4)) {
        const float* rgla = (const float*)(ws + WS_RGLA);
        int tid = threadIdx.x; asm volatile("" : "+v"(tid));
        for (int e = blockIdx.x * 512 + tid; e < M * 128; e += G * 512) {
            const int m = e >> 7, c = (e & 127) * 8, h = c >> 8;
            const float rs = rsqrtf(rgla[m * 4 + h] * (1.f / 256.f) + EPS);
            f32x4 o0, o1, g0, g1; unpack8(*(const u32x4*)((bf16_t*)(ws + WS_V) + (size_t)e * 8), o0, o1); unpack8(*(const u32x4*)((const bf16_t*)(ws + WS_OG) + (size_t)e * 8), g0, g1);
            const f32x4 n0 = *(const f32x4*)(p.in[11] + (c & 255)), n1 = *(const f32x4*)(p.in[11] + (c & 255) + 4);
            *(u32x4*)((bf16_t*)(ws + WS_V) + (size_t)e * 8) = pack8(o0 * rs * n0 * g0, o1 * rs * n1 * g1);
        }
    }
    SEAM(4);
    if (IN(5)) {
        EpiMerge<true> E{(bf16_t*)(ws + WS_H), (const bf16_t*)(ws + WS_BGB)};
        run_gemm(lds, (const bf16_t*)(ws + WS_V), (const bf16_t*)(ws + WS_WB), 1024, 1024, E);
    }
    SEAM(5);
    if (IN(6)) {
        EpiRes E{p.in[0], p.out, (bf16_t*)(ws + WS_XB), (float*)(ws + WS_RSS2)};
        run_gemm(lds, (const bf16_t*)(ws + WS_H), (const bf16_t*)(ws + WS_WO), 1024, 1024, E);
    }
    SEAM(6);
    if (IN(7)) {
        EpiUp E{(bf16_t*)(ws + WS_UP), (const float*)(ws + WS_RSS2)};
        run_gemm(lds, (const bf16_t*)(ws + WS_XB), (const bf16_t*)(ws + WS_WUP), FF, 1024, E);
    }
    SEAM(7);
    if (IN(8)) {
        EpiRes E{p.out, p.out, (bf16_t*)(ws + WS_XB), (float*)(ws + WS_RSS3)};
        run_gemm(lds, (const bf16_t*)(ws + WS_UP), (const bf16_t*)(ws + WS_WDN), 1024, FF, E);
        EpiPlain E2{(bf16_t*)(ws + WS_H)};
        run_gemm(lds, (const bf16_t*)(ws + WS_PB), (const bf16_t*)(ws + WS_WPP), 1024, PLE, E2);
    }
    SEAM(8);
    if (IN(9)) {
        EpiPleGate E{p.out, (const bf16_t*)(ws + WS_H), (const float*)(ws + WS_RSS3), (float*)(ws + WS_RSS4)};
        run_gemm(lds, (const bf16_t*)(ws + WS_XB), (const bf16_t*)(ws + WS_WPG), 1024, 1024, E);
    }
    SEAM(9);
    if (IN(10)) {
        const float* rss4 = (const float*)(ws + WS_RSS4);
        int tid = threadIdx.x; asm volatile("" : "+v"(tid));
        for (int e = blockIdx.x * 512 + tid; e < M * 256; e += G * 512) {
            const int m = e >> 8, c = (e & 255) * 4;
            const float rs = rsqrtf(rss4[m] * (1.f / 1024.f) + EPS);
            const f32x4 v = *(const f32x4*)(p.out + (size_t)e * 4), g = *(const f32x4*)(p.in[20] + c);
            *(f32x4*)(p.out + (size_t)e * 4) = v * rs * g;
        }
    }
#ifdef MK_DUMP
    if (lo == 100) {
        int tid = threadIdx.x;
        for (size_t e = (size_t)blockIdx.x * 512 + tid; e < (size_t)M * 1024; e += (size_t)G * 512) {
            float v = 0.f;
#if MK_DUMP == 1
            v = bf_lo(((const bf16_t*)(ws + WS_V))[e]) + 2.f * bf_lo(((const bf16_t*)(ws + WS_OG))[e]) + 4.f * bf_lo(((const bf16_t*)(ws + WS_BGA))[e]) + 8.f * bf_lo(((const bf16_t*)(ws + WS_BGB))[e]) + 16.f * bf_lo(((const bf16_t*)(ws + WS_U))[e]);
#elif MK_DUMP == 0
            v = bf_lo(((const bf16_t*)(ws + WS_H))[e]) + bf_lo(((const bf16_t*)(ws + WS_WIN))[e % (6656 * 1024)]) + bf_lo(((const bf16_t*)(ws + WS_WUP))[e % (4096 * 1024)]);
#elif MK_DUMP == 21
            v = bf_lo(((const bf16_t*)(ws + WS_UP))[e]) + bf_lo(((const bf16_t*)(ws + WS_UP))[e + (size_t)M * 1024]) + bf_lo(((const bf16_t*)(ws + WS_UP))[e + (size_t)M * 2048]) + bf_lo(((const bf16_t*)(ws + WS_UP))[e + (size_t)M * 3072]);
#elif MK_DUMP == 3
            v = bf_lo(((const bf16_t*)(ws + WS_V))[e]) + bf_lo(((const bf16_t*)(ws + WS_H))[e]) + bf_lo(((const bf16_t*)(ws + WS_U))[e % ((size_t)M * 512)]);
#endif
            p.out[e] = v;
        }
    }
#endif
#undef IN
#undef SEAM
}
}

extern "C" void kernel_launch(void* const* d_in, const int* in_sizes, int n_in, void* d_out, int out_size, void* d_ws, size_t ws_size, hipStream_t stream) {
    static int grid = 0;
    if (grid == 0) {
        if (n_in != 21 || out_size != mk::M * mk::D || ws_size < mk::WS_END) { fprintf(stderr, "kernel_launch: unexpected shapes (n_in %d out %d ws %zu)\n", n_in, out_size, ws_size); grid = -1; return; }
        int dev = 0, cus = 0, per_cu = 0;
        if (hipGetDevice(&dev) != hipSuccess || hipDeviceGetAttribute(&cus, hipDeviceAttributeMultiprocessorCount, dev) != hipSuccess) { grid = -1; return; }
        if (hipFuncSetAttribute((const void*)mk::mk_fwd, hipFuncAttributeMaxDynamicSharedMemorySize, mk::LDS_BYTES) != hipSuccess) { fprintf(stderr, "kernel_launch: hipFuncSetAttribute failed\n"); grid = -1; return; }
        if (hipOccupancyMaxActiveBlocksPerMultiprocessor(&per_cu, (const void*)mk::mk_fwd, 512, mk::LDS_BYTES) != hipSuccess || per_cu < 1) { fprintf(stderr, "kernel_launch: occupancy query says %d\n", per_cu); per_cu = 1; }
        (void)hipGetLastError();
        grid = cus * per_cu;
    }
    if (grid < 0) return;
    mk::Params p{};
    for (int i = 0; i < 21; ++i) p.in[i] = (const float*)d_in[i];
    p.out = (float*)d_out; p.ws = (unsigned char*)d_ws;
#if MK_N_LAUNCHES == 1
    p.ph_lo = 0; p.ph_hi = mk::NPH;
    void* args[] = {&p};
    hipError_t e = hipLaunchCooperativeKernel((const void*)mk::mk_fwd, dim3(grid), dim3(512), args, mk::LDS_BYTES, stream);
    if (e != hipSuccess) fprintf(stderr, "kernel_launch: cooperative launch failed: %s (grid %d)\n", hipGetErrorString(e), grid);
#else
#ifdef MK_DUMP
    for (int ph = 0; ph <= (MK_DUMP == 21 ? 1 : MK_DUMP); ++ph) {
        p.ph_lo = ph; p.ph_hi = ph + 1;
        hipLaunchKernelGGL(mk::mk_fwd, dim3(grid), dim3(512), mk::LDS_BYTES, stream, p);
    }
    p.ph_lo = 100; p.ph_hi = 101;
    hipLaunchKernelGGL(mk::mk_fwd, dim3(grid), dim3(512), mk::LDS_BYTES, stream, p);
#else
    for (int ph = 0; ph < mk::NPH; ++ph) {
        p.ph_lo = ph; p.ph_hi = ph + 1;
        hipLaunchKernelGGL(mk::mk_fwd, dim3(grid), dim3(512), mk::LDS_BYTES, stream, p);
    }
#endif
#endif
}
```

```cpp
#include <hip/hip_runtime.h>
#include <hip/hip_cooperative_groups.h>
#include <cstdio>
#include <cstdint>
namespace cg = cooperative_groups;
namespace pg8 {
#define PG8_LAS __attribute__((address_space(3)))
typedef unsigned short bf16_t;
typedef short bf16x8 __attribute__((ext_vector_type(8)));
typedef float f32x4 __attribute__((ext_vector_type(4)));
typedef unsigned u32x4 __attribute__((ext_vector_type(4)));
constexpr int BM = 256, BK = 64, HALF = 128, HTB = HALF * BK * 2  , STAGE_BYTES = 8 * HTB, NXCD = 8, WGM = 8;

__host__ __device__ __forceinline__ int lds_byte(int r, int c) { const int st = (r >> 4) * 2 + (c >> 5), rr = r & 15, cc = c & 31, ob = rr * 64 + cc * 2; return st * 1024 + (ob ^ (((ob >> 9) & 1) << 5)); }
__host__ __device__ __forceinline__ void stage_rc(int b, int& R, int& C) { const int st = b / 1024, sb = b % 1024, swz = sb ^ (((sb >> 9) & 1) << 5); R = (st >> 1) * 16 + swz / 64; C = (st & 1) * 32 + (swz % 64) / 2; }
__host__ __device__ __forceinline__ int perm32(int rho) { const int n = rho >> 4, i = rho & 15; return 8 * (i >> 2) + 4 * n + (i & 3); }

struct Unit { int pm, pn; };
struct Gemm { const bf16_t* A; const bf16_t* Bt; int M, N, K; };

struct StaticOrder {
    int nM, nN, nwg, G, c;
    __host__ __device__ void init(int M, int N, int G_, int c_) { nM = M / BM; nN = N / BM; nwg = nM * nN; G = G_; c = c_; }
    __host__ __device__ bool next(int i, Unit& u) const {
        const long L = (long)i * G + c; if (L >= nwg) return false;
        int wgid = (int)L; { const int q = nwg / NXCD, r = nwg % NXCD, xcd = wgid % NXCD, off = wgid / NXCD; wgid = (xcd < r ? xcd * (q + 1) : r * (q + 1) + (xcd - r) * q) + off; }
        const int nig = WGM * nN, gid = wgid / nig, fm = gid * WGM, gsz = (nM - fm) < WGM ? (nM - fm) : WGM;
        u.pm = fm + ((wgid % nig) % gsz); u.pn = (wgid % nig) / gsz; return true;
    }
    __device__ __forceinline__ void a_ready(const Unit&) const {}
    __device__ __forceinline__ void done(const Unit&) const {}
};
typedef float f32x2 __attribute__((ext_vector_type(2)));
typedef __bf16 bf16x2_t __attribute__((ext_vector_type(2)));
__device__ __forceinline__ unsigned cvt_pk_bf16(float lo, float hi) { f32x2 v = {lo, hi}; bf16x2_t b = __builtin_convertvector(v, bf16x2_t); return __builtin_bit_cast(unsigned, b); }
template <class Epi, class Sched, bool ALIGN_EPI = false, bool SP2 = false>
__device__ __forceinline__ void gemm_phase(PG8_LAS unsigned char* lds, const Gemm g, const Sched& S, const Epi& E) {
    int tid_ = threadIdx.x; asm volatile("" : "+v"(tid_));
    const int tid = tid_, wid = __builtin_amdgcn_readfirstlane(tid >> 6), lane = tid & 63, wr = wid >> 2, wc = wid & 3, fr = lane & 15, fq = lane >> 4;
    const int K = g.K, nt = K / BK;
    unsigned voffA[2], voffB[2];
#pragma unroll
    for (int i = 0; i < 2; ++i) { int R, C; stage_rc(tid * 16 + i * 8192, R, C); const int Rb = Epi::PERM ? ((R & ~31) + perm32(R & 31)) : R;
        voffA[i] = (unsigned)(R * K + C) * 2u; voffB[i] = (unsigned)(Rb * K + C) * 2u; }
    const size_t kstep = (size_t)(BK * 2);
    const size_t hstep = (size_t)HALF * K * 2;
    const size_t tstep = 2 * hstep;
    const unsigned ldsw = (unsigned)wid * 1024u;
    const int aoff = lds_byte(wr * 64 + fr, fq * 8), boff = lds_byte(wc * 32 + fr, fq * 8);
#define PG8_SA(b, h) (((b) * 2 + (h)) * HTB)
#define PG8_SB(b, h) ((4 + (b) * 2 + (h)) * HTB)
#define PG8_STAGE(bufoff, gbase, voff) do { _Pragma("unroll") for (int _i = 0; _i < 2; ++_i) \
        __builtin_amdgcn_global_load_lds((const unsigned*)((const char*)(gbase) + (voff)[_i]), (PG8_LAS unsigned*)(lds + (bufoff) + ldsw + _i * 8192), 16, 0, 0); } while (0)
#define PG8_LDA(dst, b, h) do { _Pragma("unroll") for (int m = 0; m < 4; ++m) _Pragma("unroll") for (int k = 0; k < 2; ++k) dst[m][k] = *(const PG8_LAS bf16x8*)(lds + PG8_SA(b, h) + aoff + m * 2048 + k * 1024); } while (0)
#define PG8_LDB(dst, b, h) do { _Pragma("unroll") for (int n = 0; n < 2; ++n) _Pragma("unroll") for (int k = 0; k < 2; ++k) dst[n][k] = *(const PG8_LAS bf16x8*)(lds + PG8_SB(b, h) + boff + n * 2048 + k * 1024); } while (0)
#define PG8_MMA(ai, bj, At, Bt) do { __builtin_amdgcn_s_setprio(1); _Pragma("unroll") for (int m = 0; m < 4; ++m) _Pragma("unroll") for (int n = 0; n < 2; ++n) _Pragma("unroll") for (int k = 0; k < 2; ++k) \
        acc[ai][bj][m][n] = __builtin_amdgcn_mfma_f32_16x16x32_bf16(Bt[n][k], At[m][k], acc[ai][bj][m][n], 0, 0, 0); __builtin_amdgcn_s_setprio(0); } while (0)
#define PG8_WAIT_V(n) asm volatile("s_waitcnt vmcnt(" #n ")" ::: "memory")
#define PG8_WAIT_L(n) asm volatile("s_waitcnt lgkmcnt(" #n ")" ::: "memory")
#define PG8_BAR __builtin_amdgcn_s_barrier()
#define PG8_SCHED __builtin_amdgcn_sched_barrier(0)
    Unit cur, nxt; int ui = 0;
    if (!S.next(0, cur)) return;
    f32x4 acc[2][2][4][2];
#pragma unroll
    for (int a = 0; a < 2; ++a)
#pragma unroll
        for (int b = 0; b < 2; ++b)
#pragma unroll
            for (int m = 0; m < 4; ++m)
#pragma unroll
                for (int n = 0; n < 2; ++n) acc[a][b][m][n] = (f32x4){0.f, 0.f, 0.f, 0.f};
    bf16x8 At[4][2], B0[2][2], B1[2][2];
    const char* cA = (const char*)g.A + (size_t)cur.pm * tstep; const char* cB = (const char*)g.Bt + (size_t)cur.pn * tstep;
    S.a_ready(cur);
    if constexpr (SP2) {
        PG8_STAGE(PG8_SB(0, 0), cB, voffB); PG8_STAGE(PG8_SB(0, 1), cB + hstep, voffB); PG8_STAGE(PG8_SA(0, 0), cA, voffA); PG8_STAGE(PG8_SA(0, 1), cA + hstep, voffA);
        if (wr == 1) PG8_BAR;
        PG8_WAIT_V(2); PG8_BAR;
        PG8_STAGE(PG8_SB(1, 0), cB + kstep, voffB); PG8_STAGE(PG8_SA(1, 0), cA + kstep, voffA); PG8_STAGE(PG8_SB(1, 1), cB + hstep + kstep, voffB);
        PG8_WAIT_V(6); PG8_BAR;
    } else {
        PG8_STAGE(PG8_SB(0, 0), cB, voffB); PG8_STAGE(PG8_SA(0, 0), cA, voffA); PG8_STAGE(PG8_SB(0, 1), cB + hstep, voffB); PG8_STAGE(PG8_SA(0, 1), cA + hstep, voffA);
        if (wr == 1) PG8_BAR;
        PG8_WAIT_V(4); PG8_BAR;
        PG8_STAGE(PG8_SB(1, 0), cB + kstep, voffB); PG8_STAGE(PG8_SA(1, 0), cA + kstep, voffA); PG8_STAGE(PG8_SB(1, 1), cB + hstep + kstep, voffB);
        PG8_WAIT_V(6); PG8_BAR;
    }
    for (;;) {
        const bool has_next = S.next(ui + 1, nxt);
        const char* nA = has_next ? (const char*)g.A + (size_t)nxt.pm * tstep : cA; const char* nB = has_next ? (const char*)g.Bt + (size_t)nxt.pn * tstep : cB;
        for (int t = 0; t < nt; t += 2) {
            const bool last = (t == nt - 2);
            const char* a1 = cA + (size_t)(t + 1) * kstep;
            const char* a2 = last ? nA : cA + (size_t)(t + 2) * kstep; const char* b2 = last ? nB : cB + (size_t)(t + 2) * kstep;
            const char* a3 = a2 + kstep; const char* b3 = b2 + kstep;
            if (last && has_next) S.a_ready(nxt);
            if constexpr (SP2) {
            PG8_LDB(B0, 0, 0); PG8_LDB(B1, 0, 1); PG8_SCHED; PG8_LDA(At, 0, 0); PG8_STAGE(PG8_SA(1, 1), a1 + hstep, voffA);
            PG8_WAIT_V(8); PG8_WAIT_L(0); PG8_BAR; PG8_MMA(0, 0, At, B0); PG8_MMA(0, 1, At, B1); PG8_BAR; PG8_SCHED;
            PG8_LDA(At, 0, 1); PG8_STAGE(PG8_SB(0, 0), b2, voffB); PG8_STAGE(PG8_SB(0, 1), b2 + hstep, voffB); PG8_STAGE(PG8_SA(0, 0), a2, voffA);
            PG8_WAIT_V(8); PG8_WAIT_L(0); PG8_BAR; PG8_MMA(1, 0, At, B0); PG8_MMA(1, 1, At, B1); PG8_BAR; PG8_SCHED;
            PG8_LDB(B0, 1, 0); PG8_LDB(B1, 1, 1); PG8_SCHED; PG8_LDA(At, 1, 0); PG8_STAGE(PG8_SA(0, 1), a2 + hstep, voffA);
            PG8_WAIT_V(8); PG8_WAIT_L(0); PG8_BAR; PG8_MMA(0, 0, At, B0); PG8_MMA(0, 1, At, B1); PG8_BAR; PG8_SCHED;
            PG8_LDA(At, 1, 1); PG8_STAGE(PG8_SB(1, 0), b3, voffB); PG8_STAGE(PG8_SB(1, 1), b3 + hstep, voffB); PG8_STAGE(PG8_SA(1, 0), a3, voffA);
            PG8_WAIT_V(8); PG8_WAIT_L(0); PG8_BAR; PG8_MMA(1, 0, At, B0); PG8_MMA(1, 1, At, B1); PG8_BAR; PG8_SCHED;
            } else {
            PG8_LDB(B0, 0, 0); PG8_SCHED; PG8_LDA(At, 0, 0); PG8_STAGE(PG8_SA(1, 1), a1 + hstep, voffA);
            PG8_WAIT_L(8); PG8_BAR; PG8_WAIT_L(0); PG8_MMA(0, 0, At, B0); PG8_BAR; PG8_SCHED;
            PG8_LDB(B1, 0, 1); PG8_STAGE(PG8_SB(0, 0), b2, voffB);
            PG8_BAR; PG8_WAIT_L(0); PG8_MMA(0, 1, At, B1); PG8_BAR;
            PG8_LDA(At, 0, 1); PG8_STAGE(PG8_SA(0, 0), a2, voffA);
            PG8_BAR; PG8_WAIT_L(0); PG8_MMA(1, 0, At, B0); PG8_BAR; PG8_SCHED;
            PG8_STAGE(PG8_SB(0, 1), b2 + hstep, voffB);
            PG8_WAIT_V(6); PG8_BAR; PG8_MMA(1, 1, At, B1); PG8_BAR;
            PG8_LDB(B0, 1, 0); PG8_SCHED; PG8_LDA(At, 1, 0); PG8_STAGE(PG8_SA(0, 1), a2 + hstep, voffA);
            PG8_WAIT_L(8); PG8_BAR; PG8_WAIT_L(0); PG8_MMA(0, 0, At, B0); PG8_BAR; PG8_SCHED;
            PG8_LDB(B1, 1, 1); PG8_STAGE(PG8_SB(1, 0), b3, voffB);
            PG8_BAR; PG8_WAIT_L(0); PG8_MMA(0, 1, At, B1); PG8_BAR;
            PG8_LDA(At, 1, 1); PG8_STAGE(PG8_SA(1, 0), a3, voffA);
            PG8_BAR; PG8_WAIT_L(0); PG8_MMA(1, 0, At, B0); PG8_BAR; PG8_SCHED;
            PG8_STAGE(PG8_SB(1, 1), b3 + hstep, voffB);
            PG8_WAIT_V(6); PG8_BAR; PG8_MMA(1, 1, At, B1); PG8_BAR;
            }
        }
        if constexpr (ALIGN_EPI) { if (wr == 0) PG8_BAR; }
        if constexpr (!Epi::AFTER_DRAIN) { E(acc, cur, wr, wc, fr, fq); S.done(cur); }
        if (!has_next) break;
#pragma unroll
        for (int a = 0; a < 2; ++a)
#pragma unroll
            for (int b = 0; b < 2; ++b)
#pragma unroll
                for (int m = 0; m < 4; ++m)
#pragma unroll
                    for (int n = 0; n < 2; ++n) acc[a][b][m][n] = (f32x4){0.f, 0.f, 0.f, 0.f};
        cur = nxt; cA = nA; cB = nB; ++ui;
        if constexpr (ALIGN_EPI) { if (wr == 1) PG8_BAR; }
    }
    PG8_WAIT_V(0);
    if constexpr (!ALIGN_EPI) { if (wr == 0) PG8_BAR; }
    PG8_BAR;
    if constexpr (Epi::AFTER_DRAIN) { E.fused(acc, cur, wr, wc, fr, fq, lds, wid, lane); S.done(cur); }
#undef PG8_SA
#undef PG8_SB
#undef PG8_STAGE
#undef PG8_LDA
#undef PG8_LDB
#undef PG8_MMA
#undef PG8_WAIT_V
#undef PG8_WAIT_L
#undef PG8_BAR
#undef PG8_SCHED
}
}

#define LAS __attribute__((address_space(3)))
namespace mk {
using pg8::bf16_t; using pg8::bf16x8; using pg8::f32x4; using pg8::u32x4; using pg8::Unit;
typedef unsigned u32x2 __attribute__((ext_vector_type(2)));

constexpr int M = 16384, D = 1024, SEQ = 2048, FF = 4096, PLE = 256, NIN = 6656;
constexpr float EPS = 1e-6f;
constexpr size_t MiB = 1u << 20;
constexpr size_t WS_VSTAT = 0;
constexpr size_t WS_RSS2 = 128 * 1024;
constexpr size_t WS_RSS3 = 192 * 1024;
constexpr size_t WS_RSS4 = 256 * 1024;
constexpr size_t WS_RGLA = 320 * 1024;
constexpr size_t WS_BAR = 576 * 1024;
constexpr size_t WS_BHC = 576 * 1024 + 256;
constexpr size_t WS_P35 = 576 * 1024 + 256 + 8192;
constexpr size_t WS_PCNT = 592 * 1024;
constexpr size_t WS_ZERO_END = 640 * 1024;
constexpr size_t WS_XBAR = 640 * 1024;
constexpr size_t WS_WSB = 1 * MiB;
constexpr size_t WS_WIN = 2 * MiB;
constexpr size_t WS_WA = 15 * MiB;
constexpr size_t WS_WB = 16 * MiB;
constexpr size_t WS_WO = 18 * MiB;
constexpr size_t WS_WUP = 20 * MiB;
constexpr size_t WS_WDN = 28 * MiB;
constexpr size_t WS_WPG = 36 * MiB;
constexpr size_t WS_WPP = 38 * MiB;
constexpr size_t WS_PB = 39 * MiB;
constexpr size_t WS_H = 47 * MiB;
constexpr size_t WS_U = 79 * MiB;
constexpr size_t WS_VSG = 95 * MiB;
constexpr size_t WS_V = 111 * MiB;
constexpr size_t WS_OG = 143 * MiB;
constexpr size_t WS_BGA = 175 * MiB;
constexpr size_t WS_BGB = 207 * MiB;
constexpr size_t WS_UP = 79 * MiB;
constexpr size_t WS_XB = 207 * MiB;
constexpr size_t WS_GPART = 239 * MiB;
constexpr size_t WS_END = 243 * MiB;
constexpr size_t DO_Q = 0, DO_K = 16 * MiB, DO_LA = 32 * MiB;

constexpr int LDS_BYTES = 147456;

struct Params { const float* in[21]; float* out; unsigned char* ws; };

__device__ __forceinline__ unsigned f2bf(float f) { unsigned u = __builtin_bit_cast(unsigned, f); return (u + 0x7fffu + ((u >> 16) & 1u)) >> 16; }
__device__ __forceinline__ unsigned pk2(float lo, float hi) { return pg8::cvt_pk_bf16(lo, hi); }
__device__ __forceinline__ float bf_lo(unsigned u) { return __uint_as_float(u << 16); }
__device__ __forceinline__ float bf_hi(unsigned u) { return __uint_as_float(u & 0xffff0000u); }
__device__ __forceinline__ u32x4 pack8(f32x4 a, f32x4 b) { u32x4 w; w.x = pk2(a[0], a[1]); w.y = pk2(a[2], a[3]); w.z = pk2(b[0], b[1]); w.w = pk2(b[2], b[3]); return w; }
__device__ __forceinline__ u32x2 pack4(f32x4 a) { u32x2 w; w.x = pk2(a[0], a[1]); w.y = pk2(a[2], a[3]); return w; }
__device__ __forceinline__ void unpack8(u32x4 w, f32x4& a, f32x4& b) { a[0] = bf_lo(w.x); a[1] = bf_hi(w.x); a[2] = bf_lo(w.y); a[3] = bf_hi(w.y); b[0] = bf_lo(w.z); b[1] = bf_hi(w.z); b[2] = bf_lo(w.w); b[3] = bf_hi(w.w); }
__device__ __forceinline__ f32x4 unpack4(u32x2 w) { f32x4 a; a[0] = bf_lo(w.x); a[1] = bf_hi(w.x); a[2] = bf_lo(w.y); a[3] = bf_hi(w.y); return a; }
__device__ __forceinline__ float sigmoid_f(float x) { return __builtin_amdgcn_rcpf(1.f + __expf(-x)); }
__device__ __forceinline__ float gelu_f(float x) { const float t = 1.5957691216057308f * (x + 0.044715f * x * x * x); return x * sigmoid_f(t); }
__device__ __forceinline__ float silu_f(float x) { return x * sigmoid_f(x); }
__device__ __forceinline__ float logsig_f(float x) { return fminf(x, 0.f) - __logf(1.f + __expf(-fabsf(x))); }
__device__ __forceinline__ float wave_sum(float v) {
#pragma unroll
    for (int o = 1; o < 64; o <<= 1) v += __shfl_xor(v, o);
    return v;
}
__device__ __forceinline__ void atomic_add_agent(float* p, float v) { (void)__hip_atomic_fetch_add(p, v, __ATOMIC_RELAXED, __HIP_MEMORY_SCOPE_AGENT); }
__device__ __forceinline__ void lds_barrier() { asm volatile("s_waitcnt lgkmcnt(0)" ::: "memory"); __builtin_amdgcn_s_barrier(); asm volatile("" ::: "memory"); }
#define LDS_WAIT() asm volatile("s_waitcnt lgkmcnt(0)" ::: "memory")

enum { ACT_NONE = 0, ACT_GELU, ACT_SILU, ACT_SIGM, ACT_SCALE, ACT_LOGSIG };
enum { LAY_512 = 0, LAY_1024, LAY_BLK };
template <int ACT> __device__ __forceinline__ float act1(float x) {
    if (ACT == ACT_GELU) return gelu_f(x);
    if (ACT == ACT_SILU) return silu_f(x);
    if (ACT == ACT_SIGM) return sigmoid_f(x);
    if (ACT == ACT_SCALE) return x * 0.08838834764831845f;
    if (ACT == ACT_LOGSIG) return logsig_f(x) * 0.0625f;
    return x;
}
struct EpiIn {
    static constexpr bool PERM = true, AFTER_DRAIN = false;
    bf16_t *U, *VSG, *Q, *K, *V, *LA, *OG, *BGA, *BGB; float* vstat; const float* bgate;
    template <int ACT, int LAY, bool STATS, bool BIAS> __device__ __forceinline__ void run(const f32x4 (&acc)[2][2][4][2], bf16_t* base, int rowb, int colb, int fq) const {
        f32x4 b0[2], b1[2];
#pragma unroll
        for (int bj = 0; bj < 2; ++bj) { if (BIAS) { b0[bj] = *(const f32x4*)(bgate + colb + bj * 128); b1[bj] = *(const f32x4*)(bgate + colb + bj * 128 + 4); } else { b0[bj] = (f32x4){0.f, 0.f, 0.f, 0.f}; b1[bj] = b0[bj]; } }
#pragma unroll
        for (int ai = 0; ai < 2; ++ai)
#pragma unroll
            for (int m = 0; m < 4; ++m) {
                const int row = rowb + ai * 128 + m * 16; float s1 = 0.f, s2 = 0.f;
#pragma unroll
                for (int bj = 0; bj < 2; ++bj) {
                    const int col = colb + bj * 128; f32x4 v0 = acc[ai][bj][m][0] + b0[bj], v1 = acc[ai][bj][m][1] + b1[bj];
#pragma unroll
                    for (int j = 0; j < 4; ++j) { v0[j] = act1<ACT>(v0[j]); v1[j] = act1<ACT>(v1[j]); }
                    const u32x4 w = pack8(v0, v1);
                    if (STATS) { f32x4 r0, r1; unpack8(w, r0, r1);
#pragma unroll
                        for (int j = 0; j < 4; ++j) { s1 += r0[j] + r1[j]; s2 += r0[j] * r0[j] + r1[j] * r1[j]; } }
                    size_t off;
                    if (LAY == LAY_512) off = (size_t)row * 512 + col;
                    else if (LAY == LAY_1024) off = (size_t)row * 1024 + col;
                    else off = ((size_t)(row >> 6) * 4 + (col >> 7)) * 8192 + (size_t)(row & 63) * 128 + (col & 127);
                    __builtin_nontemporal_store(w, (u32x4*)(base + off));
                }
                asm volatile("" ::: "memory");
                if (STATS) { s1 += __shfl_xor(s1, 16); s1 += __shfl_xor(s1, 32); s2 += __shfl_xor(s2, 16); s2 += __shfl_xor(s2, 32);
                    if (fq == 0) { atomic_add_agent(vstat + 2 * row, s1); atomic_add_agent(vstat + 2 * row + 1, s2); } }
            }
    }
    __device__ __forceinline__ void operator()(const f32x4 (&acc)[2][2][4][2], const Unit& u, int wr, int wc, int fr, int fq) const {
        const int rowb = u.pm * 256 + wr * 64 + fr, cw = wc * 32 + 8 * fq, pn = u.pn;
        if (pn < 2) run<ACT_GELU, LAY_512, false, false>(acc, U, rowb, pn * 256 + cw, fq);
        else if (pn < 4) run<ACT_GELU, LAY_512, true, false>(acc, VSG, rowb, (pn - 2) * 256 + cw, fq);
        else if (pn < 6) run<ACT_SCALE, LAY_BLK, false, false>(acc, Q, rowb, (pn - 4) * 256 + cw, fq);
        else if (pn < 8) run<ACT_NONE, LAY_BLK, false, false>(acc, K, rowb, (pn - 6) * 256 + cw, fq);
        else if (pn < 12) run<ACT_NONE, LAY_1024, false, false>(acc, V, rowb, (pn - 8) * 256 + cw, fq);
        else if (pn < 14) run<ACT_LOGSIG, LAY_BLK, false, true>(acc, LA, rowb, (pn - 12) * 256 + cw, fq);
        else if (pn < 18) run<ACT_SILU, LAY_1024, false, false>(acc, OG, rowb, (pn - 14) * 256 + cw, fq);
        else if (pn < 22) run<ACT_SIGM, LAY_1024, false, false>(acc, BGA, rowb, (pn - 18) * 256 + cw, fq);
        else run<ACT_SIGM, LAY_1024, false, false>(acc, BGB, rowb, (pn - 22) * 256 + cw, fq);
    }
};
template <bool ACCUM> struct EpiMerge {
    static constexpr bool PERM = true, AFTER_DRAIN = false;
    bf16_t* MG; const bf16_t* G;
    __device__ __forceinline__ void operator()(const f32x4 (&acc)[2][2][4][2], const Unit& u, int wr, int wc, int fr, int fq) const {
        const int rowb = u.pm * 256 + wr * 64 + fr, colb = u.pn * 256 + wc * 32 + 8 * fq;
#pragma unroll
        for (int ai = 0; ai < 2; ++ai)
#pragma unroll
            for (int m = 0; m < 4; ++m)
#pragma unroll
                for (int bj = 0; bj < 2; ++bj) {
                    const size_t off = (size_t)(rowb + ai * 128 + m * 16) * 1024 + colb + bj * 128;
                    f32x4 g0, g1; unpack8(*(const u32x4*)(G + off), g0, g1);
                    f32x4 v0 = acc[ai][bj][m][0] * g0, v1 = acc[ai][bj][m][1] * g1;
                    if (ACCUM) { f32x4 p0, p1; unpack8(*(const u32x4*)(MG + off), p0, p1); v0 += p0; v1 += p1; }
                    *(u32x4*)(MG + off) = pack8(v0, v1);
                    asm volatile("" ::: "memory");
                }
    }
};
template <bool BF16_BASE> struct EpiRes {
    static constexpr bool PERM = true, AFTER_DRAIN = false;
    const float* base; bf16_t* xb; float* rss;
    __device__ __forceinline__ void operator()(const f32x4 (&acc)[2][2][4][2], const Unit& u, int wr, int wc, int fr, int fq) const {
        const int rowb = u.pm * 256 + wr * 64 + fr, colb = u.pn * 256 + wc * 32 + 8 * fq;
#pragma unroll
        for (int ai = 0; ai < 2; ++ai)
#pragma unroll
            for (int m = 0; m < 4; ++m) {
                const int row = rowb + ai * 128 + m * 16; float ss = 0.f;
#pragma unroll
                for (int bj = 0; bj < 2; ++bj) {
                    const size_t off = (size_t)row * 1024 + colb + bj * 128;
                    f32x4 v0, v1;
                    if (BF16_BASE) unpack8(*(const u32x4*)(xb + off), v0, v1); else { v0 = *(const f32x4*)(base + off); v1 = *(const f32x4*)(base + off + 4); }
                    v0 += acc[ai][bj][m][0]; v1 += acc[ai][bj][m][1];
                    *(u32x4*)(xb + off) = pack8(v0, v1);
#pragma unroll
                    for (int j = 0; j < 4; ++j) ss += v0[j] * v0[j] + v1[j] * v1[j];
                }
                ss += __shfl_xor(ss, 16); ss += __shfl_xor(ss, 32);
                if (fq == 0) atomic_add_agent(rss + row, ss);
                asm volatile("" ::: "memory");
            }
    }
};
struct EpiUp {
    static constexpr bool PERM = true, AFTER_DRAIN = false;
    bf16_t* UPB; const float* rss;
    __device__ __forceinline__ void operator()(const f32x4 (&acc)[2][2][4][2], const Unit& u, int wr, int wc, int fr, int fq) const {
        const int rowb = u.pm * 256 + wr * 64 + fr, colb = u.pn * 256 + wc * 32 + 8 * fq;
#pragma unroll
        for (int ai = 0; ai < 2; ++ai)
#pragma unroll
            for (int m = 0; m < 4; ++m) {
                const int row = rowb + ai * 128 + m * 16; const float rs = rsqrtf(rss[row] * (1.f / 1024.f) + EPS);
#pragma unroll
                for (int bj = 0; bj < 2; ++bj) {
                    f32x4 v0 = acc[ai][bj][m][0] * rs, v1 = acc[ai][bj][m][1] * rs;
#pragma unroll
                    for (int j = 0; j < 4; ++j) { const float a = fmaxf(v0[j], 0.f), b = fmaxf(v1[j], 0.f); v0[j] = a * a; v1[j] = b * b; }
                    *(u32x4*)(UPB + (size_t)row * 4096 + colb + bj * 128) = pack8(v0, v1);
                }
                asm volatile("" ::: "memory");
            }
    }
};
struct EpiPlain {
    static constexpr bool PERM = true, AFTER_DRAIN = false;
    bf16_t* O;
    __device__ __forceinline__ void operator()(const f32x4 (&acc)[2][2][4][2], const Unit& u, int wr, int wc, int fr, int fq) const {
        const int rowb = u.pm * 256 + wr * 64 + fr, colb = u.pn * 256 + wc * 32 + 8 * fq;
#pragma unroll
        for (int ai = 0; ai < 2; ++ai)
#pragma unroll
            for (int m = 0; m < 4; ++m)
#pragma unroll
                for (int bj = 0; bj < 2; ++bj)
                    *(u32x4*)(O + (size_t)(rowb + ai * 128 + m * 16) * 1024 + colb + bj * 128) = pack8(acc[ai][bj][m][0], acc[ai][bj][m][1]);
    }
};
struct EpiPleGate {
    static constexpr bool PERM = true, AFTER_DRAIN = false;
    float* x; const bf16_t* xb; const bf16_t* PLEB; const float* rss_in; float* rss_out;
    __device__ __forceinline__ void operator()(const f32x4 (&acc)[2][2][4][2], const Unit& u, int wr, int wc, int fr, int fq) const {
        const int rowb = u.pm * 256 + wr * 64 + fr, colb = u.pn * 256 + wc * 32 + 8 * fq;
#pragma unroll
        for (int ai = 0; ai < 2; ++ai)
#pragma unroll
            for (int m = 0; m < 4; ++m) {
                const int row = rowb + ai * 128 + m * 16; const float rs = rsqrtf(rss_in[row] * (1.f / 1024.f) + EPS); float ss = 0.f;
#pragma unroll
                for (int bj = 0; bj < 2; ++bj) {
                    const size_t off = (size_t)row * 1024 + colb + bj * 128;
                    f32x4 p0, p1; unpack8(*(const u32x4*)(PLEB + off), p0, p1);
                    f32x4 v0, v1; unpack8(*(const u32x4*)(xb + off), v0, v1);
#pragma unroll
                    for (int j = 0; j < 4; ++j) { v0[j] += sigmoid_f(acc[ai][bj][m][0][j] * rs) * p0[j]; v1[j] += sigmoid_f(acc[ai][bj][m][1][j] * rs) * p1[j]; ss += v0[j] * v0[j] + v1[j] * v1[j]; }
                    *(f32x4*)(x + off) = v0; *(f32x4*)(x + off + 4) = v1;
                }
                ss += __shfl_xor(ss, 16); ss += __shfl_xor(ss, 32);
                if (fq == 0) atomic_add_agent(rss_out + row, ss);
                asm volatile("" ::: "memory");
            }
    }
};

struct EpiPleFinal {
    static constexpr bool PERM = true, AFTER_DRAIN = true;
    float* out; const bf16_t* xb; const bf16_t* PLEB; const float* rss_in; float* rss_out; unsigned* pcnt; const float* gfin; bool same_xcd;
    __device__ __forceinline__ void fused(f32x4 (&acc)[2][2][4][2], const Unit& u, int wr, int wc, int fr, int fq, PG8_LAS unsigned char* lds, int wid, int lane) const {
        const int rowb = u.pm * 256 + wr * 64 + fr, colb = u.pn * 256 + wc * 32 + 8 * fq;
#pragma unroll
        for (int ai = 0; ai < 2; ++ai)
#pragma unroll
            for (int m = 0; m < 4; ++m) {
                const int row = rowb + ai * 128 + m * 16; const float rs = rsqrtf(rss_in[row] * (1.f / 1024.f) + EPS); float ss = 0.f;
#pragma unroll
                for (int bj = 0; bj < 2; ++bj) {
                    const size_t off = (size_t)row * 1024 + colb + bj * 128;
                    f32x4 p0, p1; unpack8(*(const u32x4*)(PLEB + off), p0, p1);
                    f32x4 v0, v1; unpack8(*(const u32x4*)(xb + off), v0, v1);
#pragma unroll
                    for (int j = 0; j < 4; ++j) { v0[j] += sigmoid_f(acc[ai][bj][m][0][j] * rs) * p0[j]; v1[j] += sigmoid_f(acc[ai][bj][m][1][j] * rs) * p1[j]; ss += v0[j] * v0[j] + v1[j] * v1[j]; }
                    acc[ai][bj][m][0] = v0; acc[ai][bj][m][1] = v1;
                }
                ss += __shfl_xor(ss, 16); ss += __shfl_xor(ss, 32);
                if (fq == 0) atomic_add_agent(rss_out + row, ss);
                asm volatile("" ::: "memory");
            }
        asm volatile("s_waitcnt vmcnt(0)" ::: "memory");
        __syncthreads();
        if (wid == 0 && lane == 0) {
            unsigned* c = pcnt + 32 * u.pm;
            if (!same_xcd) { __builtin_amdgcn_fence(__ATOMIC_RELEASE, "agent"); asm volatile("s_waitcnt vmcnt(0)" ::: "memory"); }
            __hip_atomic_fetch_add(c, 1u, __ATOMIC_RELAXED, __HIP_MEMORY_SCOPE_AGENT);
            while (__hip_atomic_load(c, __ATOMIC_RELAXED, __HIP_MEMORY_SCOPE_AGENT) < 4u) __builtin_amdgcn_s_sleep(1);
            __builtin_amdgcn_fence(__ATOMIC_ACQUIRE, "agent"); asm volatile("s_waitcnt vmcnt(0)" ::: "memory");
        }
        __syncthreads();
        f32x4 g0[2], g1[2];
#pragma unroll
        for (int bj = 0; bj < 2; ++bj) { g0[bj] = *(const f32x4*)(gfin + colb + bj * 128); g1[bj] = *(const f32x4*)(gfin + colb + bj * 128 + 4); }
        float rf[2][4];
#pragma unroll
        for (int ai = 0; ai < 2; ++ai)
#pragma unroll
            for (int m = 0; m < 4; ++m) rf[ai][m] = __hip_atomic_load(rss_out + rowb + ai * 128 + m * 16, __ATOMIC_RELAXED, __HIP_MEMORY_SCOPE_AGENT);
        const int tid = wid * 64 + lane;
#pragma unroll
        for (int ai = 0; ai < 2; ++ai) {
#pragma unroll
            for (int m = 0; m < 4; ++m) {
                const float rs = rsqrtf(rf[ai][m] * (1.f / 1024.f) + EPS);
                const int rowl = wr * 64 + m * 16 + fr;
#pragma unroll
                for (int bj = 0; bj < 2; ++bj) {
                    const int c = bj * 32 + wc * 8 + 2 * fq;
                    *(PG8_LAS f32x4*)(lds + rowl * 1024 + (((c) ^ (rowl & 63)) << 4)) = acc[ai][bj][m][0] * rs * g0[bj];
                    *(PG8_LAS f32x4*)(lds + rowl * 1024 + (((c + 1) ^ (rowl & 63)) << 4)) = acc[ai][bj][m][1] * rs * g1[bj];
                }
            }
            lds_barrier();
#pragma unroll
            for (int k = 0; k < 16; ++k) { const int e = tid + 512 * k, rowl = e >> 6, c = e & 63;
                const f32x4 v = *(const PG8_LAS f32x4*)(lds + rowl * 1024 + ((c ^ (rowl & 63)) << 4));
                *(f32x4*)(out + (size_t)(u.pm * 256 + ai * 128 + rowl) * 1024 + u.pn * 256 + c * 4) = v; }
            lds_barrier();
        }
    }
};

template <class Epi, bool ALIGN = true> __device__ __forceinline__ void run_gemm(LAS unsigned char* lds, const bf16_t* A, const bf16_t* Bt, int N, int K, const Epi& E) {
    asm volatile("" : "+s"(K));
    pg8::Gemm g{A, Bt, M, N, K}; pg8::StaticOrder S; S.init(M, N, (int)gridDim.x, (int)blockIdx.x);
    pg8::gemm_phase<Epi, pg8::StaticOrder, ALIGN, true>(lds, g, S, E);
}

struct TrDesc { const float* W; const float* ksc; bf16_t* WT; int ldw, K, ncols, row_off, r; };
__device__ __forceinline__ void tr_load(const TrDesc& d, float (&wv)[32], int lane) {
    const int nblk = d.ncols / 32, kb = d.r / nblk, nb = d.r % nblk, k0 = 64 * kb, n0 = 32 * nb;
#pragma unroll
    for (int i = 0; i < 32; ++i) wv[i] = d.W[(size_t)(k0 + 2 * i + (lane >> 5)) * d.ldw + n0 + (lane & 31)];
}
__device__ __forceinline__ void tr_finish(const TrDesc& d, float (&wv)[32], LAS float* scr, int lane) {
    const int nblk = d.ncols / 32, kb = d.r / nblk, nb = d.r % nblk, k0 = 64 * kb, n0 = 32 * nb;
    if (d.ksc) {
#pragma unroll
        for (int i = 0; i < 32; ++i) wv[i] *= d.ksc[k0 + 2 * i + (lane >> 5)];
    }
#pragma unroll
    for (int i = 0; i < 32; ++i) scr[(2 * i + (lane >> 5)) * 33 + (lane & 31)] = wv[i];
    LDS_WAIT();
    const int c = lane & 7;
#pragma unroll
    for (int j = 0; j < 4; ++j) { const int n = (lane >> 3) + 8 * j; const LAS float* s = scr + (8 * c) * 33 + n;
        u32x4 o; o.x = pk2(s[0 * 33], s[1 * 33]); o.y = pk2(s[2 * 33], s[3 * 33]); o.z = pk2(s[4 * 33], s[5 * 33]); o.w = pk2(s[6 * 33], s[7 * 33]);
        *(u32x4*)(d.WT + (size_t)(d.row_off + n0 + n) * d.K + k0 + 8 * c) = o; }
    LDS_WAIT();
}
__device__ __forceinline__ void comb_item(const float* Win, const float* Wgu, bf16_t* WT, LAS float* scr, int item, int lane) {
    const int nblk = 512 / 32, kb = item / nblk, nb = item % nblk, k0 = 64 * kb, n0 = 32 * nb;
    float g[16];
#pragma unroll
    for (int r = 0; r < 16; ++r) g[r] = Wgu[r * 512 + n0 + (lane & 31)];
#pragma unroll 8
    for (int i = 0; i < 32; ++i) { const int kk = 2 * i + (lane >> 5); const f32x4* wr_ = (const f32x4*)(Win + (size_t)(k0 + kk) * 6160 + 3072);
        const f32x4 a = wr_[0], b = wr_[1], c = wr_[2], d = wr_[3]; float s = 0.f;
#pragma unroll
        for (int r = 0; r < 4; ++r) s += a[r] * g[r] + b[r] * g[4 + r] + c[r] * g[8 + r] + d[r] * g[12 + r];
        scr[kk * 33 + (lane & 31)] = s; }
    LDS_WAIT();
    const int c = lane & 7;
#pragma unroll
    for (int j = 0; j < 4; ++j) { const int n = (lane >> 3) + 8 * j; const LAS float* s = scr + (8 * c) * 33 + n;
        u32x4 o; o.x = pk2(s[0 * 33], s[1 * 33]); o.y = pk2(s[2 * 33], s[3 * 33]); o.z = pk2(s[4 * 33], s[5 * 33]); o.w = pk2(s[6 * 33], s[7 * 33]);
        *(u32x4*)(WT + (size_t)(3072 + n0 + n) * 1024 + k0 + 8 * c) = o; }
    LDS_WAIT();
}

constexpr int I_IN1 = 16 * 96, I_IN2 = 16 * 96, I_A = 8 * 32, I_B = 16 * 32, I_O = 16 * 32, I_UP = 16 * 128, I_DN = 64 * 32, I_PG = 16 * 32, I_PP = 4 * 32;
constexpr int TR_EARLY = I_IN1 + I_IN2, TR_ALL = I_IN1 + I_IN2 + I_A + I_B + I_O + I_UP + I_DN + I_PG + I_PP;
__device__ __forceinline__ void tr_run(const Params& p, LAS float* scr, int lane, int first, int count, int w0, int nw) {
    unsigned char* ws = p.ws;
#define TR_DECODE(d, it_) do { int r = (it_); d.W = p.in[3]; d.ksc = nullptr; d.ldw = 6160; d.K = 1024; d.ncols = 3072; d.row_off = 0; size_t wto = WS_WIN; \
        if (r < I_IN1) { } \
        else if ((r -= I_IN1) < I_IN2) { d.W = p.in[3] + 3088; d.row_off = 3584; } \
        else if ((r -= I_IN2) < I_A) { d.W = p.in[8]; d.ldw = 1024; d.K = 512; d.ncols = 1024; wto = WS_WA; } \
        else if ((r -= I_A) < I_B) { d.W = p.in[12]; d.ldw = 1024; d.ncols = 1024; wto = WS_WB; } \
        else if ((r -= I_B) < I_O) { d.W = p.in[13]; d.ldw = 1024; d.ncols = 1024; wto = WS_WO; } \
        else if ((r -= I_O) < I_UP) { d.W = p.in[15]; d.ldw = 4096; d.ncols = 4096; wto = WS_WUP; d.ksc = p.in[14]; } \
        else if ((r -= I_UP) < I_DN) { d.W = p.in[16]; d.ldw = 1024; d.K = 4096; d.ncols = 1024; wto = WS_WDN; } \
        else if ((r -= I_DN) < I_PG) { d.W = p.in[18]; d.ldw = 1024; d.ncols = 1024; wto = WS_WPG; d.ksc = p.in[17]; } \
        else { r -= I_PG; d.W = p.in[19]; d.ldw = 1024; d.K = 256; d.ncols = 1024; wto = WS_WPP; } \
        d.r = r; d.WT = (bf16_t*)(ws + wto); } while (0)
    const int end = first + count;
    for (int it = first + w0; it < end; it += 2 * nw) {
        const int it1 = it + nw; const bool has1 = it1 < end;
        TrDesc d0, d1; TR_DECODE(d0, it); TR_DECODE(d1, has1 ? it1 : it);
        float a[32], b[32];
        tr_load(d0, a, lane); tr_load(d1, b, lane);
        tr_finish(d0, a, scr, lane);
        if (has1) tr_finish(d1, b, scr, lane);
    }
#undef TR_DECODE
}

__device__ __forceinline__ void phase_prologue(const Params& p, LAS unsigned char* lds) {
    int tid_ = threadIdx.x; asm volatile("" : "+v"(tid_)); const int tid = tid_, lane = tid & 63, wave = tid >> 6, G = gridDim.x;
    const int gw = blockIdx.x * 8 + wave, NGW = G * 8;
    const int gt = blockIdx.x * 512 + tid, NGT = G * 512;
    unsigned char* ws = p.ws;
    LAS float* scr = (LAS float*)(lds + wave * 16384);
    for (int i = gt; i < (int)(WS_ZERO_END / 4); i += NGT) ((float*)ws)[i] = 0.f;
    {
        const f32x4* gm = (const f32x4*)p.in[2] + lane;
        const f32x4 g0 = gm[0], g1 = gm[64], g2 = gm[128], g3 = gm[192];
        for (int m = gw; m < M; m += 4 * NGW) {
            f32x4 v[4][4]; int mr[4];
#pragma unroll
            for (int q = 0; q < 4; ++q) { mr[q] = m + q * NGW; const int ml = mr[q] < M ? mr[q] : m; const f32x4* xr = (const f32x4*)(p.in[0] + (size_t)ml * D) + lane;
                v[q][0] = xr[0]; v[q][1] = xr[64]; v[q][2] = xr[128]; v[q][3] = xr[192]; }
#pragma unroll
            for (int q = 0; q < 4; ++q) {
                float s = 0.f;
#pragma unroll
                for (int j = 0; j < 4; ++j) s += v[q][0][j] * v[q][0][j] + v[q][1][j] * v[q][1][j] + v[q][2][j] * v[q][2][j] + v[q][3][j] * v[q][3][j];
                const float rs = rsqrtf(wave_sum(s) * (1.f / 1024.f) + EPS);
                if (mr[q] < M) { u32x2* o = (u32x2*)(ws + WS_H + (size_t)mr[q] * 2048) + lane;
                    o[0] = pack4(v[q][0] * rs * g0); o[64] = pack4(v[q][1] * rs * g1); o[128] = pack4(v[q][2] * rs * g2); o[192] = pack4(v[q][3] * rs * g3); }
            }
        }
    }
    for (int i = gt; i < M * PLE / 8; i += 4 * NGT) {
        f32x4 a[4], b[4];
#pragma unroll
        for (int q = 0; q < 4; ++q) { const int iq = i + q * NGT, il = iq < M * PLE / 8 ? iq : i; a[q] = ((const f32x4*)p.in[1])[2 * il]; b[q] = ((const f32x4*)p.in[1])[2 * il + 1]; }
#pragma unroll
        for (int q = 0; q < 4; ++q) { const int iq = i + q * NGT; if (iq < M * PLE / 8) ((u32x4*)(ws + WS_PB))[iq] = pack8(a[q], b[q]); }
    }
    tr_run(p, scr, lane, 0, TR_EARLY, gw, NGW);
    { const int cw = gw - (NGW > 1280 ? 1024 : 0); for (int it = cw; it >= 0 && it < 256; it += NGW) comb_item(p.in[3], p.in[9], (bf16_t*)(ws + WS_WIN), scr, it, lane); }
    for (int i = gt; i < 4 * 128 * 128; i += NGT) { const int t = (i >> 7) & 127, s = i & 127; ((bf16_t*)(ws + WS_WSB))[i] = (bf16_t)(s <= t ? f2bf(p.in[6][i]) : 0u); }
}

struct SgRegs { u32x4 w[4], v[4]; float s1[4], s2[4]; };
__device__ __forceinline__ void sg_load(SgRegs& R, const Params& p, int item, int tid) {
    const int g = item & 3, chunk = item >> 2, m0 = chunk * 128, c0 = g * 128;
    const bf16_t* WSB = (const bf16_t*)(p.ws + WS_WSB) + g * 16384; const bf16_t* VSG = (const bf16_t*)(p.ws + WS_VSG); const float* vstat = (const float*)(p.ws + WS_VSTAT);
#pragma unroll
    for (int k = 0; k < 4; ++k) { const int e = tid + 512 * k, t = e >> 4, sv = (e & 15) * 8; R.w[k] = *(const u32x4*)(WSB + t * 128 + sv);
        const int m = m0 + t; R.v[k] = *(const u32x4*)(VSG + (size_t)m * 512 + c0 + sv); R.s1[k] = vstat[2 * m]; R.s2[k] = vstat[2 * m + 1]; }
}
__device__ __forceinline__ void sg_item(const Params& p, LAS unsigned char* lds, int item, SgRegs& C, int item_next, SgRegs& N) {
    int tid_ = threadIdx.x; asm volatile("" : "+v"(tid_)); const int tid = tid_, lane = tid & 63, w = tid >> 6, fr = lane & 15, fq = lane >> 4;
    const int g = item & 3, chunk = item >> 2, m0 = chunk * 128, c0 = g * 128;
    unsigned char* ws = p.ws;
    LAS bf16_t* VNT = (LAS bf16_t*)lds;
    LAS bf16_t* WL = (LAS bf16_t*)(lds + 34816);
    bf16_t* U = (bf16_t*)(ws + WS_U);
    const float* lng = p.in[4] + c0; const float* lnb = p.in[5] + c0;
    const int tt = w, t = 16 * tt + fr;
    u32x4 ur[4];
#pragma unroll
    for (int k = 0; k < 4; ++k) { const int e = tid + 512 * k; ur[k] = *(const u32x4*)(U + (size_t)(m0 + (e >> 4)) * 512 + c0 + (e & 15) * 8); }
    const float bias = p.in[7][g * 128 + t];
#pragma unroll
    for (int k = 0; k < 4; ++k) { const int e = tid + 512 * k, tr = e >> 4, sv = (e & 15) * 8; *(LAS u32x4*)(WL + tr * 136 + sv) = C.w[k]; }
#pragma unroll
    for (int k = 0; k < 4; ++k) {
        const int e = tid + 512 * k, sr = e >> 4, cv = (e & 15) * 8;
        f32x4 a, b; unpack8(C.v[k], a, b);
        const float mu = C.s1[k] * (1.f / 512.f), var = fmaxf(C.s2[k] * (1.f / 512.f) - mu * mu, 0.f), rs = rsqrtf(var + EPS);
        const f32x4 ga = *(const f32x4*)(lng + cv), gb = *(const f32x4*)(lng + cv + 4), ba = *(const f32x4*)(lnb + cv), bb = *(const f32x4*)(lnb + cv + 4);
        a = (a - mu) * rs * ga + ba; b = (b - mu) * rs * gb + bb;
        const int ssw = ((((sr >> 3) ^ ((cv >> 3) & 15)) << 3) + (sr & 7));
#pragma unroll
        for (int j = 0; j < 4; ++j) { VNT[(cv + j) * 136 + ssw] = (bf16_t)f2bf(a[j]); VNT[(cv + 4 + j) * 136 + ssw] = (bf16_t)f2bf(b[j]); }
    }
    if (item_next >= 0) sg_load(N, p, item_next, tid);
    lds_barrier();
    f32x4 acc[8];
#pragma unroll
    for (int tc = 0; tc < 8; ++tc) acc[tc] = (f32x4){0.f, 0.f, 0.f, 0.f};
    const int ksn = (tt >> 1) + 1;
    for (int ks = 0; ks < ksn; ++ks) {
        const bf16x8 bf = *(const LAS bf16x8*)(WL + (16 * tt + fr) * 136 + 32 * ks + 8 * fq);
#pragma unroll
        for (int tc = 0; tc < 8; ++tc) { const bf16x8 af = *(const LAS bf16x8*)(VNT + (16 * tc + fr) * 136 + (((4 * ks + fq) ^ (2 * tc + (fr >> 3))) << 3)); acc[tc] = __builtin_amdgcn_mfma_f32_16x16x32_bf16(af, bf, acc[tc], 0, 0, 0); }
    }
    lds_barrier();
    LAS float* ZS = (LAS float*)lds;
#pragma unroll
    for (int tc = 0; tc < 8; ++tc) *(LAS f32x4*)(ZS + t * 132 + 16 * tc + 4 * fq) = acc[tc] + bias;
    lds_barrier();
#pragma unroll
    for (int k = 0; k < 4; ++k) { const int e = tid + 512 * k, tr = e >> 4, cv = (e & 15) * 8;
        const f32x4 z0 = *(const LAS f32x4*)(ZS + tr * 132 + cv), z1 = *(const LAS f32x4*)(ZS + tr * 132 + cv + 4);
        f32x4 u0, u1; unpack8(ur[k], u0, u1);
        *(u32x4*)(U + (size_t)(m0 + tr) * 512 + c0 + cv) = pack8(u0 * z0, u1 * z1); }
    lds_barrier();
}

struct PrepRegs { u32x4 la[2], q[2], k[2]; };
__device__ __forceinline__ void prep_load(PrepRegs& R, const Params& p, int it, int tid) {
    const unsigned char* dob = (const unsigned char*)p.out;
    const bf16_t* Qg = (const bf16_t*)(dob + DO_Q) + (size_t)it * 8192; const bf16_t* Kg = (const bf16_t*)(dob + DO_K) + (size_t)it * 8192; const bf16_t* Lg = (const bf16_t*)(dob + DO_LA) + (size_t)it * 8192;
#pragma unroll
    for (int k = 0; k < 2; ++k) { const int e = tid + 512 * k; R.la[k] = *(const u32x4*)(Lg + (size_t)e * 8); R.q[k] = *(const u32x4*)(Qg + (size_t)e * 8); R.k[k] = *(const u32x4*)(Kg + (size_t)e * 8); }
}
__device__ __forceinline__ void gla_prep_item(const Params& p, LAS unsigned char* lds, int it, PrepRegs& C, int it_next, PrepRegs& N) {
    int tid_ = threadIdx.x; asm volatile("" : "+v"(tid_)); const int tid = tid_, lane = tid & 63, w = tid >> 6, fr = lane & 15, fq = lane >> 4;
    LAS float* BC = (LAS float*)lds;
    LAS bf16_t* QI = (LAS bf16_t*)(lds + 32768);
    LAS bf16_t* KI = (LAS bf16_t*)(lds + 32768 + 17408);
    LAS bf16_t* KDT = (LAS bf16_t*)(lds + 32768 + 2 * 17408);
    unsigned char* dob = (unsigned char*)p.out;
    bf16_t* Qg = (bf16_t*)(dob + DO_Q) + (size_t)it * 8192;
    bf16_t* Kg = (bf16_t*)(dob + DO_K) + (size_t)it * 8192;
    bf16_t* Lg = (bf16_t*)(dob + DO_LA) + (size_t)it * 8192;
#pragma unroll
    for (int k = 0; k < 2; ++k) { const int e = tid + 512 * k, i = e >> 4, dv = (e & 15) * 8; f32x4 a, b; unpack8(C.la[k], a, b);
        *(LAS f32x4*)(BC + i * 128 + dv) = a; *(LAS f32x4*)(BC + i * 128 + dv + 4) = b; }
    if (it_next >= 0) prep_load(N, p, it_next, tid);
    lds_barrier();
    { const int d = tid & 127, seg = tid >> 7; float cv_[16]; float run = 0.f;
      LAS float* TOT = (LAS float*)(lds + 86016);
#pragma unroll
      for (int r = 0; r < 16; ++r) cv_[r] = BC[(16 * seg + r) * 128 + d];
#pragma unroll
      for (int r = 0; r < 16; ++r) { run += cv_[r]; cv_[r] = run; }
      TOT[seg * 128 + d] = run;
      lds_barrier();
      float offs = 0.f;
#pragma unroll
      for (int s = 0; s < 3; ++s) if (s < seg) offs += TOT[s * 128 + d];
#pragma unroll
      for (int r = 0; r < 16; ++r) BC[(16 * seg + r) * 128 + d] = cv_[r] + offs;
    }
    lds_barrier();
#pragma unroll
    for (int k = 0; k < 2; ++k) {
        const int e = tid + 512 * k, i = e >> 4, dv = (e & 15) * 8;
        f32x4 q0, q1, k0, k1; unpack8(C.q[k], q0, q1); unpack8(C.k[k], k0, k1);
        f32x4 qd0, qd1, qi0, qi1, ki0, ki1;
        const f32x4 bi0 = *(const LAS f32x4*)(BC + i * 128 + dv), bi1 = *(const LAS f32x4*)(BC + i * 128 + dv + 4);
        const f32x4 br0 = *(const LAS f32x4*)(BC + 31 * 128 + dv), br1 = *(const LAS f32x4*)(BC + 31 * 128 + dv + 4);
        const f32x4 bl0 = *(const LAS f32x4*)(BC + 63 * 128 + dv), bl1 = *(const LAS f32x4*)(BC + 63 * 128 + dv + 4);
        const int isw = ((((i >> 3) ^ ((dv >> 3) & 7)) << 3) + (i & 7));
#pragma unroll
        for (int j = 0; j < 4; ++j) {
            { const int d = dv + j; const float bi = bi0[j], br = br0[j], bl = bl0[j];
              qd0[j] = q0[j] * __expf(bi); qi0[j] = q0[j] * __expf(bi - br); ki0[j] = k0[j] * __expf(br - bi); KDT[d * 72 + isw] = (bf16_t)f2bf(k0[j] * __expf(bl - bi)); }
            { const int d = dv + 4 + j; const float bi = bi1[j], br = br1[j], bl = bl1[j];
              qd1[j] = q1[j] * __expf(bi); qi1[j] = q1[j] * __expf(bi - br); ki1[j] = k1[j] * __expf(br - bi); KDT[d * 72 + isw] = (bf16_t)f2bf(k1[j] * __expf(bl - bi)); }
        }
        *(u32x4*)(Qg + i * 128 + dv) = pack8(qd0, qd1);
        *(LAS u32x4*)(QI + i * 136 + dv) = pack8(qi0, qi1);
        *(LAS u32x4*)(KI + i * 136 + dv) = pack8(ki0, ki1);
    }
    if (tid < 128) ((float*)Lg)[2048 + tid] = __expf(BC[63 * 128 + tid]);
    lds_barrier();
    { const int ti = w >> 1;
#pragma unroll
      for (int tjj = 0; tjj < 2; ++tjj) {
          const int tj = 2 * (w & 1) + tjj; f32x4 acc = (f32x4){0.f, 0.f, 0.f, 0.f};
#pragma unroll
          for (int ks = 0; ks < 4; ++ks) { const bf16x8 af = *(const LAS bf16x8*)(KI + (16 * tj + fr) * 136 + 32 * ks + 8 * fq), bf = *(const LAS bf16x8*)(QI + (16 * ti + fr) * 136 + 32 * ks + 8 * fq);
              acc = __builtin_amdgcn_mfma_f32_16x16x32_bf16(af, bf, acc, 0, 0, 0); }
          const int i = 16 * ti + fr, j0 = 16 * tj + 4 * fq;
#pragma unroll
          for (int r = 0; r < 4; ++r) if (j0 + r > i) acc[r] = 0.f;
          *(u32x2*)(Lg + i * 64 + j0) = pack4(acc);
      } }
#pragma unroll
    for (int k = 0; k < 2; ++k) { const int e = tid + 512 * k, d = e >> 3, jb = e & 7; *(u32x4*)(Kg + d * 64 + jb * 8) = *(const LAS u32x4*)(KDT + d * 72 + ((jb ^ ((d >> 3) & 7)) << 3)); }
    lds_barrier();
}

struct GlaRegs { u32x4 P, Q0, Q1, K0, K1, V; float D; };
__device__ __forceinline__ void gla_load(GlaRegs& R, const bf16_t* Qb, const bf16_t* Kb, const bf16_t* Lb, const bf16_t* Vb, int b, int h, int vs, int n, int tid) {
    const size_t ib = ((size_t)(b * 32 + n) * 4 + h) * 8192;
    R.P = *(const u32x4*)(Lb + ib + (size_t)tid * 8);
    R.Q0 = *(const u32x4*)(Qb + ib + (size_t)tid * 8); R.Q1 = *(const u32x4*)(Qb + ib + (size_t)(tid + 512) * 8);
    R.K0 = *(const u32x4*)(Kb + ib + (size_t)tid * 8); R.K1 = *(const u32x4*)(Kb + ib + (size_t)(tid + 512) * 8);
    if (tid < 256) R.V = *(const u32x4*)(Vb + (size_t)(b * 2048 + n * 64 + (tid >> 2)) * 1024 + h * 256 + vs * 32 + (tid & 3) * 8);
    if (tid < 128) R.D = ((const float*)(Lb + ib))[2048 + tid];
}
__device__ __forceinline__ void gla_fill(LAS unsigned char* B, const GlaRegs& C, int tid) {
    LAS bf16_t* PL = (LAS bf16_t*)B; LAS bf16_t* QD = (LAS bf16_t*)(B + 9216); LAS bf16_t* KD = (LAS bf16_t*)(B + 26624); LAS bf16_t* VT = (LAS bf16_t*)(B + 45056); LAS float* DC = (LAS float*)(B + 58368);
    *(LAS u32x4*)(PL + (tid >> 3) * 72 + (tid & 7) * 8) = C.P;
    *(LAS u32x4*)(QD + (tid >> 4) * 136 + (tid & 15) * 8) = C.Q0; *(LAS u32x4*)(QD + ((tid + 512) >> 4) * 136 + (tid & 15) * 8) = C.Q1;
    *(LAS u32x4*)(KD + (tid >> 3) * 72 + (tid & 7) * 8) = C.K0; *(LAS u32x4*)(KD + ((tid + 512) >> 3) * 72 + (tid & 7) * 8) = C.K1;
    if (tid < 256) { const int jr = tid >> 2, v0 = (tid & 3) * 8, j = (((jr >> 3) ^ (v0 >> 3)) << 3) + (jr & 7); const u32x4 rV = C.V;
        VT[(v0 + 0) * 72 + j] = (bf16_t)(rV.x & 0xffffu); VT[(v0 + 1) * 72 + j] = (bf16_t)(rV.x >> 16);
        VT[(v0 + 2) * 72 + j] = (bf16_t)(rV.y & 0xffffu); VT[(v0 + 3) * 72 + j] = (bf16_t)(rV.y >> 16);
        VT[(v0 + 4) * 72 + j] = (bf16_t)(rV.z & 0xffffu); VT[(v0 + 5) * 72 + j] = (bf16_t)(rV.z >> 16);
        VT[(v0 + 6) * 72 + j] = (bf16_t)(rV.w & 0xffffu); VT[(v0 + 7) * 72 + j] = (bf16_t)(rV.w >> 16); }
    if (tid < 128) DC[tid] = C.D;
}
__device__ __forceinline__ void gla_seq(const Params& p, LAS unsigned char* lds, int bh, int vs) {
    int tid_ = threadIdx.x; asm volatile("" : "+v"(tid_)); const int tid = tid_, lane = tid & 63, w = tid >> 6, fr = lane & 15, fq = lane >> 4;
    constexpr int SETB = 58880;
    const int b = bh >> 2, h = bh & 3;
    unsigned char* dob = (unsigned char*)p.out;
    const bf16_t* Qb = (const bf16_t*)(dob + DO_Q); const bf16_t* Kb = (const bf16_t*)(dob + DO_K); const bf16_t* Lb = (const bf16_t*)(dob + DO_LA);
    bf16_t* Vb = (bf16_t*)(p.ws + WS_V);
    float* gpart = (float*)(p.ws + WS_GPART);
    for (int e = tid; e < 32 * 136 / 2; e += 512) ((LAS unsigned*)(lds + 49664))[e] = 0u;
    f32x4 S[2]; S[0] = (f32x4){0.f, 0.f, 0.f, 0.f}; S[1] = S[0];
    GlaRegs R[2];
    R[0].V = (u32x4){0u, 0u, 0u, 0u}; R[1].V = R[0].V; R[0].D = 0.f; R[1].D = 0.f;
    gla_load(R[0], Qb, Kb, Lb, Vb, b, h, vs, 0, tid);
    gla_load(R[1], Qb, Kb, Lb, Vb, b, h, vs, 1, tid);
    gla_fill(lds, R[0], tid);
    gla_load(R[0], Qb, Kb, Lb, Vb, b, h, vs, 2, tid);
    lds_barrier();
    const int ti = w >> 1, tv = w & 1;
    for (int n2 = 0; n2 < 32; n2 += 2) {
#pragma unroll
        for (int u = 0; u < 2; ++u) {
            const int n = n2 + u;
            LAS unsigned char* Bc = lds + u * SETB; LAS unsigned char* Bn = lds + (u ^ 1) * SETB;
            if (n + 1 < 32) gla_fill(Bn, R[u ^ 1], tid);
            if (n + 3 < 32) gla_load(R[u ^ 1], Qb, Kb, Lb, Vb, b, h, vs, n + 3, tid);
            const LAS bf16_t* PL = (const LAS bf16_t*)Bc; const LAS bf16_t* QD = (const LAS bf16_t*)(Bc + 9216); const LAS bf16_t* KD = (const LAS bf16_t*)(Bc + 26624);
            const LAS bf16_t* VT = (const LAS bf16_t*)(Bc + 45056); const LAS bf16_t* ST = (const LAS bf16_t*)(Bc + 49664); const LAS float* DC = (const LAS float*)(Bc + 58368);
            f32x4 o = (f32x4){0.f, 0.f, 0.f, 0.f};
#pragma unroll
            for (int ks = 0; ks < 2; ++ks) { const bf16x8 af = *(const LAS bf16x8*)(VT + (16 * tv + fr) * 72 + (((4 * ks + fq) ^ (2 * tv + (fr >> 3))) << 3)), bf = *(const LAS bf16x8*)(PL + (16 * ti + fr) * 72 + 32 * ks + 8 * fq);
                o = __builtin_amdgcn_mfma_f32_16x16x32_bf16(af, bf, o, 0, 0, 0); }
#pragma unroll
            for (int ks = 0; ks < 4; ++ks) { const bf16x8 af = *(const LAS bf16x8*)(ST + (16 * tv + fr) * 136 + 32 * ks + 8 * fq), bf = *(const LAS bf16x8*)(QD + (16 * ti + fr) * 136 + 32 * ks + 8 * fq);
                o = __builtin_amdgcn_mfma_f32_16x16x32_bf16(af, bf, o, 0, 0, 0); }
            const f32x4 dec = *(const LAS f32x4*)(DC + 16 * w + 4 * fq);
#pragma unroll
            for (int tvv = 0; tvv < 2; ++tvv) { f32x4 kv = (f32x4){0.f, 0.f, 0.f, 0.f};
#pragma unroll
                for (int ks = 0; ks < 2; ++ks) { const bf16x8 af = *(const LAS bf16x8*)(KD + (16 * w + fr) * 72 + 32 * ks + 8 * fq), bf = *(const LAS bf16x8*)(VT + (16 * tvv + fr) * 72 + (((4 * ks + fq) ^ (2 * tvv + (fr >> 3))) << 3));
                    kv = __builtin_amdgcn_mfma_f32_16x16x32_bf16(af, bf, kv, 0, 0, 0); }
                S[tvv] = dec * S[tvv] + kv; }
            LAS bf16_t* STn = (LAS bf16_t*)(Bn + 49664);
#pragma unroll
            for (int tvv = 0; tvv < 2; ++tvv) *(LAS u32x2*)(STn + (16 * tvv + fr) * 136 + 16 * w + 4 * fq) = pack4(S[tvv]);
            const int m = b * 2048 + n * 64 + 16 * ti + fr;
            *(u32x2*)(Vb + (size_t)m * 1024 + h * 256 + vs * 32 + 16 * tv + 4 * fq) = pack4(o);
            float ss = o[0] * o[0] + o[1] * o[1] + o[2] * o[2] + o[3] * o[3];
            ss += __shfl_xor(ss, 16); ss += __shfl_xor(ss, 32);
            if (fq == 0) gpart[((size_t)bh * 2048 + n * 64 + 16 * ti + fr) * 16 + vs * 2 + tv] = ss;
            lds_barrier();
        }
    }
    __syncthreads();
}

__device__ __forceinline__ void gla_meet_arrive(const Params& p, int bh, bool same_xcd) {
    asm volatile("s_waitcnt vmcnt(0) lgkmcnt(0)" ::: "memory");
    __syncthreads();
    if (threadIdx.x == 0) {
        unsigned* c = (unsigned*)(p.ws + WS_BHC) + bh * 64;
        if (!same_xcd) { __builtin_amdgcn_fence(__ATOMIC_RELEASE, "agent"); asm volatile("s_waitcnt vmcnt(0)" ::: "memory"); }
        __hip_atomic_fetch_add(c, 1u, __ATOMIC_RELAXED, __HIP_MEMORY_SCOPE_AGENT);
    }
}
__device__ __forceinline__ void gla_norm_meet(const Params& p, int bh, int vs) {
    int tid_ = threadIdx.x; asm volatile("" : "+v"(tid_)); const int tid = tid_;
    const int b = bh >> 2, h = bh & 3;
    bf16_t* Vb = (bf16_t*)(p.ws + WS_V);
    const float* gpart = (const float*)(p.ws + WS_GPART);
    {
        if (tid == 0) {
            unsigned* c = (unsigned*)(p.ws + WS_BHC) + bh * 64;
            while (__hip_atomic_load(c, __ATOMIC_RELAXED, __HIP_MEMORY_SCOPE_AGENT) < 8u) __builtin_amdgcn_s_sleep(1);
            __builtin_amdgcn_fence(__ATOMIC_ACQUIRE, "agent");
            asm volatile("s_waitcnt vmcnt(0)" ::: "memory");
        }
        __syncthreads();
        const bf16_t* OGb = (const bf16_t*)(p.ws + WS_OG);
        const int cv = (tid & 31) * 8;
        const f32x4 n0 = *(const f32x4*)(p.in[11] + cv), n1 = *(const f32x4*)(p.in[11] + cv + 4);
#pragma unroll 4
        for (int r = tid >> 5; r < 256; r += 16) {
            const int row = vs * 256 + r, m = b * 2048 + row; const size_t off = (size_t)m * 1024 + h * 256 + cv;
            const f32x4* gp = (const f32x4*)(gpart + ((size_t)bh * 2048 + row) * 16);
            const f32x4 s4 = (gp[0] + gp[1]) + (gp[2] + gp[3]);
            const float rs = rsqrtf(((s4[0] + s4[1]) + (s4[2] + s4[3])) * (1.f / 256.f) + EPS);
            f32x4 o0, o1, g0, g1; unpack8(*(const u32x4*)(Vb + off), o0, o1); unpack8(*(const u32x4*)(OGb + off), g0, g1);
            *(u32x4*)(Vb + off) = pack8(o0 * rs * n0 * g0, o1 * rs * n1 * g1);
        }
    }
}

#define XB_TMO      128
#define XB_XCNT(j)  (256  + 64 * (j))
#define XB_XSUB(j)  (1280 + 64 * (j))
#define XB_XGEN(j)  (2304 + 64 * (j))
#define XB_TOP      3328
#define XB_TOPGEN   3392
#define XCD_BAR_WORDS 3456
#define XB_SPIN_CAP (1u << 18)

__device__ __forceinline__ unsigned xb_ld(unsigned* p)              { return __hip_atomic_load(p, __ATOMIC_RELAXED, __HIP_MEMORY_SCOPE_AGENT); }
__device__ __forceinline__ unsigned xb_add(unsigned* p, unsigned v) { return __hip_atomic_fetch_add(p, v, __ATOMIC_RELAXED, __HIP_MEMORY_SCOPE_AGENT); }
__device__ __forceinline__ unsigned xb_xcc_id() { return (unsigned)__builtin_amdgcn_s_getreg((3 << 11) | 20) & 0xFu; }
#define XB_SPIN(cond, bar) do { unsigned _sp = 0; while (cond) { __builtin_amdgcn_s_sleep(1); \
    if ((++_sp & 255u) == 0u) { if (xb_ld(&(bar)[XB_TMO])) break; if (_sp > XB_SPIN_CAP) { atomicAdd(&(bar)[XB_TMO], 1u); break; } } } } while (0)

struct XcdBarrier {
    unsigned* bar; unsigned x;
    volatile LAS unsigned* st;
};

__device__ __forceinline__ XcdBarrier xcd_barrier_post(unsigned* bar, volatile LAS unsigned* st) {
    XcdBarrier b; b.bar = bar; b.x = xb_xcc_id(); b.st = st;
    if (threadIdx.x == 0) (void)xb_add(&bar[XB_XCNT(b.x)], 1u);
    return b;
}
__device__ __forceinline__ void xcd_barrier_complete(unsigned* bar, unsigned x, unsigned& nloc, unsigned& nx) {
    const unsigned G = gridDim.x * gridDim.y * gridDim.z;
    unsigned sum, cnt, mine, sp = 0u;
    for (;;) {
        sum = 0u; cnt = 0u; mine = 0u;
#pragma unroll
        for (unsigned j = 0; j < 16; ++j) { const unsigned c = xb_ld(&bar[XB_XCNT(j)]); sum += c; cnt += (c > 0u) ? 1u : 0u; mine = (j == x) ? c : mine; }
        if (sum == G) break;
        __builtin_amdgcn_s_sleep(1);
        if ((++sp & 255u) == 0u) { if (xb_ld(&bar[XB_TMO])) break; if (sp > XB_SPIN_CAP) { atomicAdd(&bar[XB_TMO], 1u); break; } }
    }
    nloc = mine > 0u ? mine : 1u; nx = cnt > 0u ? cnt : 1u;
}

__device__ __forceinline__ void xcd_barrier(const XcdBarrier& b) {
    asm volatile("s_waitcnt vmcnt(0)" ::: "memory");
    __syncthreads();
    if (threadIdx.x == 0) {
        unsigned* bar = b.bar;
        __builtin_amdgcn_s_waitcnt(0);
        unsigned nloc = b.st[0], nx = b.st[1];
        if (nloc == 0u) { xcd_barrier_complete(bar, b.x, nloc, nx); b.st[0] = nloc; b.st[1] = nx; }
        const unsigned old = xb_add(&bar[XB_XSUB(b.x)], 1u);
        const unsigned gen = old / nloc;
        if (old + 1u == (gen + 1u) * nloc) {
            __builtin_amdgcn_fence(__ATOMIC_RELEASE, "agent");
            asm volatile("s_waitcnt vmcnt(0)" ::: "memory");
            const unsigned og = xb_add(&bar[XB_TOP], 1u);
            const unsigned tg = og / nx;
            if (og + 1u == (tg + 1u) * nx) xb_add(&bar[XB_TOPGEN], 1u);
            else XB_SPIN(xb_ld(&bar[XB_TOPGEN]) == tg, bar);
            __builtin_amdgcn_fence(__ATOMIC_ACQUIRE, "agent");
            xb_add(&bar[XB_XGEN(b.x)], 1u);
            asm volatile("s_waitcnt vmcnt(0)" ::: "memory");
        } else {
            XB_SPIN(xb_ld(&bar[XB_XGEN(b.x)]) == gen, bar);
            __builtin_amdgcn_fence(__ATOMIC_ACQUIRE, "agent");
            asm volatile("s_waitcnt vmcnt(0)" ::: "memory");
        }
    }
    __syncthreads();
}

__device__ __forceinline__ void grid_bar(unsigned* cnt, unsigned target) {
    asm volatile("s_waitcnt vmcnt(0) lgkmcnt(0)" ::: "memory");
    __syncthreads();
    if (threadIdx.x == 0) {
        __builtin_amdgcn_fence(__ATOMIC_RELEASE, "agent");
        asm volatile("s_waitcnt vmcnt(0)" ::: "memory");
        __hip_atomic_fetch_add(cnt, 1u, __ATOMIC_RELAXED, __HIP_MEMORY_SCOPE_AGENT);
        while (__hip_atomic_load(cnt, __ATOMIC_RELAXED, __HIP_MEMORY_SCOPE_AGENT) < target) __builtin_amdgcn_s_sleep(1);
        __builtin_amdgcn_fence(__ATOMIC_ACQUIRE, "agent");
        asm volatile("s_waitcnt vmcnt(0)" ::: "memory");
    }
    __syncthreads();
}
__device__ __forceinline__ void panel_meet(unsigned* cnt, bool same_xcd) {
    asm volatile("s_waitcnt vmcnt(0) lgkmcnt(0)" ::: "memory");
    __syncthreads();
    if (threadIdx.x == 0) {
        if (!same_xcd) { __builtin_amdgcn_fence(__ATOMIC_RELEASE, "agent"); asm volatile("s_waitcnt vmcnt(0)" ::: "memory"); }
        __hip_atomic_fetch_add(cnt, 1u, __ATOMIC_RELAXED, __HIP_MEMORY_SCOPE_AGENT);
        while (__hip_atomic_load(cnt, __ATOMIC_RELAXED, __HIP_MEMORY_SCOPE_AGENT) < 4u) __builtin_amdgcn_s_sleep(1);
        __builtin_amdgcn_fence(__ATOMIC_ACQUIRE, "agent");
        asm volatile("s_waitcnt vmcnt(0)" ::: "memory");
    }
    __syncthreads();
}
__global__ void __launch_bounds__(512, 2) mk_fwd(Params p) {
    extern __shared__ __attribute__((aligned(16))) unsigned char lds_raw[];
    LAS unsigned char* lds = (LAS unsigned char*)lds_raw;
    cg::grid_group grid = cg::this_grid();
    unsigned char* ws = p.ws; unsigned char* dob = (unsigned char*)p.out;
    const int G = gridDim.x;
    if (threadIdx.x < 2) ((volatile LAS unsigned*)(lds + 131072 + 512))[threadIdx.x] = 0u;
    __syncthreads();
#ifndef MK_PHASE_MASK
#define MK_PHASE_MASK 0x7ff
#endif
#define IN(k) ((((MK_PHASE_MASK) >> (k)) & 1) != 0)
#define GBAR() xcd_barrier(xbar)
#ifndef MK_DELAY_MASK
#define MK_DELAY_MASK 0
#endif
    unsigned long long t_ph = 0;
#define TBEG() do { if (MK_DELAY_MASK) t_ph = __builtin_amdgcn_s_memrealtime(); } while (0)
#define TEND(k) do { if ((MK_DELAY_MASK >> (k)) & 1) { const unsigned long long t1_ = __builtin_amdgcn_s_memrealtime(), dt_ = t1_ - t_ph; while (__builtin_amdgcn_s_memrealtime() - t1_ < dt_) __builtin_amdgcn_s_sleep(8); __syncthreads(); } } while (0)
    const unsigned long long t_k0 = MK_DELAY_MASK ? __builtin_amdgcn_s_memrealtime() : 0ull;
    for (int i = blockIdx.x * 512 + threadIdx.x; i < 4096; i += G * 512) ((unsigned*)(ws + WS_XBAR))[i] = 0u;
    grid.sync();
    XcdBarrier xbar = xcd_barrier_post((unsigned*)(ws + WS_XBAR), (volatile LAS unsigned*)(lds + 131072 + 512));
    const bool chain = (G == 256);
    int my_pm = 0; { pg8::StaticOrder S0; S0.init(M, 1024, G, (int)blockIdx.x); pg8::Unit u0; if (S0.next(0, u0)) my_pm = u0.pm; }
    unsigned* pmask = (unsigned*)(ws + WS_XBAR) + 3584 + my_pm;
    if (chain && threadIdx.x == 0) __hip_atomic_fetch_or(pmask, 1u << xb_xcc_id(), __ATOMIC_RELAXED, __HIP_MEMORY_SCOPE_AGENT);
    const int my_it = blockIdx.x, my_b = my_it & 7, my_bh = 4 * my_b + ((my_it >> 3) & 3), my_vs = (my_it >> 5) & 7;
    unsigned* bmask0 = (unsigned*)(ws + WS_XBAR) + 3584 + 128;
    if (chain && threadIdx.x == 0) __hip_atomic_fetch_or(bmask0 + my_b, 1u << xb_xcc_id(), __ATOMIC_RELAXED, __HIP_MEMORY_SCOPE_AGENT);
    unsigned* bhmask = (unsigned*)(ws + WS_XBAR) + 3584 + 64 + (my_bh & 31);
    if (G >= 256 && my_it < 256 && threadIdx.x == 0) __hip_atomic_fetch_or(bhmask, 1u << xb_xcc_id(), __ATOMIC_RELAXED, __HIP_MEMORY_SCOPE_AGENT);
    TBEG();
    if (IN(0)) phase_prologue(p, lds);
    GBAR();
    TEND(0);
    TBEG();
    if (IN(1)) {
        EpiIn E{(bf16_t*)(ws + WS_U), (bf16_t*)(ws + WS_VSG), (bf16_t*)(dob + DO_Q), (bf16_t*)(dob + DO_K), (bf16_t*)(ws + WS_V), (bf16_t*)(dob + DO_LA),
                (bf16_t*)(ws + WS_OG), (bf16_t*)(ws + WS_BGA), (bf16_t*)(ws + WS_BGB), (float*)(ws + WS_VSTAT), p.in[10]};
        run_gemm(lds, (const bf16_t*)(ws + WS_H), (const bf16_t*)(ws + WS_WIN), NIN, 1024, E);
        { const int nwg = (M / 256) * (NIN / 256), rem = nwg % G, c = blockIdx.x; const bool light = rem == 0 || c >= rem; const int nlight = rem == 0 ? G : G - rem, li = rem == 0 ? c : c - rem;
          if (light) { int tid_ = threadIdx.x; asm volatile("" : "+v"(tid_)); const int wv = tid_ >> 6;
              tr_run(p, (LAS float*)(lds + wv * 16384), tid_ & 63, TR_EARLY, TR_ALL - TR_EARLY, li * 8 + wv, nlight * 8); } }
    }
    GBAR();
    TEND(1);
    TBEG();
    if (IN(2)) {
        int tid = threadIdx.x; asm volatile("" : "+v"(tid));
        { PrepRegs A, B; if ((int)blockIdx.x < 1024) prep_load(A, p, blockIdx.x, tid);
          for (int it = blockIdx.x; it < 1024; it += G) { const int itn = it + G < 1024 ? it + G : -1; gla_prep_item(p, lds, it, A, itn, B); A = B; } }
        { SgRegs A, B; if ((int)blockIdx.x < 512) sg_load(A, p, blockIdx.x, tid);
          for (int it = blockIdx.x; it < 512; it += G) { const int itn = it + G < 512 ? it + G : -1; sg_item(p, lds, it, A, itn, B); A = B; } }
    }
    GBAR();
    TEND(2);
    TBEG();
    const bool fuse_norm = (G >= 256);
    bool fuse35 = chain && fuse_norm;
    if (fuse35) { unsigned ok = 1u;
#pragma unroll
        for (int j = 0; j < 8; ++j) ok &= (__builtin_popcount(__hip_atomic_load(bmask0 + j, __ATOMIC_RELAXED, __HIP_MEMORY_SCOPE_AGENT)) == 1) ? 1u : 0u;
        fuse35 = ok != 0u; }
    if (IN(3)) {
        for (int it = blockIdx.x; it < 256; it += G) gla_seq(p, lds, 4 * (it & 7) + ((it >> 3) & 3), (it >> 5) & 7);
        TEND(11); TBEG();
        if (fuse_norm && my_it < 256) { const bool bh_same = __builtin_popcount(__hip_atomic_load(bhmask, __ATOMIC_RELAXED, __HIP_MEMORY_SCOPE_AGENT)) == 1; gla_meet_arrive(p, my_bh, bh_same); }
        EpiMerge<false> E{(bf16_t*)(ws + WS_H), (const bf16_t*)(ws + WS_BGA)};
        run_gemm(lds, (const bf16_t*)(ws + WS_U), (const bf16_t*)(ws + WS_WA), 1024, 512, E);
        TEND(13); TBEG();
        if (fuse_norm && my_it < 256) gla_norm_meet(p, my_bh, my_vs);
        TEND(12); TBEG();
    }
    if (fuse35) {
        asm volatile("s_waitcnt vmcnt(0) lgkmcnt(0)" ::: "memory");
        __syncthreads();
        if (threadIdx.x == 0) __hip_atomic_fetch_add((unsigned*)(ws + WS_P35) + (8 * my_b + my_vs) * 16, 1u, __ATOMIC_RELAXED, __HIP_MEMORY_SCOPE_AGENT);
    } else GBAR();
    TEND(3);
    if (!fuse_norm) {
        int tid = threadIdx.x; asm volatile("" : "+v"(tid));
        for (int e = blockIdx.x * 512 + tid; e < M * 128; e += G * 512) {
            const int m = e >> 7, c = (e & 127) * 8, h = c >> 8;
            const f32x4* gp = (const f32x4*)((const float*)(ws + WS_GPART) + ((size_t)((m >> 11) * 4 + h) * 2048 + (m & 2047)) * 16);
            const f32x4 s4 = (gp[0] + gp[1]) + (gp[2] + gp[3]);
            const float rs = rsqrtf(((s4[0] + s4[1]) + (s4[2] + s4[3])) * (1.f / 256.f) + EPS);
            f32x4 o0, o1, g0, g1; unpack8(*(const u32x4*)((bf16_t*)(ws + WS_V) + (size_t)e * 8), o0, o1); unpack8(*(const u32x4*)((const bf16_t*)(ws + WS_OG) + (size_t)e * 8), g0, g1);
            const f32x4 n0 = *(const f32x4*)(p.in[11] + (c & 255)), n1 = *(const f32x4*)(p.in[11] + (c & 255) + 4);
            *(u32x4*)((bf16_t*)(ws + WS_V) + (size_t)e * 8) = pack8(o0 * rs * n0 * g0, o1 * rs * n1 * g1);
        }
        GBAR();
    }
    TBEG();
    const bool same_xcd = chain && __builtin_popcount(__hip_atomic_load(pmask, __ATOMIC_RELAXED, __HIP_MEMORY_SCOPE_AGENT)) == 1;
#define PSEAM(k) do { if (chain) panel_meet((unsigned*)(ws + WS_PCNT) + ((k) * 64 + my_pm) * 32, same_xcd); else GBAR(); } while (0)
    if (fuse35) {
        if (threadIdx.x == 0) { unsigned* c35 = (unsigned*)(ws + WS_P35) + my_pm * 16;
            while (__hip_atomic_load(c35, __ATOMIC_RELAXED, __HIP_MEMORY_SCOPE_AGENT) < 4u) __builtin_amdgcn_s_sleep(1);
            __builtin_amdgcn_fence(__ATOMIC_ACQUIRE, "agent"); asm volatile("s_waitcnt vmcnt(0)" ::: "memory"); }
        __syncthreads();
    }
    if (IN(5)) {
        EpiMerge<true> E{(bf16_t*)(ws + WS_H), (const bf16_t*)(ws + WS_BGB)};
        run_gemm(lds, (const bf16_t*)(ws + WS_V), (const bf16_t*)(ws + WS_WB), 1024, 1024, E);
    }
    PSEAM(3);
    if (chain && threadIdx.x == 0) __hip_atomic_fetch_add((unsigned*)(ws + WS_BAR), 1u, __ATOMIC_RELAXED, __HIP_MEMORY_SCOPE_AGENT);
    TEND(5);
    TBEG();
    if (IN(6)) {
        EpiRes<false> E{p.in[0], (bf16_t*)(ws + WS_XB), (float*)(ws + WS_RSS2)};
        run_gemm(lds, (const bf16_t*)(ws + WS_H), (const bf16_t*)(ws + WS_WO), 1024, 1024, E);
    }
    PSEAM(0);
    TEND(6);
    TBEG();
    if (chain) { if (threadIdx.x == 0) { while (__hip_atomic_load((unsigned*)(ws + WS_BAR), __ATOMIC_RELAXED, __HIP_MEMORY_SCOPE_AGENT) < (unsigned)G) __builtin_amdgcn_s_sleep(1); } __syncthreads(); }
    if (IN(7)) {
        EpiUp E{(bf16_t*)(ws + WS_UP), (const float*)(ws + WS_RSS2)};
        run_gemm(lds, (const bf16_t*)(ws + WS_XB), (const bf16_t*)(ws + WS_WUP), FF, 1024, E);
    }
    PSEAM(1);
    TEND(7);
    TBEG();
    if (IN(8)) {
        EpiRes<true> E{nullptr, (bf16_t*)(ws + WS_XB), (float*)(ws + WS_RSS3)};
        run_gemm(lds, (const bf16_t*)(ws + WS_UP), (const bf16_t*)(ws + WS_WDN), 1024, FF, E);
        EpiPlain E2{(bf16_t*)(ws + WS_H)};
        run_gemm(lds, (const bf16_t*)(ws + WS_PB), (const bf16_t*)(ws + WS_WPP), 1024, PLE, E2);
    }
    PSEAM(2);
    TEND(8);
    TBEG();
    const bool fuse_final = (G == 256);
    TBEG();
    if (IN(9)) {
        if (fuse_final) {
            EpiPleFinal E{p.out, (const bf16_t*)(ws + WS_XB), (const bf16_t*)(ws + WS_H), (const float*)(ws + WS_RSS3), (float*)(ws + WS_RSS4), (unsigned*)(ws + WS_PCNT) + 4 * 64 * 32, p.in[20], same_xcd};
            run_gemm<EpiPleFinal, false>(lds, (const bf16_t*)(ws + WS_XB), (const bf16_t*)(ws + WS_WPG), 1024, 1024, E);
        } else {
            EpiPleGate E{p.out, (const bf16_t*)(ws + WS_XB), (const bf16_t*)(ws + WS_H), (const float*)(ws + WS_RSS3), (float*)(ws + WS_RSS4)};
            run_gemm(lds, (const bf16_t*)(ws + WS_XB), (const bf16_t*)(ws + WS_WPG), 1024, 1024, E);
        }
    }
    if (!fuse_final) {
        GBAR();
        const float* rss4 = (const float*)(ws + WS_RSS4);
        int tid = threadIdx.x; asm volatile("" : "+v"(tid));
        for (int e = blockIdx.x * 512 + tid; e < M * 256; e += G * 512) {
            const int m = e >> 8, c = (e & 255) * 4;
            const float rs = rsqrtf(rss4[m] * (1.f / 1024.f) + EPS);
            const f32x4 v = *(const f32x4*)(p.out + (size_t)e * 4), g = *(const f32x4*)(p.in[20] + c);
            *(f32x4*)(p.out + (size_t)e * 4) = v * rs * g;
        }
    }
    if ((MK_DELAY_MASK >> 10) & 1) { asm volatile("s_waitcnt vmcnt(0)" ::: "memory"); __syncthreads(); }
    TEND(9);
    if ((MK_DELAY_MASK >> 14) & 1) { asm volatile("s_waitcnt vmcnt(0)" ::: "memory"); __syncthreads(); t_ph = t_k0; }
    TEND(14);
#undef IN
#undef GBAR
#undef PSEAM
}
}

extern "C" void kernel_launch(void* const* d_in, const int* in_sizes, int n_in, void* d_out, int out_size, void* d_ws, size_t ws_size, hipStream_t stream) {
    static int grid = 0;
    if (grid == 0) {
        if (n_in != 21 || out_size != mk::M * mk::D || ws_size < mk::WS_END) { fprintf(stderr, "kernel_launch: unexpected shapes (n_in %d out %d ws %zu)\n", n_in, out_size, ws_size); grid = -1; return; }
        int dev = 0, cus = 0, per_cu = 0;
        if (hipGetDevice(&dev) != hipSuccess || hipDeviceGetAttribute(&cus, hipDeviceAttributeMultiprocessorCount, dev) != hipSuccess) { grid = -1; return; }
        if (hipFuncSetAttribute((const void*)mk::mk_fwd, hipFuncAttributeMaxDynamicSharedMemorySize, mk::LDS_BYTES) != hipSuccess) { fprintf(stderr, "kernel_launch: hipFuncSetAttribute failed\n"); grid = -1; return; }
        if (hipOccupancyMaxActiveBlocksPerMultiprocessor(&per_cu, (const void*)mk::mk_fwd, 512, mk::LDS_BYTES) != hipSuccess || per_cu < 1) { fprintf(stderr, "kernel_launch: occupancy query says %d\n", per_cu); per_cu = 1; }
        (void)hipGetLastError();
        grid = cus * per_cu;
    }
    if (grid < 0) return;
    mk::Params p{};
    for (int i = 0; i < 21; ++i) p.in[i] = (const float*)d_in[i];
    p.out = (float*)d_out; p.ws = (unsigned char*)d_ws;
    void* args[] = {&p};
    hipError_t e = hipLaunchCooperativeKernel((const void*)mk::mk_fwd, dim3(grid), dim3(512), args, mk::LDS_BYTES, stream);
    if (e != hipSuccess) fprintf(stderr, "kernel_launch: cooperative launch failed: %s (grid %d)\n", hipGetErrorString(e), grid);

}
```

```cpp
#include <hip/hip_runtime.h>
#include <hip/hip_cooperative_groups.h>
#include <cstdio>
#include <cstdint>
namespace cg = cooperative_groups;
namespace pg8 {
#define PG8_LAS __attribute__((address_space(3)))
typedef unsigned short bf16_t;
typedef short bf16x8 __attribute__((ext_vector_type(8)));
typedef float f32x4 __attribute__((ext_vector_type(4)));
typedef unsigned u32x4 __attribute__((ext_vector_type(4)));
constexpr int BM = 256, BK = 64, HALF = 128, HTB = HALF * BK * 2  , STAGE_BYTES = 8 * HTB, NXCD = 8, WGM = 8;

__host__ __device__ __forceinline__ int lds_byte(int r, int c) { const int st = (r >> 4) * 2 + (c >> 5), rr = r & 15, cc = c & 31, ob = rr * 64 + cc * 2; return st * 1024 + (ob ^ (((ob >> 9) & 1) << 5)); }
__host__ __device__ __forceinline__ void stage_rc(int b, int& R, int& C) { const int st = b / 1024, sb = b % 1024, swz = sb ^ (((sb >> 9) & 1) << 5); R = (st >> 1) * 16 + swz / 64; C = (st & 1) * 32 + (swz % 64) / 2; }
__host__ __device__ __forceinline__ int perm32(int rho) { const int n = rho >> 4, i = rho & 15; return 8 * (i >> 2) + 4 * n + (i & 3); }

struct Unit { int pm, pn; };
struct Gemm { const bf16_t* A; const bf16_t* Bt; int M, N, K; };

struct StaticOrder {
    int nM, nN, nwg, G, c;
    __host__ __device__ void init(int M, int N, int G_, int c_) { nM = M / BM; nN = N / BM; nwg = nM * nN; G = G_; c = c_; }
    __host__ __device__ bool next(int i, Unit& u) const {
        const long L = (long)i * G + c; if (L >= nwg) return false;
        int wgid = (int)L; { const int q = nwg / NXCD, r = nwg % NXCD, xcd = wgid % NXCD, off = wgid / NXCD; wgid = (xcd < r ? xcd * (q + 1) : r * (q + 1) + (xcd - r) * q) + off; }
        const int nig = WGM * nN, gid = wgid / nig, fm = gid * WGM, gsz = (nM - fm) < WGM ? (nM - fm) : WGM;
        u.pm = fm + ((wgid % nig) % gsz); u.pn = (wgid % nig) / gsz; return true;
    }
    __device__ __forceinline__ void a_ready(const Unit&) const {}
    __device__ __forceinline__ void done(const Unit&) const {}
};
typedef float f32x2 __attribute__((ext_vector_type(2)));
typedef __bf16 bf16x2_t __attribute__((ext_vector_type(2)));
__device__ __forceinline__ unsigned cvt_pk_bf16(float lo, float hi) { f32x2 v = {lo, hi}; bf16x2_t b = __builtin_convertvector(v, bf16x2_t); return __builtin_bit_cast(unsigned, b); }
template <class Epi, class Sched, bool ALIGN_EPI = false, bool SP2 = false>
__device__ __forceinline__ void gemm_phase(PG8_LAS unsigned char* lds, const Gemm g, const Sched& S, const Epi& E) {
    int tid_ = threadIdx.x; asm volatile("" : "+v"(tid_));
    const int tid = tid_, wid = __builtin_amdgcn_readfirstlane(tid >> 6), lane = tid & 63, wr = wid >> 2, wc = wid & 3, fr = lane & 15, fq = lane >> 4;
    const int K = g.K, nt = K / BK;
    unsigned voffA[2], voffB[2];
#pragma unroll
    for (int i = 0; i < 2; ++i) { int R, C; stage_rc(tid * 16 + i * 8192, R, C); const int Rb = Epi::PERM ? ((R & ~31) + perm32(R & 31)) : R;
        voffA[i] = (unsigned)(R * K + C) * 2u; voffB[i] = (unsigned)(Rb * K + C) * 2u; }
    const size_t kstep = (size_t)(BK * 2);
    const size_t hstep = (size_t)HALF * K * 2;
    const size_t tstep = 2 * hstep;
    const unsigned ldsw = (unsigned)wid * 1024u;
    const int aoff = lds_byte(wr * 64 + fr, fq * 8), boff = lds_byte(wc * 32 + fr, fq * 8);
#define PG8_SA(b, h) (((b) * 2 + (h)) * HTB)
#define PG8_SB(b, h) ((4 + (b) * 2 + (h)) * HTB)
#define PG8_STAGE(bufoff, gbase, voff) do { _Pragma("unroll") for (int _i = 0; _i < 2; ++_i) \
        __builtin_amdgcn_global_load_lds((const unsigned*)((const char*)(gbase) + (voff)[_i]), (PG8_LAS unsigned*)(lds + (bufoff) + ldsw + _i * 8192), 16, 0, 0); } while (0)
#define PG8_LDA(dst, b, h) do { _Pragma("unroll") for (int m = 0; m < 4; ++m) _Pragma("unroll") for (int k = 0; k < 2; ++k) dst[m][k] = *(const PG8_LAS bf16x8*)(lds + PG8_SA(b, h) + aoff + m * 2048 + k * 1024); } while (0)
#define PG8_LDB(dst, b, h) do { _Pragma("unroll") for (int n = 0; n < 2; ++n) _Pragma("unroll") for (int k = 0; k < 2; ++k) dst[n][k] = *(const PG8_LAS bf16x8*)(lds + PG8_SB(b, h) + boff + n * 2048 + k * 1024); } while (0)
#define PG8_MMA(ai, bj, At, Bt) do { __builtin_amdgcn_s_setprio(1); _Pragma("unroll") for (int m = 0; m < 4; ++m) _Pragma("unroll") for (int n = 0; n < 2; ++n) _Pragma("unroll") for (int k = 0; k < 2; ++k) \
        acc[ai][bj][m][n] = __builtin_amdgcn_mfma_f32_16x16x32_bf16(Bt[n][k], At[m][k], acc[ai][bj][m][n], 0, 0, 0); __builtin_amdgcn_s_setprio(0); } while (0)
#define PG8_WAIT_V(n) asm volatile("s_waitcnt vmcnt(" #n ")" ::: "memory")
#define PG8_WAIT_L(n) asm volatile("s_waitcnt lgkmcnt(" #n ")" ::: "memory")
#define PG8_BAR __builtin_amdgcn_s_barrier()
#define PG8_SCHED __builtin_amdgcn_sched_barrier(0)
    Unit cur, nxt; int ui = 0;
    if (!S.next(0, cur)) return;
    f32x4 acc[2][2][4][2];
#pragma unroll
    for (int a = 0; a < 2; ++a)
#pragma unroll
        for (int b = 0; b < 2; ++b)
#pragma unroll
            for (int m = 0; m < 4; ++m)
#pragma unroll
                for (int n = 0; n < 2; ++n) acc[a][b][m][n] = (f32x4){0.f, 0.f, 0.f, 0.f};
    bf16x8 At[4][2], B0[2][2], B1[2][2];
    const char* cA = (const char*)g.A + (size_t)cur.pm * tstep; const char* cB = (const char*)g.Bt + (size_t)cur.pn * tstep;
    S.a_ready(cur);
    if constexpr (SP2) {
        PG8_STAGE(PG8_SB(0, 0), cB, voffB); PG8_STAGE(PG8_SB(0, 1), cB + hstep, voffB); PG8_STAGE(PG8_SA(0, 0), cA, voffA); PG8_STAGE(PG8_SA(0, 1), cA + hstep, voffA);
        if (wr == 1) PG8_BAR;
        PG8_WAIT_V(2); PG8_BAR;
        PG8_STAGE(PG8_SB(1, 0), cB + kstep, voffB); PG8_STAGE(PG8_SA(1, 0), cA + kstep, voffA); PG8_STAGE(PG8_SB(1, 1), cB + hstep + kstep, voffB);
        PG8_WAIT_V(6); PG8_BAR;
    } else {
        PG8_STAGE(PG8_SB(0, 0), cB, voffB); PG8_STAGE(PG8_SA(0, 0), cA, voffA); PG8_STAGE(PG8_SB(0, 1), cB + hstep, voffB); PG8_STAGE(PG8_SA(0, 1), cA + hstep, voffA);
        if (wr == 1) PG8_BAR;
        PG8_WAIT_V(4); PG8_BAR;
        PG8_STAGE(PG8_SB(1, 0), cB + kstep, voffB); PG8_STAGE(PG8_SA(1, 0), cA + kstep, voffA); PG8_STAGE(PG8_SB(1, 1), cB + hstep + kstep, voffB);
        PG8_WAIT_V(6); PG8_BAR;
    }
    for (;;) {
        const bool has_next = S.next(ui + 1, nxt);
        const char* nA = has_next ? (const char*)g.A + (size_t)nxt.pm * tstep : cA; const char* nB = has_next ? (const char*)g.Bt + (size_t)nxt.pn * tstep : cB;
        for (int t = 0; t < nt; t += 2) {
            const bool last = (t == nt - 2);
            const char* a1 = cA + (size_t)(t + 1) * kstep;
            const char* a2 = last ? nA : cA + (size_t)(t + 2) * kstep; const char* b2 = last ? nB : cB + (size_t)(t + 2) * kstep;
            const char* a3 = a2 + kstep; const char* b3 = b2 + kstep;
            if (last && has_next) S.a_ready(nxt);
            if constexpr (SP2) {
            PG8_LDB(B0, 0, 0); PG8_LDB(B1, 0, 1); PG8_SCHED; PG8_LDA(At, 0, 0); PG8_STAGE(PG8_SA(1, 1), a1 + hstep, voffA);
            PG8_WAIT_V(8); PG8_WAIT_L(0); PG8_BAR; PG8_MMA(0, 0, At, B0); PG8_MMA(0, 1, At, B1); PG8_BAR; PG8_SCHED;
            PG8_LDA(At, 0, 1); PG8_STAGE(PG8_SB(0, 0), b2, voffB); PG8_STAGE(PG8_SB(0, 1), b2 + hstep, voffB); PG8_STAGE(PG8_SA(0, 0), a2, voffA);
            PG8_WAIT_V(8); PG8_WAIT_L(0); PG8_BAR; PG8_MMA(1, 0, At, B0); PG8_MMA(1, 1, At, B1); PG8_BAR; PG8_SCHED;
            PG8_LDB(B0, 1, 0); PG8_LDB(B1, 1, 1); PG8_SCHED; PG8_LDA(At, 1, 0); PG8_STAGE(PG8_SA(0, 1), a2 + hstep, voffA);
            PG8_WAIT_V(8); PG8_WAIT_L(0); PG8_BAR; PG8_MMA(0, 0, At, B0); PG8_MMA(0, 1, At, B1); PG8_BAR; PG8_SCHED;
            PG8_LDA(At, 1, 1); PG8_STAGE(PG8_SB(1, 0), b3, voffB); PG8_STAGE(PG8_SB(1, 1), b3 + hstep, voffB); PG8_STAGE(PG8_SA(1, 0), a3, voffA);
            PG8_WAIT_V(8); PG8_WAIT_L(0); PG8_BAR; PG8_MMA(1, 0, At, B0); PG8_MMA(1, 1, At, B1); PG8_BAR; PG8_SCHED;
            } else {
            PG8_LDB(B0, 0, 0); PG8_SCHED; PG8_LDA(At, 0, 0); PG8_STAGE(PG8_SA(1, 1), a1 + hstep, voffA);
            PG8_WAIT_L(8); PG8_BAR; PG8_WAIT_L(0); PG8_MMA(0, 0, At, B0); PG8_BAR; PG8_SCHED;
            PG8_LDB(B1, 0, 1); PG8_STAGE(PG8_SB(0, 0), b2, voffB);
            PG8_BAR; PG8_WAIT_L(0); PG8_MMA(0, 1, At, B1); PG8_BAR;
            PG8_LDA(At, 0, 1); PG8_STAGE(PG8_SA(0, 0), a2, voffA);
            PG8_BAR; PG8_WAIT_L(0); PG8_MMA(1, 0, At, B0); PG8_BAR; PG8_SCHED;
            PG8_STAGE(PG8_SB(0, 1), b2 + hstep, voffB);
            PG8_WAIT_V(6); PG8_BAR; PG8_MMA(1, 1, At, B1); PG8_BAR;
            PG8_LDB(B0, 1, 0); PG8_SCHED; PG8_LDA(At, 1, 0); PG8_STAGE(PG8_SA(0, 1), a2 + hstep, voffA);
            PG8_WAIT_L(8); PG8_BAR; PG8_WAIT_L(0); PG8_MMA(0, 0, At, B0); PG8_BAR; PG8_SCHED;
            PG8_LDB(B1, 1, 1); PG8_STAGE(PG8_SB(1, 0), b3, voffB);
            PG8_BAR; PG8_WAIT_L(0); PG8_MMA(0, 1, At, B1); PG8_BAR;
            PG8_LDA(At, 1, 1); PG8_STAGE(PG8_SA(1, 0), a3, voffA);
            PG8_BAR; PG8_WAIT_L(0); PG8_MMA(1, 0, At, B0); PG8_BAR; PG8_SCHED;
            PG8_STAGE(PG8_SB(1, 1), b3 + hstep, voffB);
            PG8_WAIT_V(6); PG8_BAR; PG8_MMA(1, 1, At, B1); PG8_BAR;
            }
        }
        if constexpr (ALIGN_EPI) { if (wr == 0) PG8_BAR; }
        if constexpr (!Epi::AFTER_DRAIN) { E(acc, cur, wr, wc, fr, fq); S.done(cur); }
        if (!has_next) break;
#pragma unroll
        for (int a = 0; a < 2; ++a)
#pragma unroll
            for (int b = 0; b < 2; ++b)
#pragma unroll
                for (int m = 0; m < 4; ++m)
#pragma unroll
                    for (int n = 0; n < 2; ++n) acc[a][b][m][n] = (f32x4){0.f, 0.f, 0.f, 0.f};
        cur = nxt; cA = nA; cB = nB; ++ui;
        if constexpr (ALIGN_EPI) { if (wr == 1) PG8_BAR; }
    }
    PG8_WAIT_V(0);
    if constexpr (!ALIGN_EPI) { if (wr == 0) PG8_BAR; }
    PG8_BAR;
    if constexpr (Epi::AFTER_DRAIN) { E.fused(acc, cur, wr, wc, fr, fq, lds, wid, lane); S.done(cur); }
#undef PG8_SA
#undef PG8_SB
#undef PG8_STAGE
#undef PG8_LDA
#undef PG8_LDB
#undef PG8_MMA
#undef PG8_WAIT_V
#undef PG8_WAIT_L
#undef PG8_BAR
#undef PG8_SCHED
}
}

#define LAS __attribute__((address_space(3)))
namespace mk {
using pg8::bf16_t; using pg8::bf16x8; using pg8::f32x4; using pg8::u32x4; using pg8::Unit;
typedef unsigned u32x2 __attribute__((ext_vector_type(2)));

constexpr int M = 16384, D = 1024, SEQ = 2048, FF = 4096, PLE = 256, NIN = 6656;
constexpr float EPS = 1e-6f;
constexpr size_t MiB = 1u << 20;
constexpr size_t WS_VSTAT = 0;
constexpr size_t WS_RSS2 = 128 * 1024;
constexpr size_t WS_RSS3 = 192 * 1024;
constexpr size_t WS_RSS4 = 256 * 1024;
constexpr size_t WS_RGLA = 320 * 1024;
constexpr size_t WS_BAR = 576 * 1024;
constexpr size_t WS_BHC = 576 * 1024 + 256;
constexpr size_t WS_P35 = 576 * 1024 + 256 + 8192;
constexpr size_t WS_PCNT = 592 * 1024;
constexpr size_t WS_ZERO_END = 640 * 1024;
constexpr size_t WS_XBAR = 640 * 1024;
constexpr size_t WS_WSB = 1 * MiB;
constexpr size_t WS_WIN = 2 * MiB;
constexpr size_t WS_WA = 15 * MiB;
constexpr size_t WS_WB = 16 * MiB;
constexpr size_t WS_WO = 18 * MiB;
constexpr size_t WS_WUP = 20 * MiB;
constexpr size_t WS_WDN = 28 * MiB;
constexpr size_t WS_WPG = 36 * MiB;
constexpr size_t WS_WPP = 38 * MiB;
constexpr size_t WS_PB = 39 * MiB;
constexpr size_t WS_H = 47 * MiB;
constexpr size_t WS_U = 79 * MiB;
constexpr size_t WS_VSG = 95 * MiB;
constexpr size_t WS_V = 111 * MiB;
constexpr size_t WS_OG = 143 * MiB;
constexpr size_t WS_BGA = 175 * MiB;
constexpr size_t WS_BGB = 207 * MiB;
constexpr size_t WS_UP = 79 * MiB;
constexpr size_t WS_XB = 207 * MiB;
constexpr size_t WS_GPART = 239 * MiB;
constexpr size_t WS_END = 243 * MiB;
constexpr size_t DO_Q = 0, DO_K = 16 * MiB, DO_LA = 32 * MiB;

constexpr int LDS_BYTES = 147456;

struct Params { const float* in[21]; float* out; unsigned char* ws; };

__device__ __forceinline__ unsigned f2bf(float f) { unsigned u = __builtin_bit_cast(unsigned, f); return (u + 0x7fffu + ((u >> 16) & 1u)) >> 16; }
__device__ __forceinline__ unsigned pk2(float lo, float hi) { return pg8::cvt_pk_bf16(lo, hi); }
__device__ __forceinline__ float bf_lo(unsigned u) { return __uint_as_float(u << 16); }
__device__ __forceinline__ float bf_hi(unsigned u) { return __uint_as_float(u & 0xffff0000u); }
__device__ __forceinline__ u32x4 pack8(f32x4 a, f32x4 b) { u32x4 w; w.x = pk2(a[0], a[1]); w.y = pk2(a[2], a[3]); w.z = pk2(b[0], b[1]); w.w = pk2(b[2], b[3]); return w; }
__device__ __forceinline__ u32x2 pack4(f32x4 a) { u32x2 w; w.x = pk2(a[0], a[1]); w.y = pk2(a[2], a[3]); return w; }
__device__ __forceinline__ void unpack8(u32x4 w, f32x4& a, f32x4& b) { a[0] = bf_lo(w.x); a[1] = bf_hi(w.x); a[2] = bf_lo(w.y); a[3] = bf_hi(w.y); b[0] = bf_lo(w.z); b[1] = bf_hi(w.z); b[2] = bf_lo(w.w); b[3] = bf_hi(w.w); }
__device__ __forceinline__ f32x4 unpack4(u32x2 w) { f32x4 a; a[0] = bf_lo(w.x); a[1] = bf_hi(w.x); a[2] = bf_lo(w.y); a[3] = bf_hi(w.y); return a; }
__device__ __forceinline__ float sigmoid_f(float x) { return __builtin_amdgcn_rcpf(1.f + __expf(-x)); }
__device__ __forceinline__ float gelu_f(float x) { const float t = 1.5957691216057308f * (x + 0.044715f * x * x * x); return x * sigmoid_f(t); }
__device__ __forceinline__ float silu_f(float x) { return x * sigmoid_f(x); }
__device__ __forceinline__ float logsig_f(float x) { return fminf(x, 0.f) - __logf(1.f + __expf(-fabsf(x))); }
__device__ __forceinline__ float wave_sum(float v) {
#pragma unroll
    for (int o = 1; o < 64; o <<= 1) v += __shfl_xor(v, o);
    return v;
}
__device__ __forceinline__ void atomic_add_agent(float* p, float v) { (void)__hip_atomic_fetch_add(p, v, __ATOMIC_RELAXED, __HIP_MEMORY_SCOPE_AGENT); }
__device__ __forceinline__ void lds_barrier() { asm volatile("s_waitcnt lgkmcnt(0)" ::: "memory"); __builtin_amdgcn_s_barrier(); asm volatile("" ::: "memory"); }
#define LDS_WAIT() asm volatile("s_waitcnt lgkmcnt(0)" ::: "memory")

enum { ACT_NONE = 0, ACT_GELU, ACT_SILU, ACT_SIGM, ACT_SCALE, ACT_LOGSIG };
enum { LAY_512 = 0, LAY_1024, LAY_BLK };
template <int ACT> __device__ __forceinline__ float act1(float x) {
    if (ACT == ACT_GELU) return gelu_f(x);
    if (ACT == ACT_SILU) return silu_f(x);
    if (ACT == ACT_SIGM) return sigmoid_f(x);
    if (ACT == ACT_SCALE) return x * 0.08838834764831845f;
    if (ACT == ACT_LOGSIG) return logsig_f(x) * 0.0625f;
    return x;
}
struct EpiIn {
    static constexpr bool PERM = true, AFTER_DRAIN = false;
    bf16_t *U, *VSG, *Q, *K, *V, *LA, *OG, *BGA, *BGB; float* vstat; const float* bgate;
    template <int ACT, int LAY, bool STATS, bool BIAS> __device__ __forceinline__ void run(const f32x4 (&acc)[2][2][4][2], bf16_t* base, int rowb, int colb, int fq) const {
        f32x4 b0[2], b1[2];
#pragma unroll
        for (int bj = 0; bj < 2; ++bj) { if (BIAS) { b0[bj] = *(const f32x4*)(bgate + colb + bj * 128); b1[bj] = *(const f32x4*)(bgate + colb + bj * 128 + 4); } else { b0[bj] = (f32x4){0.f, 0.f, 0.f, 0.f}; b1[bj] = b0[bj]; } }
#pragma unroll
        for (int ai = 0; ai < 2; ++ai)
#pragma unroll
            for (int m = 0; m < 4; ++m) {
                const int row = rowb + ai * 128 + m * 16; float s1 = 0.f, s2 = 0.f;
#pragma unroll
                for (int bj = 0; bj < 2; ++bj) {
                    const int col = colb + bj * 128; f32x4 v0 = acc[ai][bj][m][0] + b0[bj], v1 = acc[ai][bj][m][1] + b1[bj];
#pragma unroll
                    for (int j = 0; j < 4; ++j) { v0[j] = act1<ACT>(v0[j]); v1[j] = act1<ACT>(v1[j]); }
                    const u32x4 w = pack8(v0, v1);
                    if (STATS) { f32x4 r0, r1; unpack8(w, r0, r1);
#pragma unroll
                        for (int j = 0; j < 4; ++j) { s1 += r0[j] + r1[j]; s2 += r0[j] * r0[j] + r1[j] * r1[j]; } }
                    size_t off;
                    if (LAY == LAY_512) off = (size_t)row * 512 + col;
                    else if (LAY == LAY_1024) off = (size_t)row * 1024 + col;
                    else off = ((size_t)(row >> 6) * 4 + (col >> 7)) * 8192 + (size_t)(row & 63) * 128 + (col & 127);
                    *(u32x4*)(base + off) = w;
                }
                asm volatile("" ::: "memory");
                if (STATS) { s1 += __shfl_xor(s1, 16); s1 += __shfl_xor(s1, 32); s2 += __shfl_xor(s2, 16); s2 += __shfl_xor(s2, 32);
                    if (fq == 0) { atomic_add_agent(vstat + 2 * row, s1); atomic_add_agent(vstat + 2 * row + 1, s2); } }
            }
    }
    __device__ __forceinline__ void operator()(const f32x4 (&acc)[2][2][4][2], const Unit& u, int wr, int wc, int fr, int fq) const {
        const int rowb = u.pm * 256 + wr * 64 + fr, cw = wc * 32 + 8 * fq, pn = u.pn;
        if (pn < 2) run<ACT_GELU, LAY_512, false, false>(acc, U, rowb, pn * 256 + cw, fq);
        else if (pn < 4) run<ACT_GELU, LAY_512, true, false>(acc, VSG, rowb, (pn - 2) * 256 + cw, fq);
        else if (pn < 6) run<ACT_SCALE, LAY_BLK, false, false>(acc, Q, rowb, (pn - 4) * 256 + cw, fq);
        else if (pn < 8) run<ACT_NONE, LAY_BLK, false, false>(acc, K, rowb, (pn - 6) * 256 + cw, fq);
        else if (pn < 12) run<ACT_NONE, LAY_1024, false, false>(acc, V, rowb, (pn - 8) * 256 + cw, fq);
        else if (pn < 14) run<ACT_LOGSIG, LAY_BLK, false, true>(acc, LA, rowb, (pn - 12) * 256 + cw, fq);
        else if (pn < 18) run<ACT_SILU, LAY_1024, false, false>(acc, OG, rowb, (pn - 14) * 256 + cw, fq);
        else if (pn < 22) run<ACT_SIGM, LAY_1024, false, false>(acc, BGA, rowb, (pn - 18) * 256 + cw, fq);
        else run<ACT_SIGM, LAY_1024, false, false>(acc, BGB, rowb, (pn - 22) * 256 + cw, fq);
    }
};
template <bool ACCUM> struct EpiMerge {
    static constexpr bool PERM = true, AFTER_DRAIN = false;
    bf16_t* MG; const bf16_t* G;
    __device__ __forceinline__ void operator()(const f32x4 (&acc)[2][2][4][2], const Unit& u, int wr, int wc, int fr, int fq) const {
        const int rowb = u.pm * 256 + wr * 64 + fr, colb = u.pn * 256 + wc * 32 + 8 * fq;
#pragma unroll
        for (int ai = 0; ai < 2; ++ai)
#pragma unroll
            for (int m = 0; m < 4; ++m)
#pragma unroll
                for (int bj = 0; bj < 2; ++bj) {
                    const size_t off = (size_t)(rowb + ai * 128 + m * 16) * 1024 + colb + bj * 128;
                    f32x4 g0, g1; unpack8(*(const u32x4*)(G + off), g0, g1);
                    f32x4 v0 = acc[ai][bj][m][0] * g0, v1 = acc[ai][bj][m][1] * g1;
                    if (ACCUM) { f32x4 p0, p1; unpack8(*(const u32x4*)(MG + off), p0, p1); v0 += p0; v1 += p1; }
                    *(u32x4*)(MG + off) = pack8(v0, v1);
                    asm volatile("" ::: "memory");
                }
    }
};
template <bool BF16_BASE> struct EpiRes {
    static constexpr bool PERM = true, AFTER_DRAIN = false;
    const float* base; bf16_t* xb; float* rss;
    __device__ __forceinline__ void operator()(const f32x4 (&acc)[2][2][4][2], const Unit& u, int wr, int wc, int fr, int fq) const {
        const int rowb = u.pm * 256 + wr * 64 + fr, colb = u.pn * 256 + wc * 32 + 8 * fq;
#pragma unroll
        for (int ai = 0; ai < 2; ++ai)
#pragma unroll
            for (int m = 0; m < 4; ++m) {
                const int row = rowb + ai * 128 + m * 16; float ss = 0.f;
#pragma unroll
                for (int bj = 0; bj < 2; ++bj) {
                    const size_t off = (size_t)row * 1024 + colb + bj * 128;
                    f32x4 v0, v1;
                    if (BF16_BASE) unpack8(*(const u32x4*)(xb + off), v0, v1); else { v0 = *(const f32x4*)(base + off); v1 = *(const f32x4*)(base + off + 4); }
                    v0 += acc[ai][bj][m][0]; v1 += acc[ai][bj][m][1];
                    *(u32x4*)(xb + off) = pack8(v0, v1);
#pragma unroll
                    for (int j = 0; j < 4; ++j) ss += v0[j] * v0[j] + v1[j] * v1[j];
                }
                ss += __shfl_xor(ss, 16); ss += __shfl_xor(ss, 32);
                if (fq == 0) atomic_add_agent(rss + row, ss);
                asm volatile("" ::: "memory");
            }
    }
};
struct EpiUp {
    static constexpr bool PERM = true, AFTER_DRAIN = false;
    bf16_t* UPB; const float* rss;
    __device__ __forceinline__ void operator()(const f32x4 (&acc)[2][2][4][2], const Unit& u, int wr, int wc, int fr, int fq) const {
        const int rowb = u.pm * 256 + wr * 64 + fr, colb = u.pn * 256 + wc * 32 + 8 * fq;
#pragma unroll
        for (int ai = 0; ai < 2; ++ai)
#pragma unroll
            for (int m = 0; m < 4; ++m) {
                const int row = rowb + ai * 128 + m * 16; const float rs = rsqrtf(rss[row] * (1.f / 1024.f) + EPS);
#pragma unroll
                for (int bj = 0; bj < 2; ++bj) {
                    f32x4 v0 = acc[ai][bj][m][0] * rs, v1 = acc[ai][bj][m][1] * rs;
#pragma unroll
                    for (int j = 0; j < 4; ++j) { const float a = fmaxf(v0[j], 0.f), b = fmaxf(v1[j], 0.f); v0[j] = a * a; v1[j] = b * b; }
                    *(u32x4*)(UPB + (size_t)row * 4096 + colb + bj * 128) = pack8(v0, v1);
                }
                asm volatile("" ::: "memory");
            }
    }
};
struct EpiPlain {
    static constexpr bool PERM = true, AFTER_DRAIN = false;
    bf16_t* O;
    __device__ __forceinline__ void operator()(const f32x4 (&acc)[2][2][4][2], const Unit& u, int wr, int wc, int fr, int fq) const {
        const int rowb = u.pm * 256 + wr * 64 + fr, colb = u.pn * 256 + wc * 32 + 8 * fq;
#pragma unroll
        for (int ai = 0; ai < 2; ++ai)
#pragma unroll
            for (int m = 0; m < 4; ++m)
#pragma unroll
                for (int bj = 0; bj < 2; ++bj)
                    *(u32x4*)(O + (size_t)(rowb + ai * 128 + m * 16) * 1024 + colb + bj * 128) = pack8(acc[ai][bj][m][0], acc[ai][bj][m][1]);
    }
};
struct EpiPleGate {
    static constexpr bool PERM = true, AFTER_DRAIN = false;
    float* x; const bf16_t* xb; const bf16_t* PLEB; const float* rss_in; float* rss_out;
    __device__ __forceinline__ void operator()(const f32x4 (&acc)[2][2][4][2], const Unit& u, int wr, int wc, int fr, int fq) const {
        const int rowb = u.pm * 256 + wr * 64 + fr, colb = u.pn * 256 + wc * 32 + 8 * fq;
#pragma unroll
        for (int ai = 0; ai < 2; ++ai)
#pragma unroll
            for (int m = 0; m < 4; ++m) {
                const int row = rowb + ai * 128 + m * 16; const float rs = rsqrtf(rss_in[row] * (1.f / 1024.f) + EPS); float ss = 0.f;
#pragma unroll
                for (int bj = 0; bj < 2; ++bj) {
                    const size_t off = (size_t)row * 1024 + colb + bj * 128;
                    f32x4 p0, p1; unpack8(*(const u32x4*)(PLEB + off), p0, p1);
                    f32x4 v0, v1; unpack8(*(const u32x4*)(xb + off), v0, v1);
#pragma unroll
                    for (int j = 0; j < 4; ++j) { v0[j] += sigmoid_f(acc[ai][bj][m][0][j] * rs) * p0[j]; v1[j] += sigmoid_f(acc[ai][bj][m][1][j] * rs) * p1[j]; ss += v0[j] * v0[j] + v1[j] * v1[j]; }
                    *(f32x4*)(x + off) = v0; *(f32x4*)(x + off + 4) = v1;
                }
                ss += __shfl_xor(ss, 16); ss += __shfl_xor(ss, 32);
                if (fq == 0) atomic_add_agent(rss_out + row, ss);
                asm volatile("" ::: "memory");
            }
    }
};

struct EpiPleFinal {
    static constexpr bool PERM = true, AFTER_DRAIN = true;
    float* out; const bf16_t* xb; const bf16_t* PLEB; const float* rss_in; float* rss_out; unsigned* pcnt; const float* gfin; bool same_xcd;
    __device__ __forceinline__ void fused(f32x4 (&acc)[2][2][4][2], const Unit& u, int wr, int wc, int fr, int fq, PG8_LAS unsigned char* lds, int wid, int lane) const {
        const int rowb = u.pm * 256 + wr * 64 + fr, colb = u.pn * 256 + wc * 32 + 8 * fq;
#pragma unroll
        for (int ai = 0; ai < 2; ++ai)
#pragma unroll
            for (int m = 0; m < 4; ++m) {
                const int row = rowb + ai * 128 + m * 16; const float rs = rsqrtf(rss_in[row] * (1.f / 1024.f) + EPS); float ss = 0.f;
#pragma unroll
                for (int bj = 0; bj < 2; ++bj) {
                    const size_t off = (size_t)row * 1024 + colb + bj * 128;
                    f32x4 p0, p1; unpack8(*(const u32x4*)(PLEB + off), p0, p1);
                    f32x4 v0, v1; unpack8(*(const u32x4*)(xb + off), v0, v1);
#pragma unroll
                    for (int j = 0; j < 4; ++j) { v0[j] += sigmoid_f(acc[ai][bj][m][0][j] * rs) * p0[j]; v1[j] += sigmoid_f(acc[ai][bj][m][1][j] * rs) * p1[j]; ss += v0[j] * v0[j] + v1[j] * v1[j]; }
                    acc[ai][bj][m][0] = v0; acc[ai][bj][m][1] = v1;
                }
                ss += __shfl_xor(ss, 16); ss += __shfl_xor(ss, 32);
                if (fq == 0) atomic_add_agent(rss_out + row, ss);
                asm volatile("" ::: "memory");
            }
        asm volatile("s_waitcnt vmcnt(0)" ::: "memory");
        __syncthreads();
        if (wid == 0 && lane == 0) {
            unsigned* c = pcnt + 32 * u.pm;
            if (!same_xcd) { __builtin_amdgcn_fence(__ATOMIC_RELEASE, "agent"); asm volatile("s_waitcnt vmcnt(0)" ::: "memory"); }
            __hip_atomic_fetch_add(c, 1u, __ATOMIC_RELAXED, __HIP_MEMORY_SCOPE_AGENT);
            while (__hip_atomic_load(c, __ATOMIC_RELAXED, __HIP_MEMORY_SCOPE_AGENT) < 4u) __builtin_amdgcn_s_sleep(1);
            __builtin_amdgcn_fence(__ATOMIC_ACQUIRE, "agent"); asm volatile("s_waitcnt vmcnt(0)" ::: "memory");
        }
        __syncthreads();
        f32x4 g0[2], g1[2];
#pragma unroll
        for (int bj = 0; bj < 2; ++bj) { g0[bj] = *(const f32x4*)(gfin + colb + bj * 128); g1[bj] = *(const f32x4*)(gfin + colb + bj * 128 + 4); }
        float rf[2][4];
#pragma unroll
        for (int ai = 0; ai < 2; ++ai)
#pragma unroll
            for (int m = 0; m < 4; ++m) rf[ai][m] = __hip_atomic_load(rss_out + rowb + ai * 128 + m * 16, __ATOMIC_RELAXED, __HIP_MEMORY_SCOPE_AGENT);
        const int tid = wid * 64 + lane;
#pragma unroll
        for (int ai = 0; ai < 2; ++ai) {
#pragma unroll
            for (int m = 0; m < 4; ++m) {
                const float rs = rsqrtf(rf[ai][m] * (1.f / 1024.f) + EPS);
                const int rowl = wr * 64 + m * 16 + fr;
#pragma unroll
                for (int bj = 0; bj < 2; ++bj) {
                    const int c = bj * 32 + wc * 8 + 2 * fq;
                    *(PG8_LAS f32x4*)(lds + rowl * 1024 + (((c) ^ (rowl & 63)) << 4)) = acc[ai][bj][m][0] * rs * g0[bj];
                    *(PG8_LAS f32x4*)(lds + rowl * 1024 + (((c + 1) ^ (rowl & 63)) << 4)) = acc[ai][bj][m][1] * rs * g1[bj];
                }
            }
            lds_barrier();
#pragma unroll
            for (int k = 0; k < 16; ++k) { const int e = tid + 512 * k, rowl = e >> 6, c = e & 63;
                const f32x4 v = *(const PG8_LAS f32x4*)(lds + rowl * 1024 + ((c ^ (rowl & 63)) << 4));
                *(f32x4*)(out + (size_t)(u.pm * 256 + ai * 128 + rowl) * 1024 + u.pn * 256 + c * 4) = v; }
            lds_barrier();
        }
    }
};

template <class Epi, bool ALIGN = true> __device__ __forceinline__ void run_gemm(LAS unsigned char* lds, const bf16_t* A, const bf16_t* Bt, int N, int K, const Epi& E) {
    asm volatile("" : "+s"(K));
    pg8::Gemm g{A, Bt, M, N, K}; pg8::StaticOrder S; S.init(M, N, (int)gridDim.x, (int)blockIdx.x);
    pg8::gemm_phase<Epi, pg8::StaticOrder, ALIGN, true>(lds, g, S, E);
}

struct TrDesc { const float* W; const float* ksc; bf16_t* WT; int ldw, K, ncols, row_off, r; };
__device__ __forceinline__ void tr_load(const TrDesc& d, float (&wv)[32], int lane) {
    const int nblk = d.ncols / 32, kb = d.r / nblk, nb = d.r % nblk, k0 = 64 * kb, n0 = 32 * nb;
#pragma unroll
    for (int i = 0; i < 32; ++i) wv[i] = __builtin_nontemporal_load(d.W + (size_t)(k0 + 2 * i + (lane >> 5)) * d.ldw + n0 + (lane & 31));
}
__device__ __forceinline__ void tr_finish(const TrDesc& d, float (&wv)[32], LAS float* scr, int lane) {
    const int nblk = d.ncols / 32, kb = d.r / nblk, nb = d.r % nblk, k0 = 64 * kb, n0 = 32 * nb;
    if (d.ksc) {
#pragma unroll
        for (int i = 0; i < 32; ++i) wv[i] *= d.ksc[k0 + 2 * i + (lane >> 5)];
    }
#pragma unroll
    for (int i = 0; i < 32; ++i) scr[(2 * i + (lane >> 5)) * 33 + (lane & 31)] = wv[i];
    LDS_WAIT();
    const int c = lane & 7;
#pragma unroll
    for (int j = 0; j < 4; ++j) { const int n = (lane >> 3) + 8 * j; const LAS float* s = scr + (8 * c) * 33 + n;
        u32x4 o; o.x = pk2(s[0 * 33], s[1 * 33]); o.y = pk2(s[2 * 33], s[3 * 33]); o.z = pk2(s[4 * 33], s[5 * 33]); o.w = pk2(s[6 * 33], s[7 * 33]);
        *(u32x4*)(d.WT + (size_t)(d.row_off + n0 + n) * d.K + k0 + 8 * c) = o; }
    LDS_WAIT();
}
__device__ __forceinline__ void comb_item(const float* Win, const float* Wgu, bf16_t* WT, LAS float* scr, int item, int lane) {
    const int nblk = 512 / 32, kb = item / nblk, nb = item % nblk, k0 = 64 * kb, n0 = 32 * nb;
    float g[16];
#pragma unroll
    for (int r = 0; r < 16; ++r) g[r] = Wgu[r * 512 + n0 + (lane & 31)];
#pragma unroll 8
    for (int i = 0; i < 32; ++i) { const int kk = 2 * i + (lane >> 5); const f32x4* wr_ = (const f32x4*)(Win + (size_t)(k0 + kk) * 6160 + 3072);
        const f32x4 a = wr_[0], b = wr_[1], c = wr_[2], d = wr_[3]; float s = 0.f;
#pragma unroll
        for (int r = 0; r < 4; ++r) s += a[r] * g[r] + b[r] * g[4 + r] + c[r] * g[8 + r] + d[r] * g[12 + r];
        scr[kk * 33 + (lane & 31)] = s; }
    LDS_WAIT();
    const int c = lane & 7;
#pragma unroll
    for (int j = 0; j < 4; ++j) { const int n = (lane >> 3) + 8 * j; const LAS float* s = scr + (8 * c) * 33 + n;
        u32x4 o; o.x = pk2(s[0 * 33], s[1 * 33]); o.y = pk2(s[2 * 33], s[3 * 33]); o.z = pk2(s[4 * 33], s[5 * 33]); o.w = pk2(s[6 * 33], s[7 * 33]);
        *(u32x4*)(WT + (size_t)(3072 + n0 + n) * 1024 + k0 + 8 * c) = o; }
    LDS_WAIT();
}

constexpr int I_IN1 = 16 * 96, I_IN2 = 16 * 96, I_A = 8 * 32, I_B = 16 * 32, I_O = 16 * 32, I_UP = 16 * 128, I_DN = 64 * 32, I_PG = 16 * 32, I_PP = 4 * 32;
constexpr int TR_EARLY = I_IN1 + I_IN2, TR_ALL = I_IN1 + I_IN2 + I_A + I_B + I_O + I_UP + I_DN + I_PG + I_PP;
__device__ __forceinline__ void tr_run(const Params& p, LAS float* scr, int lane, int first, int count, int w0, int nw) {
    unsigned char* ws = p.ws;
#define TR_DECODE(d, it_) do { int r = (it_); d.W = p.in[3]; d.ksc = nullptr; d.ldw = 6160; d.K = 1024; d.ncols = 3072; d.row_off = 0; size_t wto = WS_WIN; \
        if (r < I_IN1) { } \
        else if ((r -= I_IN1) < I_IN2) { d.W = p.in[3] + 3088; d.row_off = 3584; } \
        else if ((r -= I_IN2) < I_A) { d.W = p.in[8]; d.ldw = 1024; d.K = 512; d.ncols = 1024; wto = WS_WA; } \
        else if ((r -= I_A) < I_B) { d.W = p.in[12]; d.ldw = 1024; d.ncols = 1024; wto = WS_WB; } \
        else if ((r -= I_B) < I_O) { d.W = p.in[13]; d.ldw = 1024; d.ncols = 1024; wto = WS_WO; } \
        else if ((r -= I_O) < I_UP) { d.W = p.in[15]; d.ldw = 4096; d.ncols = 4096; wto = WS_WUP; d.ksc = p.in[14]; } \
        else if ((r -= I_UP) < I_DN) { d.W = p.in[16]; d.ldw = 1024; d.K = 4096; d.ncols = 1024; wto = WS_WDN; } \
        else if ((r -= I_DN) < I_PG) { d.W = p.in[18]; d.ldw = 1024; d.ncols = 1024; wto = WS_WPG; d.ksc = p.in[17]; } \
        else { r -= I_PG; d.W = p.in[19]; d.ldw = 1024; d.K = 256; d.ncols = 1024; wto = WS_WPP; } \
        d.r = r; d.WT = (bf16_t*)(ws + wto); } while (0)
    const int end = first + count;
    for (int it = first + w0; it < end; it += 2 * nw) {
        const int it1 = it + nw; const bool has1 = it1 < end;
        TrDesc d0, d1; TR_DECODE(d0, it); TR_DECODE(d1, has1 ? it1 : it);
        float a[32], b[32];
        tr_load(d0, a, lane); tr_load(d1, b, lane);
        tr_finish(d0, a, scr, lane);
        if (has1) tr_finish(d1, b, scr, lane);
    }
#undef TR_DECODE
}

__device__ __forceinline__ void phase_prologue(const Params& p, LAS unsigned char* lds) {
    int tid_ = threadIdx.x; asm volatile("" : "+v"(tid_)); const int tid = tid_, lane = tid & 63, wave = tid >> 6, G = gridDim.x;
    const int gw = blockIdx.x * 8 + wave, NGW = G * 8;
    const int gt = blockIdx.x * 512 + tid, NGT = G * 512;
    unsigned char* ws = p.ws;
    LAS float* scr = (LAS float*)(lds + wave * 16384);
    for (int i = gt; i < (int)(WS_ZERO_END / 4); i += NGT) ((float*)ws)[i] = 0.f;
    {
        const f32x4* gm = (const f32x4*)p.in[2] + lane;
        const f32x4 g0 = gm[0], g1 = gm[64], g2 = gm[128], g3 = gm[192];
        for (int m = gw; m < M; m += 4 * NGW) {
            f32x4 v[4][4]; int mr[4];
#pragma unroll
            for (int q = 0; q < 4; ++q) { mr[q] = m + q * NGW; const int ml = mr[q] < M ? mr[q] : m; const f32x4* xr = (const f32x4*)(p.in[0] + (size_t)ml * D) + lane;
                v[q][0] = xr[0]; v[q][1] = xr[64]; v[q][2] = xr[128]; v[q][3] = xr[192]; }
#pragma unroll
            for (int q = 0; q < 4; ++q) {
                float s = 0.f;
#pragma unroll
                for (int j = 0; j < 4; ++j) s += v[q][0][j] * v[q][0][j] + v[q][1][j] * v[q][1][j] + v[q][2][j] * v[q][2][j] + v[q][3][j] * v[q][3][j];
                const float rs = rsqrtf(wave_sum(s) * (1.f / 1024.f) + EPS);
                if (mr[q] < M) { u32x2* o = (u32x2*)(ws + WS_H + (size_t)mr[q] * 2048) + lane;
                    o[0] = pack4(v[q][0] * rs * g0); o[64] = pack4(v[q][1] * rs * g1); o[128] = pack4(v[q][2] * rs * g2); o[192] = pack4(v[q][3] * rs * g3); }
            }
        }
    }
    for (int i = gt; i < M * PLE / 8; i += 4 * NGT) {
        f32x4 a[4], b[4];
#pragma unroll
        for (int q = 0; q < 4; ++q) { const int iq = i + q * NGT, il = iq < M * PLE / 8 ? iq : i; a[q] = __builtin_nontemporal_load((const f32x4*)p.in[1] + 2 * il); b[q] = __builtin_nontemporal_load((const f32x4*)p.in[1] + 2 * il + 1); }
#pragma unroll
        for (int q = 0; q < 4; ++q) { const int iq = i + q * NGT; if (iq < M * PLE / 8) ((u32x4*)(ws + WS_PB))[iq] = pack8(a[q], b[q]); }
    }
    tr_run(p, scr, lane, 0, TR_EARLY, gw, NGW);
    { const int cw = gw - (NGW > 1280 ? 1024 : 0); for (int it = cw; it >= 0 && it < 256; it += NGW) comb_item(p.in[3], p.in[9], (bf16_t*)(ws + WS_WIN), scr, it, lane); }
    for (int i = gt; i < 4 * 128 * 128; i += NGT) { const int t = (i >> 7) & 127, s = i & 127; ((bf16_t*)(ws + WS_WSB))[i] = (bf16_t)(s <= t ? f2bf(p.in[6][i]) : 0u); }
}

struct SgRegs { u32x4 w[4], v[4]; float s1[4], s2[4]; };
__device__ __forceinline__ void sg_load(SgRegs& R, const Params& p, int item, int tid) {
    const int g = item & 3, chunk = item >> 2, m0 = chunk * 128, c0 = g * 128;
    const bf16_t* WSB = (const bf16_t*)(p.ws + WS_WSB) + g * 16384; const bf16_t* VSG = (const bf16_t*)(p.ws + WS_VSG); const float* vstat = (const float*)(p.ws + WS_VSTAT);
#pragma unroll
    for (int k = 0; k < 4; ++k) { const int e = tid + 512 * k, t = e >> 4, sv = (e & 15) * 8; R.w[k] = *(const u32x4*)(WSB + t * 128 + sv);
        const int m = m0 + t; R.v[k] = *(const u32x4*)(VSG + (size_t)m * 512 + c0 + sv); R.s1[k] = vstat[2 * m]; R.s2[k] = vstat[2 * m + 1]; }
}
__device__ __forceinline__ void sg_item(const Params& p, LAS unsigned char* lds, int item, SgRegs& C, int item_next, SgRegs& N) {
    int tid_ = threadIdx.x; asm volatile("" : "+v"(tid_)); const int tid = tid_, lane = tid & 63, w = tid >> 6, fr = lane & 15, fq = lane >> 4;
    const int g = item & 3, chunk = item >> 2, m0 = chunk * 128, c0 = g * 128;
    unsigned char* ws = p.ws;
    LAS bf16_t* VNT = (LAS bf16_t*)lds;
    LAS bf16_t* WL = (LAS bf16_t*)(lds + 34816);
    bf16_t* U = (bf16_t*)(ws + WS_U);
    const float* lng = p.in[4] + c0; const float* lnb = p.in[5] + c0;
    const int tt = w, t = 16 * tt + fr;
    u32x4 ur[4];
#pragma unroll
    for (int k = 0; k < 4; ++k) { const int e = tid + 512 * k; ur[k] = *(const u32x4*)(U + (size_t)(m0 + (e >> 4)) * 512 + c0 + (e & 15) * 8); }
    const float bias = p.in[7][g * 128 + t];
#pragma unroll
    for (int k = 0; k < 4; ++k) { const int e = tid + 512 * k, tr = e >> 4, sv = (e & 15) * 8; *(LAS u32x4*)(WL + tr * 136 + sv) = C.w[k]; }
#pragma unroll
    for (int k = 0; k < 4; ++k) {
        const int e = tid + 512 * k, sr = e >> 4, cv = (e & 15) * 8;
        f32x4 a, b; unpack8(C.v[k], a, b);
        const float mu = C.s1[k] * (1.f / 512.f), var = fmaxf(C.s2[k] * (1.f / 512.f) - mu * mu, 0.f), rs = rsqrtf(var + EPS);
        const f32x4 ga = *(const f32x4*)(lng + cv), gb = *(const f32x4*)(lng + cv + 4), ba = *(const f32x4*)(lnb + cv), bb = *(const f32x4*)(lnb + cv + 4);
        a = (a - mu) * rs * ga + ba; b = (b - mu) * rs * gb + bb;
        const int ssw = ((((sr >> 3) ^ ((cv >> 3) & 15)) << 3) + (sr & 7));
#pragma unroll
        for (int j = 0; j < 4; ++j) { VNT[(cv + j) * 136 + ssw] = (bf16_t)f2bf(a[j]); VNT[(cv + 4 + j) * 136 + ssw] = (bf16_t)f2bf(b[j]); }
    }
    if (item_next >= 0) sg_load(N, p, item_next, tid);
    lds_barrier();
    f32x4 acc[8];
#pragma unroll
    for (int tc = 0; tc < 8; ++tc) acc[tc] = (f32x4){0.f, 0.f, 0.f, 0.f};
    const int ksn = (tt >> 1) + 1;
    for (int ks = 0; ks < ksn; ++ks) {
        const bf16x8 bf = *(const LAS bf16x8*)(WL + (16 * tt + fr) * 136 + 32 * ks + 8 * fq);
#pragma unroll
        for (int tc = 0; tc < 8; ++tc) { const bf16x8 af = *(const LAS bf16x8*)(VNT + (16 * tc + fr) * 136 + (((4 * ks + fq) ^ (2 * tc + (fr >> 3))) << 3)); acc[tc] = __builtin_amdgcn_mfma_f32_16x16x32_bf16(af, bf, acc[tc], 0, 0, 0); }
    }
    lds_barrier();
    LAS float* ZS = (LAS float*)lds;
#pragma unroll
    for (int tc = 0; tc < 8; ++tc) *(LAS f32x4*)(ZS + t * 132 + 16 * tc + 4 * fq) = acc[tc] + bias;
    lds_barrier();
#pragma unroll
    for (int k = 0; k < 4; ++k) { const int e = tid + 512 * k, tr = e >> 4, cv = (e & 15) * 8;
        const f32x4 z0 = *(const LAS f32x4*)(ZS + tr * 132 + cv), z1 = *(const LAS f32x4*)(ZS + tr * 132 + cv + 4);
        f32x4 u0, u1; unpack8(ur[k], u0, u1);
        *(u32x4*)(U + (size_t)(m0 + tr) * 512 + c0 + cv) = pack8(u0 * z0, u1 * z1); }
    lds_barrier();
}

struct PrepRegs { u32x4 la[2], q[2], k[2]; };
__device__ __forceinline__ void prep_load(PrepRegs& R, const Params& p, int it, int tid) {
    const unsigned char* dob = (const unsigned char*)p.out;
    const bf16_t* Qg = (const bf16_t*)(dob + DO_Q) + (size_t)it * 8192; const bf16_t* Kg = (const bf16_t*)(dob + DO_K) + (size_t)it * 8192; const bf16_t* Lg = (const bf16_t*)(dob + DO_LA) + (size_t)it * 8192;
#pragma unroll
    for (int k = 0; k < 2; ++k) { const int e = tid + 512 * k; R.la[k] = *(const u32x4*)(Lg + (size_t)e * 8); R.q[k] = *(const u32x4*)(Qg + (size_t)e * 8); R.k[k] = *(const u32x4*)(Kg + (size_t)e * 8); }
}
__device__ __forceinline__ void gla_prep_item(const Params& p, LAS unsigned char* lds, int it, PrepRegs& C, int it_next, PrepRegs& N) {
    int tid_ = threadIdx.x; asm volatile("" : "+v"(tid_)); const int tid = tid_, lane = tid & 63, w = tid >> 6, fr = lane & 15, fq = lane >> 4;
    LAS float* BC = (LAS float*)lds;
    LAS bf16_t* QI = (LAS bf16_t*)(lds + 32768);
    LAS bf16_t* KI = (LAS bf16_t*)(lds + 32768 + 17408);
    LAS bf16_t* KDT = (LAS bf16_t*)(lds + 32768 + 2 * 17408);
    unsigned char* dob = (unsigned char*)p.out;
    bf16_t* Qg = (bf16_t*)(dob + DO_Q) + (size_t)it * 8192;
    bf16_t* Kg = (bf16_t*)(dob + DO_K) + (size_t)it * 8192;
    bf16_t* Lg = (bf16_t*)(dob + DO_LA) + (size_t)it * 8192;
#pragma unroll
    for (int k = 0; k < 2; ++k) { const int e = tid + 512 * k, i = e >> 4, dv = (e & 15) * 8; f32x4 a, b; unpack8(C.la[k], a, b);
        *(LAS f32x4*)(BC + i * 128 + dv) = a; *(LAS f32x4*)(BC + i * 128 + dv + 4) = b; }
    if (it_next >= 0) prep_load(N, p, it_next, tid);
    lds_barrier();
    { const int d = tid & 127, seg = tid >> 7; float cv_[16]; float run = 0.f;
      LAS float* TOT = (LAS float*)(lds + 86016);
#pragma unroll
      for (int r = 0; r < 16; ++r) cv_[r] = BC[(16 * seg + r) * 128 + d];
#pragma unroll
      for (int r = 0; r < 16; ++r) { run += cv_[r]; cv_[r] = run; }
      TOT[seg * 128 + d] = run;
      lds_barrier();
      float offs = 0.f;
#pragma unroll
      for (int s = 0; s < 3; ++s) if (s < seg) offs += TOT[s * 128 + d];
#pragma unroll
      for (int r = 0; r < 16; ++r) BC[(16 * seg + r) * 128 + d] = cv_[r] + offs;
    }
    lds_barrier();
#pragma unroll
    for (int k = 0; k < 2; ++k) {
        const int e = tid + 512 * k, i = e >> 4, dv = (e & 15) * 8;
        f32x4 q0, q1, k0, k1; unpack8(C.q[k], q0, q1); unpack8(C.k[k], k0, k1);
        f32x4 qd0, qd1, qi0, qi1, ki0, ki1;
        const f32x4 bi0 = *(const LAS f32x4*)(BC + i * 128 + dv), bi1 = *(const LAS f32x4*)(BC + i * 128 + dv + 4);
        const f32x4 br0 = *(const LAS f32x4*)(BC + 31 * 128 + dv), br1 = *(const LAS f32x4*)(BC + 31 * 128 + dv + 4);
        const f32x4 bl0 = *(const LAS f32x4*)(BC + 63 * 128 + dv), bl1 = *(const LAS f32x4*)(BC + 63 * 128 + dv + 4);
        const int isw = ((((i >> 3) ^ ((dv >> 3) & 7)) << 3) + (i & 7));
#pragma unroll
        for (int j = 0; j < 4; ++j) {
            { const int d = dv + j; const float bi = bi0[j], br = br0[j], bl = bl0[j];
              qd0[j] = q0[j] * __expf(bi); qi0[j] = q0[j] * __expf(bi - br); ki0[j] = k0[j] * __expf(br - bi); KDT[d * 72 + isw] = (bf16_t)f2bf(k0[j] * __expf(bl - bi)); }
            { const int d = dv + 4 + j; const float bi = bi1[j], br = br1[j], bl = bl1[j];
              qd1[j] = q1[j] * __expf(bi); qi1[j] = q1[j] * __expf(bi - br); ki1[j] = k1[j] * __expf(br - bi); KDT[d * 72 + isw] = (bf16_t)f2bf(k1[j] * __expf(bl - bi)); }
        }
        *(u32x4*)(Qg + i * 128 + dv) = pack8(qd0, qd1);
        *(LAS u32x4*)(QI + i * 136 + dv) = pack8(qi0, qi1);
        *(LAS u32x4*)(KI + i * 136 + dv) = pack8(ki0, ki1);
    }
    if (tid < 128) ((float*)Lg)[2048 + tid] = __expf(BC[63 * 128 + tid]);
    lds_barrier();
    { const int ti = w >> 1;
#pragma unroll
      for (int tjj = 0; tjj < 2; ++tjj) {
          const int tj = 2 * (w & 1) + tjj; f32x4 acc = (f32x4){0.f, 0.f, 0.f, 0.f};
#pragma unroll
          for (int ks = 0; ks < 4; ++ks) { const bf16x8 af = *(const LAS bf16x8*)(KI + (16 * tj + fr) * 136 + 32 * ks + 8 * fq), bf = *(const LAS bf16x8*)(QI + (16 * ti + fr) * 136 + 32 * ks + 8 * fq);
              acc = __builtin_amdgcn_mfma_f32_16x16x32_bf16(af, bf, acc, 0, 0, 0); }
          const int i = 16 * ti + fr, j0 = 16 * tj + 4 * fq;
#pragma unroll
          for (int r = 0; r < 4; ++r) if (j0 + r > i) acc[r] = 0.f;
          *(u32x2*)(Lg + i * 64 + j0) = pack4(acc);
      } }
#pragma unroll
    for (int k = 0; k < 2; ++k) { const int e = tid + 512 * k, d = e >> 3, jb = e & 7; *(u32x4*)(Kg + d * 64 + jb * 8) = *(const LAS u32x4*)(KDT + d * 72 + ((jb ^ ((d >> 3) & 7)) << 3)); }
    lds_barrier();
}

struct GlaRegs { u32x4 P, Q0, Q1, K0, K1, V; float D; };
__device__ __forceinline__ void gla_load(GlaRegs& R, const bf16_t* Qb, const bf16_t* Kb, const bf16_t* Lb, const bf16_t* Vb, int b, int h, int vs, int n, int tid) {
    const size_t ib = ((size_t)(b * 32 + n) * 4 + h) * 8192;
    R.P = *(const u32x4*)(Lb + ib + (size_t)tid * 8);
    R.Q0 = *(const u32x4*)(Qb + ib + (size_t)tid * 8); R.Q1 = *(const u32x4*)(Qb + ib + (size_t)(tid + 512) * 8);
    R.K0 = *(const u32x4*)(Kb + ib + (size_t)tid * 8); R.K1 = *(const u32x4*)(Kb + ib + (size_t)(tid + 512) * 8);
    if (tid < 256) R.V = *(const u32x4*)(Vb + (size_t)(b * 2048 + n * 64 + (tid >> 2)) * 1024 + h * 256 + vs * 32 + (tid & 3) * 8);
    if (tid < 128) R.D = ((const float*)(Lb + ib))[2048 + tid];
}
__device__ __forceinline__ void gla_fill(LAS unsigned char* B, const GlaRegs& C, int tid) {
    LAS bf16_t* PL = (LAS bf16_t*)B; LAS bf16_t* QD = (LAS bf16_t*)(B + 9216); LAS bf16_t* KD = (LAS bf16_t*)(B + 26624); LAS bf16_t* VT = (LAS bf16_t*)(B + 45056); LAS float* DC = (LAS float*)(B + 58368);
    *(LAS u32x4*)(PL + (tid >> 3) * 72 + (tid & 7) * 8) = C.P;
    *(LAS u32x4*)(QD + (tid >> 4) * 136 + (tid & 15) * 8) = C.Q0; *(LAS u32x4*)(QD + ((tid + 512) >> 4) * 136 + (tid & 15) * 8) = C.Q1;
    *(LAS u32x4*)(KD + (tid >> 3) * 72 + (tid & 7) * 8) = C.K0; *(LAS u32x4*)(KD + ((tid + 512) >> 3) * 72 + (tid & 7) * 8) = C.K1;
    if (tid < 256) { const int jr = tid >> 2, v0 = (tid & 3) * 8, j = (((jr >> 3) ^ (v0 >> 3)) << 3) + (jr & 7); const u32x4 rV = C.V;
        VT[(v0 + 0) * 72 + j] = (bf16_t)(rV.x & 0xffffu); VT[(v0 + 1) * 72 + j] = (bf16_t)(rV.x >> 16);
        VT[(v0 + 2) * 72 + j] = (bf16_t)(rV.y & 0xffffu); VT[(v0 + 3) * 72 + j] = (bf16_t)(rV.y >> 16);
        VT[(v0 + 4) * 72 + j] = (bf16_t)(rV.z & 0xffffu); VT[(v0 + 5) * 72 + j] = (bf16_t)(rV.z >> 16);
        VT[(v0 + 6) * 72 + j] = (bf16_t)(rV.w & 0xffffu); VT[(v0 + 7) * 72 + j] = (bf16_t)(rV.w >> 16); }
    if (tid < 128) DC[tid] = C.D;
}
__device__ __forceinline__ void gla_seq(const Params& p, LAS unsigned char* lds, int bh, int vs) {
    int tid_ = threadIdx.x; asm volatile("" : "+v"(tid_)); const int tid = tid_, lane = tid & 63, w = tid >> 6, fr = lane & 15, fq = lane >> 4;
    constexpr int SETB = 58880;
    const int b = bh >> 2, h = bh & 3;
    unsigned char* dob = (unsigned char*)p.out;
    const bf16_t* Qb = (const bf16_t*)(dob + DO_Q); const bf16_t* Kb = (const bf16_t*)(dob + DO_K); const bf16_t* Lb = (const bf16_t*)(dob + DO_LA);
    bf16_t* Vb = (bf16_t*)(p.ws + WS_V);
    float* gpart = (float*)(p.ws + WS_GPART);
    for (int e = tid; e < 32 * 136 / 2; e += 512) ((LAS unsigned*)(lds + 49664))[e] = 0u;
    f32x4 S[2]; S[0] = (f32x4){0.f, 0.f, 0.f, 0.f}; S[1] = S[0];
    GlaRegs R[2];
    R[0].V = (u32x4){0u, 0u, 0u, 0u}; R[1].V = R[0].V; R[0].D = 0.f; R[1].D = 0.f;
    gla_load(R[0], Qb, Kb, Lb, Vb, b, h, vs, 0, tid);
    gla_load(R[1], Qb, Kb, Lb, Vb, b, h, vs, 1, tid);
    gla_fill(lds, R[0], tid);
    gla_load(R[0], Qb, Kb, Lb, Vb, b, h, vs, 2, tid);
    lds_barrier();
    const int ti = w >> 1, tv = w & 1;
    for (int n2 = 0; n2 < 32; n2 += 2) {
#pragma unroll
        for (int u = 0; u < 2; ++u) {
            const int n = n2 + u;
            LAS unsigned char* Bc = lds + u * SETB; LAS unsigned char* Bn = lds + (u ^ 1) * SETB;
            if (n + 1 < 32) gla_fill(Bn, R[u ^ 1], tid);
            if (n + 3 < 32) gla_load(R[u ^ 1], Qb, Kb, Lb, Vb, b, h, vs, n + 3, tid);
            const LAS bf16_t* PL = (const LAS bf16_t*)Bc; const LAS bf16_t* QD = (const LAS bf16_t*)(Bc + 9216); const LAS bf16_t* KD = (const LAS bf16_t*)(Bc + 26624);
            const LAS bf16_t* VT = (const LAS bf16_t*)(Bc + 45056); const LAS bf16_t* ST = (const LAS bf16_t*)(Bc + 49664); const LAS float* DC = (const LAS float*)(Bc + 58368);
            f32x4 o = (f32x4){0.f, 0.f, 0.f, 0.f};
#pragma unroll
            for (int ks = 0; ks < 2; ++ks) { const bf16x8 af = *(const LAS bf16x8*)(VT + (16 * tv + fr) * 72 + (((4 * ks + fq) ^ (2 * tv + (fr >> 3))) << 3)), bf = *(const LAS bf16x8*)(PL + (16 * ti + fr) * 72 + 32 * ks + 8 * fq);
                o = __builtin_amdgcn_mfma_f32_16x16x32_bf16(af, bf, o, 0, 0, 0); }
#pragma unroll
            for (int ks = 0; ks < 4; ++ks) { const bf16x8 af = *(const LAS bf16x8*)(ST + (16 * tv + fr) * 136 + 32 * ks + 8 * fq), bf = *(const LAS bf16x8*)(QD + (16 * ti + fr) * 136 + 32 * ks + 8 * fq);
                o = __builtin_amdgcn_mfma_f32_16x16x32_bf16(af, bf, o, 0, 0, 0); }
            const f32x4 dec = *(const LAS f32x4*)(DC + 16 * w + 4 * fq);
#pragma unroll
            for (int tvv = 0; tvv < 2; ++tvv) { f32x4 kv = (f32x4){0.f, 0.f, 0.f, 0.f};
#pragma unroll
                for (int ks = 0; ks < 2; ++ks) { const bf16x8 af = *(const LAS bf16x8*)(KD + (16 * w + fr) * 72 + 32 * ks + 8 * fq), bf = *(const LAS bf16x8*)(VT + (16 * tvv + fr) * 72 + (((4 * ks + fq) ^ (2 * tvv + (fr >> 3))) << 3));
                    kv = __builtin_amdgcn_mfma_f32_16x16x32_bf16(af, bf, kv, 0, 0, 0); }
                S[tvv] = dec * S[tvv] + kv; }
            LAS bf16_t* STn = (LAS bf16_t*)(Bn + 49664);
#pragma unroll
            for (int tvv = 0; tvv < 2; ++tvv) *(LAS u32x2*)(STn + (16 * tvv + fr) * 136 + 16 * w + 4 * fq) = pack4(S[tvv]);
            const int m = b * 2048 + n * 64 + 16 * ti + fr;
            *(u32x2*)(Vb + (size_t)m * 1024 + h * 256 + vs * 32 + 16 * tv + 4 * fq) = pack4(o);
            float ss = o[0] * o[0] + o[1] * o[1] + o[2] * o[2] + o[3] * o[3];
            ss += __shfl_xor(ss, 16); ss += __shfl_xor(ss, 32);
            if (fq == 0) gpart[((size_t)bh * 2048 + n * 64 + 16 * ti + fr) * 16 + vs * 2 + tv] = ss;
            lds_barrier();
        }
    }
    __syncthreads();
}

__device__ __forceinline__ void gla_meet_arrive(const Params& p, int bh, bool same_xcd) {
    asm volatile("s_waitcnt vmcnt(0) lgkmcnt(0)" ::: "memory");
    __syncthreads();
    if (threadIdx.x == 0) {
        unsigned* c = (unsigned*)(p.ws + WS_BHC) + bh * 64;
        if (!same_xcd) { __builtin_amdgcn_fence(__ATOMIC_RELEASE, "agent"); asm volatile("s_waitcnt vmcnt(0)" ::: "memory"); }
        __hip_atomic_fetch_add(c, 1u, __ATOMIC_RELAXED, __HIP_MEMORY_SCOPE_AGENT);
    }
}
__device__ __forceinline__ void gla_norm_meet(const Params& p, int bh, int vs) {
    int tid_ = threadIdx.x; asm volatile("" : "+v"(tid_)); const int tid = tid_;
    const int b = bh >> 2, h = bh & 3;
    bf16_t* Vb = (bf16_t*)(p.ws + WS_V);
    const float* gpart = (const float*)(p.ws + WS_GPART);
    {
        if (tid == 0) {
            unsigned* c = (unsigned*)(p.ws + WS_BHC) + bh * 64;
            while (__hip_atomic_load(c, __ATOMIC_RELAXED, __HIP_MEMORY_SCOPE_AGENT) < 8u) __builtin_amdgcn_s_sleep(1);
            __builtin_amdgcn_fence(__ATOMIC_ACQUIRE, "agent");
            asm volatile("s_waitcnt vmcnt(0)" ::: "memory");
        }
        __syncthreads();
        const bf16_t* OGb = (const bf16_t*)(p.ws + WS_OG);
        const int cv = (tid & 31) * 8;
        const f32x4 n0 = *(const f32x4*)(p.in[11] + cv), n1 = *(const f32x4*)(p.in[11] + cv + 4);
#pragma unroll 4
        for (int r = tid >> 5; r < 256; r += 16) {
            const int row = vs * 256 + r, m = b * 2048 + row; const size_t off = (size_t)m * 1024 + h * 256 + cv;
            const f32x4* gp = (const f32x4*)(gpart + ((size_t)bh * 2048 + row) * 16);
            const f32x4 s4 = (gp[0] + gp[1]) + (gp[2] + gp[3]);
            const float rs = rsqrtf(((s4[0] + s4[1]) + (s4[2] + s4[3])) * (1.f / 256.f) + EPS);
            f32x4 o0, o1, g0, g1; unpack8(*(const u32x4*)(Vb + off), o0, o1); unpack8(*(const u32x4*)(OGb + off), g0, g1);
            *(u32x4*)(Vb + off) = pack8(o0 * rs * n0 * g0, o1 * rs * n1 * g1);
        }
    }
}

#define XB_TMO      128
#define XB_XCNT(j)  (256  + 64 * (j))
#define XB_XSUB(j)  (1280 + 64 * (j))
#define XB_XGEN(j)  (2304 + 64 * (j))
#define XB_TOP      3328
#define XB_TOPGEN   3392
#define XCD_BAR_WORDS 3456
#define XB_SPIN_CAP (1u << 18)

__device__ __forceinline__ unsigned xb_ld(unsigned* p)              { return __hip_atomic_load(p, __ATOMIC_RELAXED, __HIP_MEMORY_SCOPE_AGENT); }
__device__ __forceinline__ unsigned xb_add(unsigned* p, unsigned v) { return __hip_atomic_fetch_add(p, v, __ATOMIC_RELAXED, __HIP_MEMORY_SCOPE_AGENT); }
__device__ __forceinline__ unsigned xb_xcc_id() { return (unsigned)__builtin_amdgcn_s_getreg((3 << 11) | 20) & 0xFu; }
#define XB_SPIN(cond, bar) do { unsigned _sp = 0; while (cond) { __builtin_amdgcn_s_sleep(1); \
    if ((++_sp & 255u) == 0u) { if (xb_ld(&(bar)[XB_TMO])) break; if (_sp > XB_SPIN_CAP) { atomicAdd(&(bar)[XB_TMO], 1u); break; } } } } while (0)

struct XcdBarrier {
    unsigned* bar; unsigned x;
    volatile LAS unsigned* st;
};

__device__ __forceinline__ XcdBarrier xcd_barrier_post(unsigned* bar, volatile LAS unsigned* st) {
    XcdBarrier b; b.bar = bar; b.x = xb_xcc_id(); b.st = st;
    if (threadIdx.x == 0) (void)xb_add(&bar[XB_XCNT(b.x)], 1u);
    return b;
}
__device__ __forceinline__ void xcd_barrier_complete(unsigned* bar, unsigned x, unsigned& nloc, unsigned& nx) {
    const unsigned G = gridDim.x * gridDim.y * gridDim.z;
    unsigned sum, cnt, mine, sp = 0u;
    for (;;) {
        sum = 0u; cnt = 0u; mine = 0u;
#pragma unroll
        for (unsigned j = 0; j < 16; ++j) { const unsigned c = xb_ld(&bar[XB_XCNT(j)]); sum += c; cnt += (c > 0u) ? 1u : 0u; mine = (j == x) ? c : mine; }
        if (sum == G) break;
        __builtin_amdgcn_s_sleep(1);
        if ((++sp & 255u) == 0u) { if (xb_ld(&bar[XB_TMO])) break; if (sp > XB_SPIN_CAP) { atomicAdd(&bar[XB_TMO], 1u); break; } }
    }
    nloc = mine > 0u ? mine : 1u; nx = cnt > 0u ? cnt : 1u;
}

__device__ __forceinline__ void xcd_barrier(const XcdBarrier& b) {
    asm volatile("s_waitcnt vmcnt(0)" ::: "memory");
    __syncthreads();
    if (threadIdx.x == 0) {
        unsigned* bar = b.bar;
        __builtin_amdgcn_s_waitcnt(0);
        unsigned nloc = b.st[0], nx = b.st[1];
        if (nloc == 0u) { xcd_barrier_complete(bar, b.x, nloc, nx); b.st[0] = nloc; b.st[1] = nx; }
        const unsigned old = xb_add(&bar[XB_XSUB(b.x)], 1u);
        const unsigned gen = old / nloc;
        if (old + 1u == (gen + 1u) * nloc) {
            __builtin_amdgcn_fence(__ATOMIC_RELEASE, "agent");
            asm volatile("s_waitcnt vmcnt(0)" ::: "memory");
            const unsigned og = xb_add(&bar[XB_TOP], 1u);
            const unsigned tg = og / nx;
            if (og + 1u == (tg + 1u) * nx) xb_add(&bar[XB_TOPGEN], 1u);
            else XB_SPIN(xb_ld(&bar[XB_TOPGEN]) == tg, bar);
            __builtin_amdgcn_fence(__ATOMIC_ACQUIRE, "agent");
            xb_add(&bar[XB_XGEN(b.x)], 1u);
            asm volatile("s_waitcnt vmcnt(0)" ::: "memory");
        } else {
            XB_SPIN(xb_ld(&bar[XB_XGEN(b.x)]) == gen, bar);
            __builtin_amdgcn_fence(__ATOMIC_ACQUIRE, "agent");
            asm volatile("s_waitcnt vmcnt(0)" ::: "memory");
        }
    }
    __syncthreads();
}

__device__ __forceinline__ void grid_bar(unsigned* cnt, unsigned target) {
    asm volatile("s_waitcnt vmcnt(0) lgkmcnt(0)" ::: "memory");
    __syncthreads();
    if (threadIdx.x == 0) {
        __builtin_amdgcn_fence(__ATOMIC_RELEASE, "agent");
        asm volatile("s_waitcnt vmcnt(0)" ::: "memory");
        __hip_atomic_fetch_add(cnt, 1u, __ATOMIC_RELAXED, __HIP_MEMORY_SCOPE_AGENT);
        while (__hip_atomic_load(cnt, __ATOMIC_RELAXED, __HIP_MEMORY_SCOPE_AGENT) < target) __builtin_amdgcn_s_sleep(1);
        __builtin_amdgcn_fence(__ATOMIC_ACQUIRE, "agent");
        asm volatile("s_waitcnt vmcnt(0)" ::: "memory");
    }
    __syncthreads();
}
__device__ __forceinline__ void panel_meet(unsigned* cnt, bool same_xcd) {
    asm volatile("s_waitcnt vmcnt(0) lgkmcnt(0)" ::: "memory");
    __syncthreads();
    if (threadIdx.x == 0) {
        if (!same_xcd) { __builtin_amdgcn_fence(__ATOMIC_RELEASE, "agent"); asm volatile("s_waitcnt vmcnt(0)" ::: "memory"); }
        __hip_atomic_fetch_add(cnt, 1u, __ATOMIC_RELAXED, __HIP_MEMORY_SCOPE_AGENT);
        while (__hip_atomic_load(cnt, __ATOMIC_RELAXED, __HIP_MEMORY_SCOPE_AGENT) < 4u) __builtin_amdgcn_s_sleep(1);
        __builtin_amdgcn_fence(__ATOMIC_ACQUIRE, "agent");
        asm volatile("s_waitcnt vmcnt(0)" ::: "memory");
    }
    __syncthreads();
}
__global__ void __launch_bounds__(512, 2) mk_fwd(Params p) {
    extern __shared__ __attribute__((aligned(16))) unsigned char lds_raw[];
    LAS unsigned char* lds = (LAS unsigned char*)lds_raw;
    cg::grid_group grid = cg::this_grid();
    unsigned char* ws = p.ws; unsigned char* dob = (unsigned char*)p.out;
    const int G = gridDim.x;
    if (threadIdx.x < 2) ((volatile LAS unsigned*)(lds + 131072 + 512))[threadIdx.x] = 0u;
    __syncthreads();
#ifndef MK_PHASE_MASK
#define MK_PHASE_MASK 0x7ff
#endif
#define IN(k) ((((MK_PHASE_MASK) >> (k)) & 1) != 0)
#define GBAR() xcd_barrier(xbar)
#ifndef MK_DELAY_MASK
#define MK_DELAY_MASK 0
#endif
    unsigned long long t_ph = 0;
#define TBEG() do { if (MK_DELAY_MASK) t_ph = __builtin_amdgcn_s_memrealtime(); } while (0)
#define TEND(k) do { if ((MK_DELAY_MASK >> (k)) & 1) { const unsigned long long t1_ = __builtin_amdgcn_s_memrealtime(), dt_ = t1_ - t_ph; while (__builtin_amdgcn_s_memrealtime() - t1_ < dt_) __builtin_amdgcn_s_sleep(8); __syncthreads(); } } while (0)
    const unsigned long long t_k0 = MK_DELAY_MASK ? __builtin_amdgcn_s_memrealtime() : 0ull;
    for (int i = blockIdx.x * 512 + threadIdx.x; i < 4096; i += G * 512) ((unsigned*)(ws + WS_XBAR))[i] = 0u;
    grid.sync();
    XcdBarrier xbar = xcd_barrier_post((unsigned*)(ws + WS_XBAR), (volatile LAS unsigned*)(lds + 131072 + 512));
    const bool chain = (G == 256);
    int my_pm = 0; { pg8::StaticOrder S0; S0.init(M, 1024, G, (int)blockIdx.x); pg8::Unit u0; if (S0.next(0, u0)) my_pm = u0.pm; }
    unsigned* pmask = (unsigned*)(ws + WS_XBAR) + 3584 + my_pm;
    if (chain && threadIdx.x == 0) __hip_atomic_fetch_or(pmask, 1u << xb_xcc_id(), __ATOMIC_RELAXED, __HIP_MEMORY_SCOPE_AGENT);
    const int my_it = blockIdx.x, my_b = my_it & 7, my_bh = 4 * my_b + ((my_it >> 3) & 3), my_vs = (my_it >> 5) & 7;
    unsigned* bmask0 = (unsigned*)(ws + WS_XBAR) + 3584 + 128;
    if (chain && threadIdx.x == 0) __hip_atomic_fetch_or(bmask0 + my_b, 1u << xb_xcc_id(), __ATOMIC_RELAXED, __HIP_MEMORY_SCOPE_AGENT);
    unsigned* bhmask = (unsigned*)(ws + WS_XBAR) + 3584 + 64 + (my_bh & 31);
    if (G >= 256 && my_it < 256 && threadIdx.x == 0) __hip_atomic_fetch_or(bhmask, 1u << xb_xcc_id(), __ATOMIC_RELAXED, __HIP_MEMORY_SCOPE_AGENT);
    TBEG();
    if (IN(0)) phase_prologue(p, lds);
    GBAR();
    TEND(0);
    TBEG();
    if (IN(1)) {
        EpiIn E{(bf16_t*)(ws + WS_U), (bf16_t*)(ws + WS_VSG), (bf16_t*)(dob + DO_Q), (bf16_t*)(dob + DO_K), (bf16_t*)(ws + WS_V), (bf16_t*)(dob + DO_LA),
                (bf16_t*)(ws + WS_OG), (bf16_t*)(ws + WS_BGA), (bf16_t*)(ws + WS_BGB), (float*)(ws + WS_VSTAT), p.in[10]};
        run_gemm(lds, (const bf16_t*)(ws + WS_H), (const bf16_t*)(ws + WS_WIN), NIN, 1024, E);
        { const int nwg = (M / 256) * (NIN / 256), rem = nwg % G, c = blockIdx.x; const bool light = rem == 0 || c >= rem; const int nlight = rem == 0 ? G : G - rem, li = rem == 0 ? c : c - rem;
          if (light) { int tid_ = threadIdx.x; asm volatile("" : "+v"(tid_)); const int wv = tid_ >> 6;
              tr_run(p, (LAS float*)(lds + wv * 16384), tid_ & 63, TR_EARLY, TR_ALL - TR_EARLY, li * 8 + wv, nlight * 8); } }
    }
    GBAR();
    TEND(1);
    TBEG();
    if (IN(2)) {
        int tid = threadIdx.x; asm volatile("" : "+v"(tid));
        { PrepRegs A, B; if ((int)blockIdx.x < 1024) prep_load(A, p, blockIdx.x, tid);
          for (int it = blockIdx.x; it < 1024; it += G) { const int itn = it + G < 1024 ? it + G : -1; gla_prep_item(p, lds, it, A, itn, B); A = B; } }
        { SgRegs A, B; if ((int)blockIdx.x < 512) sg_load(A, p, blockIdx.x, tid);
          for (int it = blockIdx.x; it < 512; it += G) { const int itn = it + G < 512 ? it + G : -1; sg_item(p, lds, it, A, itn, B); A = B; } }
    }
    GBAR();
    TEND(2);
    TBEG();
    const bool fuse_norm = (G >= 256);
    bool fuse35 = chain && fuse_norm;
    if (fuse35) { unsigned ok = 1u;
#pragma unroll
        for (int j = 0; j < 8; ++j) ok &= (__builtin_popcount(__hip_atomic_load(bmask0 + j, __ATOMIC_RELAXED, __HIP_MEMORY_SCOPE_AGENT)) == 1) ? 1u : 0u;
        fuse35 = ok != 0u; }
    if (IN(3)) {
        for (int it = blockIdx.x; it < 256; it += G) gla_seq(p, lds, 4 * (it & 7) + ((it >> 3) & 3), (it >> 5) & 7);
        TEND(11); TBEG();
        if (fuse_norm && my_it < 256) { const bool bh_same = __builtin_popcount(__hip_atomic_load(bhmask, __ATOMIC_RELAXED, __HIP_MEMORY_SCOPE_AGENT)) == 1; gla_meet_arrive(p, my_bh, bh_same); }
        EpiMerge<false> E{(bf16_t*)(ws + WS_H), (const bf16_t*)(ws + WS_BGA)};
        run_gemm(lds, (const bf16_t*)(ws + WS_U), (const bf16_t*)(ws + WS_WA), 1024, 512, E);
        TEND(13); TBEG();
        if (fuse_norm && my_it < 256) gla_norm_meet(p, my_bh, my_vs);
        TEND(12); TBEG();
    }
    if (fuse35) {
        asm volatile("s_waitcnt vmcnt(0) lgkmcnt(0)" ::: "memory");
        __syncthreads();
        if (threadIdx.x == 0) __hip_atomic_fetch_add((unsigned*)(ws + WS_P35) + (8 * my_b + my_vs) * 16, 1u, __ATOMIC_RELAXED, __HIP_MEMORY_SCOPE_AGENT);
    } else GBAR();
    TEND(3);
    if (!fuse_norm) {
        int tid = threadIdx.x; asm volatile("" : "+v"(tid));
        for (int e = blockIdx.x * 512 + tid; e < M * 128; e += G * 512) {
            const int m = e >> 7, c = (e & 127) * 8, h = c >> 8;
            const f32x4* gp = (const f32x4*)((const float*)(ws + WS_GPART) + ((size_t)((m >> 11) * 4 + h) * 2048 + (m & 2047)) * 16);
            const f32x4 s4 = (gp[0] + gp[1]) + (gp[2] + gp[3]);
            const float rs = rsqrtf(((s4[0] + s4[1]) + (s4[2] + s4[3])) * (1.f / 256.f) + EPS);
            f32x4 o0, o1, g0, g1; unpack8(*(const u32x4*)((bf16_t*)(ws + WS_V) + (size_t)e * 8), o0, o1); unpack8(*(const u32x4*)((const bf16_t*)(ws + WS_OG) + (size_t)e * 8), g0, g1);
            const f32x4 n0 = *(const f32x4*)(p.in[11] + (c & 255)), n1 = *(const f32x4*)(p.in[11] + (c & 255) + 4);
            *(u32x4*)((bf16_t*)(ws + WS_V) + (size_t)e * 8) = pack8(o0 * rs * n0 * g0, o1 * rs * n1 * g1);
        }
        GBAR();
    }
    TBEG();
    const bool same_xcd = chain && __builtin_popcount(__hip_atomic_load(pmask, __ATOMIC_RELAXED, __HIP_MEMORY_SCOPE_AGENT)) == 1;
#define PSEAM(k) do { if (chain) panel_meet((unsigned*)(ws + WS_PCNT) + ((k) * 64 + my_pm) * 32, same_xcd); else GBAR(); } while (0)
    if (fuse35) {
        if (threadIdx.x == 0) { unsigned* c35 = (unsigned*)(ws + WS_P35) + my_pm * 16;
            while (__hip_atomic_load(c35, __ATOMIC_RELAXED, __HIP_MEMORY_SCOPE_AGENT) < 4u) __builtin_amdgcn_s_sleep(1);
            __builtin_amdgcn_fence(__ATOMIC_ACQUIRE, "agent"); asm volatile("s_waitcnt vmcnt(0)" ::: "memory"); }
        __syncthreads();
    }
    if (IN(5)) {
        EpiMerge<true> E{(bf16_t*)(ws + WS_H), (const bf16_t*)(ws + WS_BGB)};
        run_gemm(lds, (const bf16_t*)(ws + WS_V), (const bf16_t*)(ws + WS_WB), 1024, 1024, E);
    }
    PSEAM(3);
    if (chain && threadIdx.x == 0) __hip_atomic_fetch_add((unsigned*)(ws + WS_BAR), 1u, __ATOMIC_RELAXED, __HIP_MEMORY_SCOPE_AGENT);
    TEND(5);
    TBEG();
    if (IN(6)) {
        EpiRes<false> E{p.in[0], (bf16_t*)(ws + WS_XB), (float*)(ws + WS_RSS2)};
        run_gemm(lds, (const bf16_t*)(ws + WS_H), (const bf16_t*)(ws + WS_WO), 1024, 1024, E);
    }
    PSEAM(0);
    TEND(6);
    TBEG();
    if (chain) { if (threadIdx.x == 0) { while (__hip_atomic_load((unsigned*)(ws + WS_BAR), __ATOMIC_RELAXED, __HIP_MEMORY_SCOPE_AGENT) < (unsigned)G) __builtin_amdgcn_s_sleep(1); } __syncthreads(); }
    if (IN(7)) {
        EpiUp E{(bf16_t*)(ws + WS_UP), (const float*)(ws + WS_RSS2)};
        run_gemm(lds, (const bf16_t*)(ws + WS_XB), (const bf16_t*)(ws + WS_WUP), FF, 1024, E);
    }
    PSEAM(1);
    TEND(7);
    TBEG();
    if (IN(8)) {
        EpiRes<true> E{nullptr, (bf16_t*)(ws + WS_XB), (float*)(ws + WS_RSS3)};
        run_gemm(lds, (const bf16_t*)(ws + WS_UP), (const bf16_t*)(ws + WS_WDN), 1024, FF, E);
        EpiPlain E2{(bf16_t*)(ws + WS_H)};
        run_gemm(lds, (const bf16_t*)(ws + WS_PB), (const bf16_t*)(ws + WS_WPP), 1024, PLE, E2);
    }
    PSEAM(2);
    TEND(8);
    TBEG();
    const bool fuse_final = (G == 256);
    TBEG();
    if (IN(9)) {
        if (fuse_final) {
            EpiPleFinal E{p.out, (const bf16_t*)(ws + WS_XB), (const bf16_t*)(ws + WS_H), (const float*)(ws + WS_RSS3), (float*)(ws + WS_RSS4), (unsigned*)(ws + WS_PCNT) + 4 * 64 * 32, p.in[20], same_xcd};
            run_gemm<EpiPleFinal, false>(lds, (const bf16_t*)(ws + WS_XB), (const bf16_t*)(ws + WS_WPG), 1024, 1024, E);
        } else {
            EpiPleGate E{p.out, (const bf16_t*)(ws + WS_XB), (const bf16_t*)(ws + WS_H), (const float*)(ws + WS_RSS3), (float*)(ws + WS_RSS4)};
            run_gemm(lds, (const bf16_t*)(ws + WS_XB), (const bf16_t*)(ws + WS_WPG), 1024, 1024, E);
        }
    }
    if (!fuse_final) {
        GBAR();
        const float* rss4 = (const float*)(ws + WS_RSS4);
        int tid = threadIdx.x; asm volatile("" : "+v"(tid));
        for (int e = blockIdx.x * 512 + tid; e < M * 256; e += G * 512) {
            const int m = e >> 8, c = (e & 255) * 4;
            const float rs = rsqrtf(rss4[m] * (1.f / 1024.f) + EPS);
            const f32x4 v = *(const f32x4*)(p.out + (size_t)e * 4), g = *(const f32x4*)(p.in[20] + c);
            *(f32x4*)(p.out + (size_t)e * 4) = v * rs * g;
        }
    }
    if ((MK_DELAY_MASK >> 10) & 1) { asm volatile("s_waitcnt vmcnt(0)" ::: "memory"); __syncthreads(); }
    TEND(9);
    if ((MK_DELAY_MASK >> 14) & 1) { asm volatile("s_waitcnt vmcnt(0)" ::: "memory"); __syncthreads(); t_ph = t_k0; }
    TEND(14);
#undef IN
#undef GBAR
#undef PSEAM
}
}

extern "C" void kernel_launch(void* const* d_in, const int* in_sizes, int n_in, void* d_out, int out_size, void* d_ws, size_t ws_size, hipStream_t stream) {
    static int grid = 0;
    if (grid == 0) {
        if (n_in != 21 || out_size != mk::M * mk::D || ws_size < mk::WS_END) { fprintf(stderr, "kernel_launch: unexpected shapes (n_in %d out %d ws %zu)\n", n_in, out_size, ws_size); grid = -1; return; }
        int dev = 0, cus = 0, per_cu = 0;
        if (hipGetDevice(&dev) != hipSuccess || hipDeviceGetAttribute(&cus, hipDeviceAttributeMultiprocessorCount, dev) != hipSuccess) { grid = -1; return; }
        if (hipFuncSetAttribute((const void*)mk::mk_fwd, hipFuncAttributeMaxDynamicSharedMemorySize, mk::LDS_BYTES) != hipSuccess) { fprintf(stderr, "kernel_launch: hipFuncSetAttribute failed\n"); grid = -1; return; }
        if (hipOccupancyMaxActiveBlocksPerMultiprocessor(&per_cu, (const void*)mk::mk_fwd, 512, mk::LDS_BYTES) != hipSuccess || per_cu < 1) { fprintf(stderr, "kernel_launch: occupancy query says %d\n", per_cu); per_cu = 1; }
        (void)hipGetLastError();
        grid = cus * per_cu;
    }
    if (grid < 0) return;
    mk::Params p{};
    for (int i = 0; i < 21; ++i) p.in[i] = (const float*)d_in[i];
    p.out = (float*)d_out; p.ws = (unsigned char*)d_ws;
    void* args[] = {&p};
    hipError_t e = hipLaunchCooperativeKernel((const void*)mk::mk_fwd, dim3(grid), dim3(512), args, mk::LDS_BYTES, stream);
    if (e != hipSuccess) fprintf(stderr, "kernel_launch: cooperative launch failed: %s (grid %d)\n", hipGetErrorString(e), grid);

}
```

```cpp
#include <hip/hip_runtime.h>
#include <hip/hip_cooperative_groups.h>
#include <cstdio>
#include <cstdint>
namespace cg = cooperative_groups;
namespace pg8 {
#define PG8_LAS __attribute__((address_space(3)))
typedef unsigned short bf16_t;
typedef short bf16x8 __attribute__((ext_vector_type(8)));
typedef float f32x4 __attribute__((ext_vector_type(4)));
typedef unsigned u32x4 __attribute__((ext_vector_type(4)));
constexpr int BM = 256, BK = 64, HALF = 128, HTB = HALF * BK * 2  , STAGE_BYTES = 8 * HTB, NXCD = 8, WGM = 8;

__host__ __device__ __forceinline__ int lds_byte(int r, int c) { const int st = (r >> 4) * 2 + (c >> 5), rr = r & 15, cc = c & 31, ob = rr * 64 + cc * 2; return st * 1024 + (ob ^ (((ob >> 9) & 1) << 5)); }
__host__ __device__ __forceinline__ void stage_rc(int b, int& R, int& C) { const int st = b / 1024, sb = b % 1024, swz = sb ^ (((sb >> 9) & 1) << 5); R = (st >> 1) * 16 + swz / 64; C = (st & 1) * 32 + (swz % 64) / 2; }
__host__ __device__ __forceinline__ int perm32(int rho) { const int n = rho >> 4, i = rho & 15; return 8 * (i >> 2) + 4 * n + (i & 3); }

struct Unit { int pm, pn; };
struct Gemm { const bf16_t* A; const bf16_t* Bt; int M, N, K; };

struct StaticOrder {
    int nM, nN, nwg, G, c;
    __host__ __device__ void init(int M, int N, int G_, int c_) { nM = M / BM; nN = N / BM; nwg = nM * nN; G = G_; c = c_; }
    __host__ __device__ bool next(int i, Unit& u) const {
        const long L = (long)i * G + c; if (L >= nwg) return false;
        int wgid = (int)L; { const int q = nwg / NXCD, r = nwg % NXCD, xcd = wgid % NXCD, off = wgid / NXCD; wgid = (xcd < r ? xcd * (q + 1) : r * (q + 1) + (xcd - r) * q) + off; }
        const int nig = WGM * nN, gid = wgid / nig, fm = gid * WGM, gsz = (nM - fm) < WGM ? (nM - fm) : WGM;
        u.pm = fm + ((wgid % nig) % gsz); u.pn = (wgid % nig) / gsz; return true;
    }
    __device__ __forceinline__ void a_ready(const Unit&) const {}
    __device__ __forceinline__ void done(const Unit&) const {}
};
typedef float f32x2 __attribute__((ext_vector_type(2)));
typedef __bf16 bf16x2_t __attribute__((ext_vector_type(2)));
__device__ __forceinline__ unsigned cvt_pk_bf16(float lo, float hi) { f32x2 v = {lo, hi}; bf16x2_t b = __builtin_convertvector(v, bf16x2_t); return __builtin_bit_cast(unsigned, b); }
template <class Epi, class Sched, bool ALIGN_EPI = false, bool SP2 = false>
__device__ __forceinline__ void gemm_phase(PG8_LAS unsigned char* lds, const Gemm g, const Sched& S, const Epi& E) {
    int tid_ = threadIdx.x; asm volatile("" : "+v"(tid_));
    const int tid = tid_, wid = __builtin_amdgcn_readfirstlane(tid >> 6), lane = tid & 63, wr = wid >> 2, wc = wid & 3, fr = lane & 15, fq = lane >> 4;
    const int K = g.K, nt = K / BK;
    unsigned voffA[2], voffB[2];
#pragma unroll
    for (int i = 0; i < 2; ++i) { int R, C; stage_rc(tid * 16 + i * 8192, R, C); const int Rb = Epi::PERM ? ((R & ~31) + perm32(R & 31)) : R;
        voffA[i] = (unsigned)(R * K + C) * 2u; voffB[i] = (unsigned)(Rb * K + C) * 2u; }
    const size_t kstep = (size_t)(BK * 2);
    const size_t hstep = (size_t)HALF * K * 2;
    const size_t tstep = 2 * hstep;
    const unsigned ldsw = (unsigned)wid * 1024u;
    const int aoff = lds_byte(wr * 64 + fr, fq * 8), boff = lds_byte(wc * 32 + fr, fq * 8);
#define PG8_SA(b, h) (((b) * 2 + (h)) * HTB)
#define PG8_SB(b, h) ((4 + (b) * 2 + (h)) * HTB)
#define PG8_STAGE(bufoff, gbase, voff) do { _Pragma("unroll") for (int _i = 0; _i < 2; ++_i) \
        __builtin_amdgcn_global_load_lds((const unsigned*)((const char*)(gbase) + (voff)[_i]), (PG8_LAS unsigned*)(lds + (bufoff) + ldsw + _i * 8192), 16, 0, 0); } while (0)
#define PG8_LDA(dst, b, h) do { _Pragma("unroll") for (int m = 0; m < 4; ++m) _Pragma("unroll") for (int k = 0; k < 2; ++k) dst[m][k] = *(const PG8_LAS bf16x8*)(lds + PG8_SA(b, h) + aoff + m * 2048 + k * 1024); } while (0)
#define PG8_LDB(dst, b, h) do { _Pragma("unroll") for (int n = 0; n < 2; ++n) _Pragma("unroll") for (int k = 0; k < 2; ++k) dst[n][k] = *(const PG8_LAS bf16x8*)(lds + PG8_SB(b, h) + boff + n * 2048 + k * 1024); } while (0)
#define PG8_MMA(ai, bj, At, Bt) do { __builtin_amdgcn_s_setprio(1); _Pragma("unroll") for (int m = 0; m < 4; ++m) _Pragma("unroll") for (int n = 0; n < 2; ++n) _Pragma("unroll") for (int k = 0; k < 2; ++k) \
        acc[ai][bj][m][n] = __builtin_amdgcn_mfma_f32_16x16x32_bf16(Bt[n][k], At[m][k], acc[ai][bj][m][n], 0, 0, 0); __builtin_amdgcn_s_setprio(0); } while (0)
#define PG8_WAIT_V(n) asm volatile("s_waitcnt vmcnt(" #n ")" ::: "memory")
#define PG8_WAIT_L(n) asm volatile("s_waitcnt lgkmcnt(" #n ")" ::: "memory")
#define PG8_BAR __builtin_amdgcn_s_barrier()
#define PG8_SCHED __builtin_amdgcn_sched_barrier(0)
    Unit cur, nxt; int ui = 0;
    if (!S.next(0, cur)) return;
    f32x4 acc[2][2][4][2];
#pragma unroll
    for (int a = 0; a < 2; ++a)
#pragma unroll
        for (int b = 0; b < 2; ++b)
#pragma unroll
            for (int m = 0; m < 4; ++m)
#pragma unroll
                for (int n = 0; n < 2; ++n) acc[a][b][m][n] = (f32x4){0.f, 0.f, 0.f, 0.f};
    bf16x8 At[4][2], B0[2][2], B1[2][2];
    const char* cA = (const char*)g.A + (size_t)cur.pm * tstep; const char* cB = (const char*)g.Bt + (size_t)cur.pn * tstep;
    S.a_ready(cur);
    if constexpr (SP2) {
        PG8_STAGE(PG8_SB(0, 0), cB, voffB); PG8_STAGE(PG8_SB(0, 1), cB + hstep, voffB); PG8_STAGE(PG8_SA(0, 0), cA, voffA); PG8_STAGE(PG8_SA(0, 1), cA + hstep, voffA);
        if (wr == 1) PG8_BAR;
        PG8_WAIT_V(2); PG8_BAR;
        PG8_STAGE(PG8_SB(1, 0), cB + kstep, voffB); PG8_STAGE(PG8_SA(1, 0), cA + kstep, voffA); PG8_STAGE(PG8_SB(1, 1), cB + hstep + kstep, voffB);
        PG8_WAIT_V(6); PG8_BAR;
    } else {
        PG8_STAGE(PG8_SB(0, 0), cB, voffB); PG8_STAGE(PG8_SA(0, 0), cA, voffA); PG8_STAGE(PG8_SB(0, 1), cB + hstep, voffB); PG8_STAGE(PG8_SA(0, 1), cA + hstep, voffA);
        if (wr == 1) PG8_BAR;
        PG8_WAIT_V(4); PG8_BAR;
        PG8_STAGE(PG8_SB(1, 0), cB + kstep, voffB); PG8_STAGE(PG8_SA(1, 0), cA + kstep, voffA); PG8_STAGE(PG8_SB(1, 1), cB + hstep + kstep, voffB);
        PG8_WAIT_V(6); PG8_BAR;
    }
    for (;;) {
        const bool has_next = S.next(ui + 1, nxt);
        const char* nA = has_next ? (const char*)g.A + (size_t)nxt.pm * tstep : cA; const char* nB = has_next ? (const char*)g.Bt + (size_t)nxt.pn * tstep : cB;
        for (int t = 0; t < nt; t += 2) {
            const bool last = (t == nt - 2);
            const char* a1 = cA + (size_t)(t + 1) * kstep;
            const char* a2 = last ? nA : cA + (size_t)(t + 2) * kstep; const char* b2 = last ? nB : cB + (size_t)(t + 2) * kstep;
            const char* a3 = a2 + kstep; const char* b3 = b2 + kstep;
            if (last && has_next) S.a_ready(nxt);
            if constexpr (SP2) {
            PG8_LDB(B0, 0, 0); PG8_LDB(B1, 0, 1); PG8_SCHED; PG8_LDA(At, 0, 0); PG8_STAGE(PG8_SA(1, 1), a1 + hstep, voffA);
            PG8_WAIT_V(8); PG8_WAIT_L(0); PG8_BAR; PG8_MMA(0, 0, At, B0); PG8_MMA(0, 1, At, B1); PG8_BAR; PG8_SCHED;
            PG8_LDA(At, 0, 1); PG8_STAGE(PG8_SB(0, 0), b2, voffB); PG8_STAGE(PG8_SB(0, 1), b2 + hstep, voffB); PG8_STAGE(PG8_SA(0, 0), a2, voffA);
            PG8_WAIT_V(8); PG8_WAIT_L(0); PG8_BAR; PG8_MMA(1, 0, At, B0); PG8_MMA(1, 1, At, B1); PG8_BAR; PG8_SCHED;
            PG8_LDB(B0, 1, 0); PG8_LDB(B1, 1, 1); PG8_SCHED; PG8_LDA(At, 1, 0); PG8_STAGE(PG8_SA(0, 1), a2 + hstep, voffA);
            PG8_WAIT_V(8); PG8_WAIT_L(0); PG8_BAR; PG8_MMA(0, 0, At, B0); PG8_MMA(0, 1, At, B1); PG8_BAR; PG8_SCHED;
            PG8_LDA(At, 1, 1); PG8_STAGE(PG8_SB(1, 0), b3, voffB); PG8_STAGE(PG8_SB(1, 1), b3 + hstep, voffB); PG8_STAGE(PG8_SA(1, 0), a3, voffA);
            PG8_WAIT_V(8); PG8_WAIT_L(0); PG8_BAR; PG8_MMA(1, 0, At, B0); PG8_MMA(1, 1, At, B1); PG8_BAR; PG8_SCHED;
            } else {
            PG8_LDB(B0, 0, 0); PG8_SCHED; PG8_LDA(At, 0, 0); PG8_STAGE(PG8_SA(1, 1), a1 + hstep, voffA);
            PG8_WAIT_L(8); PG8_BAR; PG8_WAIT_L(0); PG8_MMA(0, 0, At, B0); PG8_BAR; PG8_SCHED;
            PG8_LDB(B1, 0, 1); PG8_STAGE(PG8_SB(0, 0), b2, voffB);
            PG8_BAR; PG8_WAIT_L(0); PG8_MMA(0, 1, At, B1); PG8_BAR;
            PG8_LDA(At, 0, 1); PG8_STAGE(PG8_SA(0, 0), a2, voffA);
            PG8_BAR; PG8_WAIT_L(0); PG8_MMA(1, 0, At, B0); PG8_BAR; PG8_SCHED;
            PG8_STAGE(PG8_SB(0, 1), b2 + hstep, voffB);
            PG8_WAIT_V(6); PG8_BAR; PG8_MMA(1, 1, At, B1); PG8_BAR;
            PG8_LDB(B0, 1, 0); PG8_SCHED; PG8_LDA(At, 1, 0); PG8_STAGE(PG8_SA(0, 1), a2 + hstep, voffA);
            PG8_WAIT_L(8); PG8_BAR; PG8_WAIT_L(0); PG8_MMA(0, 0, At, B0); PG8_BAR; PG8_SCHED;
            PG8_LDB(B1, 1, 1); PG8_STAGE(PG8_SB(1, 0), b3, voffB);
            PG8_BAR; PG8_WAIT_L(0); PG8_MMA(0, 1, At, B1); PG8_BAR;
            PG8_LDA(At, 1, 1); PG8_STAGE(PG8_SA(1, 0), a3, voffA);
            PG8_BAR; PG8_WAIT_L(0); PG8_MMA(1, 0, At, B0); PG8_BAR; PG8_SCHED;
            PG8_STAGE(PG8_SB(1, 1), b3 + hstep, voffB);
            PG8_WAIT_V(6); PG8_BAR; PG8_MMA(1, 1, At, B1); PG8_BAR;
            }
        }
        if constexpr (ALIGN_EPI) { if (wr == 0) PG8_BAR; }
        if constexpr (!Epi::AFTER_DRAIN) { E(acc, cur, wr, wc, fr, fq); S.done(cur); }
        if (!has_next) break;
#pragma unroll
        for (int a = 0; a < 2; ++a)
#pragma unroll
            for (int b = 0; b < 2; ++b)
#pragma unroll
                for (int m = 0; m < 4; ++m)
#pragma unroll
                    for (int n = 0; n < 2; ++n) acc[a][b][m][n] = (f32x4){0.f, 0.f, 0.f, 0.f};
        cur = nxt; cA = nA; cB = nB; ++ui;
        if constexpr (ALIGN_EPI) { if (wr == 1) PG8_BAR; }
    }
    PG8_WAIT_V(0);
    if constexpr (!ALIGN_EPI) { if (wr == 0) PG8_BAR; }
    PG8_BAR;
    if constexpr (Epi::AFTER_DRAIN) { E.fused(acc, cur, wr, wc, fr, fq, lds, wid, lane); S.done(cur); }
#undef PG8_SA
#undef PG8_SB
#undef PG8_STAGE
#undef PG8_LDA
#undef PG8_LDB
#undef PG8_MMA
#undef PG8_WAIT_V
#undef PG8_WAIT_L
#undef PG8_BAR
#undef PG8_SCHED
}
}

#define LAS __attribute__((address_space(3)))
namespace mk {
using pg8::bf16_t; using pg8::bf16x8; using pg8::f32x4; using pg8::u32x4; using pg8::Unit;
typedef unsigned u32x2 __attribute__((ext_vector_type(2)));

constexpr int M = 16384, D = 1024, SEQ = 2048, FF = 4096, PLE = 256, NIN = 6656;
constexpr float EPS = 1e-6f;
constexpr size_t MiB = 1u << 20;
constexpr size_t WS_VSTAT = 0;
constexpr size_t WS_RSS2 = 128 * 1024;
constexpr size_t WS_RSS3 = 192 * 1024;
constexpr size_t WS_RSS4 = 256 * 1024;
constexpr size_t WS_RGLA = 320 * 1024;
constexpr size_t WS_BAR = 576 * 1024;
constexpr size_t WS_BHC = 576 * 1024 + 256;
constexpr size_t WS_P35 = 576 * 1024 + 256 + 8192;
constexpr size_t WS_PCNT = 592 * 1024;
constexpr size_t WS_ZERO_END = 640 * 1024;
constexpr size_t WS_XBAR = 640 * 1024;
constexpr size_t WS_WSB = 1 * MiB;
constexpr size_t WS_WIN = 2 * MiB;
constexpr size_t WS_WA = 15 * MiB;
constexpr size_t WS_WB = 16 * MiB;
constexpr size_t WS_WO = 18 * MiB;
constexpr size_t WS_WUP = 20 * MiB;
constexpr size_t WS_WDN = 28 * MiB;
constexpr size_t WS_WPG = 36 * MiB;
constexpr size_t WS_WPP = 38 * MiB;
constexpr size_t WS_PB = 39 * MiB;
constexpr size_t WS_H = 47 * MiB;
constexpr size_t WS_U = 79 * MiB;
constexpr size_t WS_VSG = 95 * MiB;
constexpr size_t WS_V = 111 * MiB;
constexpr size_t WS_OG = 143 * MiB;
constexpr size_t WS_BGA = 175 * MiB;
constexpr size_t WS_BGB = 207 * MiB;
constexpr size_t WS_UP = 79 * MiB;
constexpr size_t WS_XB = 207 * MiB;
constexpr size_t WS_GPART = 239 * MiB;
constexpr size_t WS_END = 243 * MiB;
constexpr size_t DO_Q = 0, DO_K = 16 * MiB, DO_LA = 32 * MiB;

constexpr int LDS_BYTES = 147456;

struct Params { const float* in[21]; float* out; unsigned char* ws; };

__device__ __forceinline__ unsigned f2bf(float f) { unsigned u = __builtin_bit_cast(unsigned, f); return (u + 0x7fffu + ((u >> 16) & 1u)) >> 16; }
__device__ __forceinline__ unsigned pk2(float lo, float hi) { return pg8::cvt_pk_bf16(lo, hi); }
__device__ __forceinline__ float bf_lo(unsigned u) { return __uint_as_float(u << 16); }
__device__ __forceinline__ float bf_hi(unsigned u) { return __uint_as_float(u & 0xffff0000u); }
__device__ __forceinline__ u32x4 pack8(f32x4 a, f32x4 b) { u32x4 w; w.x = pk2(a[0], a[1]); w.y = pk2(a[2], a[3]); w.z = pk2(b[0], b[1]); w.w = pk2(b[2], b[3]); return w; }
__device__ __forceinline__ u32x2 pack4(f32x4 a) { u32x2 w; w.x = pk2(a[0], a[1]); w.y = pk2(a[2], a[3]); return w; }
__device__ __forceinline__ void unpack8(u32x4 w, f32x4& a, f32x4& b) { a[0] = bf_lo(w.x); a[1] = bf_hi(w.x); a[2] = bf_lo(w.y); a[3] = bf_hi(w.y); b[0] = bf_lo(w.z); b[1] = bf_hi(w.z); b[2] = bf_lo(w.w); b[3] = bf_hi(w.w); }
__device__ __forceinline__ f32x4 unpack4(u32x2 w) { f32x4 a; a[0] = bf_lo(w.x); a[1] = bf_hi(w.x); a[2] = bf_lo(w.y); a[3] = bf_hi(w.y); return a; }
__device__ __forceinline__ float sigmoid_f(float x) { return __builtin_amdgcn_rcpf(1.f + __expf(-x)); }
__device__ __forceinline__ float gelu_f(float x) { const float t = 1.5957691216057308f * (x + 0.044715f * x * x * x); return x * sigmoid_f(t); }
__device__ __forceinline__ float silu_f(float x) { return x * sigmoid_f(x); }
__device__ __forceinline__ float logsig_f(float x) { return fminf(x, 0.f) - __logf(1.f + __expf(-fabsf(x))); }
__device__ __forceinline__ float wave_sum(float v) {
#pragma unroll
    for (int o = 1; o < 64; o <<= 1) v += __shfl_xor(v, o);
    return v;
}
__device__ __forceinline__ void atomic_add_agent(float* p, float v) { (void)__hip_atomic_fetch_add(p, v, __ATOMIC_RELAXED, __HIP_MEMORY_SCOPE_AGENT); }
__device__ __forceinline__ void lds_barrier() { asm volatile("s_waitcnt lgkmcnt(0)" ::: "memory"); __builtin_amdgcn_s_barrier(); asm volatile("" ::: "memory"); }
#define LDS_WAIT() asm volatile("s_waitcnt lgkmcnt(0)" ::: "memory")

enum { ACT_NONE = 0, ACT_GELU, ACT_SILU, ACT_SIGM, ACT_SCALE, ACT_LOGSIG };
enum { LAY_512 = 0, LAY_1024, LAY_BLK };
template <int ACT> __device__ __forceinline__ float act1(float x) {
    if (ACT == ACT_GELU) return gelu_f(x);
    if (ACT == ACT_SILU) return silu_f(x);
    if (ACT == ACT_SIGM) return sigmoid_f(x);
    if (ACT == ACT_SCALE) return x * 0.08838834764831845f;
    if (ACT == ACT_LOGSIG) return logsig_f(x) * 0.0625f;
    return x;
}
struct EpiIn {
    static constexpr bool PERM = true, AFTER_DRAIN = false;
    bf16_t *U, *VSG, *Q, *K, *V, *LA, *OG, *BGA, *BGB; float* vstat; const float* bgate;
    template <int ACT, int LAY, bool STATS, bool BIAS> __device__ __forceinline__ void run(const f32x4 (&acc)[2][2][4][2], bf16_t* base, int rowb, int colb, int fq) const {
        f32x4 b0[2], b1[2];
#pragma unroll
        for (int bj = 0; bj < 2; ++bj) { if (BIAS) { b0[bj] = *(const f32x4*)(bgate + colb + bj * 128); b1[bj] = *(const f32x4*)(bgate + colb + bj * 128 + 4); } else { b0[bj] = (f32x4){0.f, 0.f, 0.f, 0.f}; b1[bj] = b0[bj]; } }
#pragma unroll
        for (int ai = 0; ai < 2; ++ai)
#pragma unroll
            for (int m = 0; m < 4; ++m) {
                const int row = rowb + ai * 128 + m * 16; float s1 = 0.f, s2 = 0.f;
#pragma unroll
                for (int bj = 0; bj < 2; ++bj) {
                    const int col = colb + bj * 128; f32x4 v0 = acc[ai][bj][m][0] + b0[bj], v1 = acc[ai][bj][m][1] + b1[bj];
#pragma unroll
                    for (int j = 0; j < 4; ++j) { v0[j] = act1<ACT>(v0[j]); v1[j] = act1<ACT>(v1[j]); }
                    const u32x4 w = pack8(v0, v1);
                    if (STATS) { f32x4 r0, r1; unpack8(w, r0, r1);
#pragma unroll
                        for (int j = 0; j < 4; ++j) { s1 += r0[j] + r1[j]; s2 += r0[j] * r0[j] + r1[j] * r1[j]; } }
                    size_t off;
                    if (LAY == LAY_512) off = (size_t)row * 512 + col;
                    else if (LAY == LAY_1024) off = (size_t)row * 1024 + col;
                    else off = ((size_t)(row >> 6) * 4 + (col >> 7)) * 8192 + (size_t)(row & 63) * 128 + (col & 127);
                    *(u32x4*)(base + off) = w;
                }
                asm volatile("" ::: "memory");
                if (STATS) { s1 += __shfl_xor(s1, 16); s1 += __shfl_xor(s1, 32); s2 += __shfl_xor(s2, 16); s2 += __shfl_xor(s2, 32);
                    if (fq == 0) { atomic_add_agent(vstat + 2 * row, s1); atomic_add_agent(vstat + 2 * row + 1, s2); } }
            }
    }
    __device__ __forceinline__ void operator()(const f32x4 (&acc)[2][2][4][2], const Unit& u, int wr, int wc, int fr, int fq) const {
        const int rowb = u.pm * 256 + wr * 64 + fr, cw = wc * 32 + 8 * fq, pn = u.pn;
        if (pn < 2) run<ACT_GELU, LAY_512, false, false>(acc, U, rowb, pn * 256 + cw, fq);
        else if (pn < 4) run<ACT_GELU, LAY_512, true, false>(acc, VSG, rowb, (pn - 2) * 256 + cw, fq);
        else if (pn < 6) run<ACT_SCALE, LAY_BLK, false, false>(acc, Q, rowb, (pn - 4) * 256 + cw, fq);
        else if (pn < 8) run<ACT_NONE, LAY_BLK, false, false>(acc, K, rowb, (pn - 6) * 256 + cw, fq);
        else if (pn < 12) run<ACT_NONE, LAY_1024, false, false>(acc, V, rowb, (pn - 8) * 256 + cw, fq);
        else if (pn < 14) run<ACT_LOGSIG, LAY_BLK, false, true>(acc, LA, rowb, (pn - 12) * 256 + cw, fq);
        else if (pn < 18) run<ACT_SILU, LAY_1024, false, false>(acc, OG, rowb, (pn - 14) * 256 + cw, fq);
        else if (pn < 22) run<ACT_SIGM, LAY_1024, false, false>(acc, BGA, rowb, (pn - 18) * 256 + cw, fq);
        else run<ACT_SIGM, LAY_1024, false, false>(acc, BGB, rowb, (pn - 22) * 256 + cw, fq);
    }
};
template <bool ACCUM> struct EpiMerge {
    static constexpr bool PERM = true, AFTER_DRAIN = false;
    bf16_t* MG; const bf16_t* G;
    __device__ __forceinline__ void operator()(const f32x4 (&acc)[2][2][4][2], const Unit& u, int wr, int wc, int fr, int fq) const {
        const int rowb = u.pm * 256 + wr * 64 + fr, colb = u.pn * 256 + wc * 32 + 8 * fq;
#pragma unroll
        for (int ai = 0; ai < 2; ++ai)
#pragma unroll
            for (int m = 0; m < 4; ++m)
#pragma unroll
                for (int bj = 0; bj < 2; ++bj) {
                    const size_t off = (size_t)(rowb + ai * 128 + m * 16) * 1024 + colb + bj * 128;
                    f32x4 g0, g1; unpack8(__builtin_nontemporal_load((const u32x4*)(G + off)), g0, g1);
                    f32x4 v0 = acc[ai][bj][m][0] * g0, v1 = acc[ai][bj][m][1] * g1;
                    if (ACCUM) { f32x4 p0, p1; unpack8(*(const u32x4*)(MG + off), p0, p1); v0 += p0; v1 += p1; }
                    *(u32x4*)(MG + off) = pack8(v0, v1);
                    asm volatile("" ::: "memory");
                }
    }
};
template <bool BF16_BASE> struct EpiRes {
    static constexpr bool PERM = true, AFTER_DRAIN = false;
    const float* base; bf16_t* xb; float* rss;
    __device__ __forceinline__ void operator()(const f32x4 (&acc)[2][2][4][2], const Unit& u, int wr, int wc, int fr, int fq) const {
        const int rowb = u.pm * 256 + wr * 64 + fr, colb = u.pn * 256 + wc * 32 + 8 * fq;
#pragma unroll
        for (int ai = 0; ai < 2; ++ai)
#pragma unroll
            for (int m = 0; m < 4; ++m) {
                const int row = rowb + ai * 128 + m * 16; float ss = 0.f;
#pragma unroll
                for (int bj = 0; bj < 2; ++bj) {
                    const size_t off = (size_t)row * 1024 + colb + bj * 128;
                    f32x4 v0, v1;
                    if (BF16_BASE) unpack8(*(const u32x4*)(xb + off), v0, v1); else { v0 = __builtin_nontemporal_load((const f32x4*)(base + off)); v1 = __builtin_nontemporal_load((const f32x4*)(base + off + 4)); }
                    v0 += acc[ai][bj][m][0]; v1 += acc[ai][bj][m][1];
                    *(u32x4*)(xb + off) = pack8(v0, v1);
#pragma unroll
                    for (int j = 0; j < 4; ++j) ss += v0[j] * v0[j] + v1[j] * v1[j];
                }
                ss += __shfl_xor(ss, 16); ss += __shfl_xor(ss, 32);
                if (fq == 0) atomic_add_agent(rss + row, ss);
                asm volatile("" ::: "memory");
            }
    }
};
struct EpiUp {
    static constexpr bool PERM = true, AFTER_DRAIN = false;
    bf16_t* UPB; const float* rss;
    __device__ __forceinline__ void operator()(const f32x4 (&acc)[2][2][4][2], const Unit& u, int wr, int wc, int fr, int fq) const {
        const int rowb = u.pm * 256 + wr * 64 + fr, colb = u.pn * 256 + wc * 32 + 8 * fq;
#pragma unroll
        for (int ai = 0; ai < 2; ++ai)
#pragma unroll
            for (int m = 0; m < 4; ++m) {
                const int row = rowb + ai * 128 + m * 16; const float rs = rsqrtf(rss[row] * (1.f / 1024.f) + EPS);
#pragma unroll
                for (int bj = 0; bj < 2; ++bj) {
                    f32x4 v0 = acc[ai][bj][m][0] * rs, v1 = acc[ai][bj][m][1] * rs;
#pragma unroll
                    for (int j = 0; j < 4; ++j) { const float a = fmaxf(v0[j], 0.f), b = fmaxf(v1[j], 0.f); v0[j] = a * a; v1[j] = b * b; }
                    *(u32x4*)(UPB + (size_t)row * 4096 + colb + bj * 128) = pack8(v0, v1);
                }
                asm volatile("" ::: "memory");
            }
    }
};
struct EpiPlain {
    static constexpr bool PERM = true, AFTER_DRAIN = false;
    bf16_t* O;
    __device__ __forceinline__ void operator()(const f32x4 (&acc)[2][2][4][2], const Unit& u, int wr, int wc, int fr, int fq) const {
        const int rowb = u.pm * 256 + wr * 64 + fr, colb = u.pn * 256 + wc * 32 + 8 * fq;
#pragma unroll
        for (int ai = 0; ai < 2; ++ai)
#pragma unroll
            for (int m = 0; m < 4; ++m)
#pragma unroll
                for (int bj = 0; bj < 2; ++bj)
                    *(u32x4*)(O + (size_t)(rowb + ai * 128 + m * 16) * 1024 + colb + bj * 128) = pack8(acc[ai][bj][m][0], acc[ai][bj][m][1]);
    }
};
struct EpiPleGate {
    static constexpr bool PERM = true, AFTER_DRAIN = false;
    float* x; const bf16_t* xb; const bf16_t* PLEB; const float* rss_in; float* rss_out;
    __device__ __forceinline__ void operator()(const f32x4 (&acc)[2][2][4][2], const Unit& u, int wr, int wc, int fr, int fq) const {
        const int rowb = u.pm * 256 + wr * 64 + fr, colb = u.pn * 256 + wc * 32 + 8 * fq;
#pragma unroll
        for (int ai = 0; ai < 2; ++ai)
#pragma unroll
            for (int m = 0; m < 4; ++m) {
                const int row = rowb + ai * 128 + m * 16; const float rs = rsqrtf(rss_in[row] * (1.f / 1024.f) + EPS); float ss = 0.f;
#pragma unroll
                for (int bj = 0; bj < 2; ++bj) {
                    const size_t off = (size_t)row * 1024 + colb + bj * 128;
                    f32x4 p0, p1; unpack8(*(const u32x4*)(PLEB + off), p0, p1);
                    f32x4 v0, v1; unpack8(*(const u32x4*)(xb + off), v0, v1);
#pragma unroll
                    for (int j = 0; j < 4; ++j) { v0[j] += sigmoid_f(acc[ai][bj][m][0][j] * rs) * p0[j]; v1[j] += sigmoid_f(acc[ai][bj][m][1][j] * rs) * p1[j]; ss += v0[j] * v0[j] + v1[j] * v1[j]; }
                    *(f32x4*)(x + off) = v0; *(f32x4*)(x + off + 4) = v1;
                }
                ss += __shfl_xor(ss, 16); ss += __shfl_xor(ss, 32);
                if (fq == 0) atomic_add_agent(rss_out + row, ss);
                asm volatile("" ::: "memory");
            }
    }
};

struct EpiPleFinal {
    static constexpr bool PERM = true, AFTER_DRAIN = true;
    float* out; const bf16_t* xb; const bf16_t* PLEB; const float* rss_in; float* rss_out; unsigned* pcnt; const float* gfin; bool same_xcd;
    __device__ __forceinline__ void fused(f32x4 (&acc)[2][2][4][2], const Unit& u, int wr, int wc, int fr, int fq, PG8_LAS unsigned char* lds, int wid, int lane) const {
        const int rowb = u.pm * 256 + wr * 64 + fr, colb = u.pn * 256 + wc * 32 + 8 * fq;
#pragma unroll
        for (int ai = 0; ai < 2; ++ai)
#pragma unroll
            for (int m = 0; m < 4; ++m) {
                const int row = rowb + ai * 128 + m * 16; const float rs = rsqrtf(rss_in[row] * (1.f / 1024.f) + EPS); float ss = 0.f;
#pragma unroll
                for (int bj = 0; bj < 2; ++bj) {
                    const size_t off = (size_t)row * 1024 + colb + bj * 128;
                    f32x4 p0, p1; unpack8(*(const u32x4*)(PLEB + off), p0, p1);
                    f32x4 v0, v1; unpack8(*(const u32x4*)(xb + off), v0, v1);
#pragma unroll
                    for (int j = 0; j < 4; ++j) { v0[j] += sigmoid_f(acc[ai][bj][m][0][j] * rs) * p0[j]; v1[j] += sigmoid_f(acc[ai][bj][m][1][j] * rs) * p1[j]; ss += v0[j] * v0[j] + v1[j] * v1[j]; }
                    acc[ai][bj][m][0] = v0; acc[ai][bj][m][1] = v1;
                }
                ss += __shfl_xor(ss, 16); ss += __shfl_xor(ss, 32);
                if (fq == 0) atomic_add_agent(rss_out + row, ss);
                asm volatile("" ::: "memory");
            }
        asm volatile("s_waitcnt vmcnt(0)" ::: "memory");
        __syncthreads();
        if (wid == 0 && lane == 0) {
            unsigned* c = pcnt + 32 * u.pm;
            if (!same_xcd) { __builtin_amdgcn_fence(__ATOMIC_RELEASE, "agent"); asm volatile("s_waitcnt vmcnt(0)" ::: "memory"); }
            __hip_atomic_fetch_add(c, 1u, __ATOMIC_RELAXED, __HIP_MEMORY_SCOPE_AGENT);
            while (__hip_atomic_load(c, __ATOMIC_RELAXED, __HIP_MEMORY_SCOPE_AGENT) < 4u) __builtin_amdgcn_s_sleep(1);
            __builtin_amdgcn_fence(__ATOMIC_ACQUIRE, "agent"); asm volatile("s_waitcnt vmcnt(0)" ::: "memory");
        }
        __syncthreads();
        f32x4 g0[2], g1[2];
#pragma unroll
        for (int bj = 0; bj < 2; ++bj) { g0[bj] = *(const f32x4*)(gfin + colb + bj * 128); g1[bj] = *(const f32x4*)(gfin + colb + bj * 128 + 4); }
        float rf[2][4];
#pragma unroll
        for (int ai = 0; ai < 2; ++ai)
#pragma unroll
            for (int m = 0; m < 4; ++m) rf[ai][m] = __hip_atomic_load(rss_out + rowb + ai * 128 + m * 16, __ATOMIC_RELAXED, __HIP_MEMORY_SCOPE_AGENT);
        const int tid = wid * 64 + lane;
#pragma unroll
        for (int ai = 0; ai < 2; ++ai) {
#pragma unroll
            for (int m = 0; m < 4; ++m) {
                const float rs = rsqrtf(rf[ai][m] * (1.f / 1024.f) + EPS);
                const int rowl = wr * 64 + m * 16 + fr;
#pragma unroll
                for (int bj = 0; bj < 2; ++bj) {
                    const int c = bj * 32 + wc * 8 + 2 * fq;
                    *(PG8_LAS f32x4*)(lds + rowl * 1024 + (((c) ^ (rowl & 63)) << 4)) = acc[ai][bj][m][0] * rs * g0[bj];
                    *(PG8_LAS f32x4*)(lds + rowl * 1024 + (((c + 1) ^ (rowl & 63)) << 4)) = acc[ai][bj][m][1] * rs * g1[bj];
                }
            }
            lds_barrier();
#pragma unroll
            for (int k = 0; k < 16; ++k) { const int e = tid + 512 * k, rowl = e >> 6, c = e & 63;
                const f32x4 v = *(const PG8_LAS f32x4*)(lds + rowl * 1024 + ((c ^ (rowl & 63)) << 4));
                *(f32x4*)(out + (size_t)(u.pm * 256 + ai * 128 + rowl) * 1024 + u.pn * 256 + c * 4) = v; }
            lds_barrier();
        }
    }
};

template <class Epi, bool ALIGN = true> __device__ __forceinline__ void run_gemm(LAS unsigned char* lds, const bf16_t* A, const bf16_t* Bt, int N, int K, const Epi& E) {
    asm volatile("" : "+s"(K));
    pg8::Gemm g{A, Bt, M, N, K}; pg8::StaticOrder S; S.init(M, N, (int)gridDim.x, (int)blockIdx.x);
    pg8::gemm_phase<Epi, pg8::StaticOrder, ALIGN, true>(lds, g, S, E);
}

struct TrDesc { const float* W; const float* ksc; bf16_t* WT; int ldw, K, ncols, row_off, r; };
__device__ __forceinline__ void tr_load(const TrDesc& d, float (&wv)[32], int lane) {
    const int nblk = d.ncols / 32, kb = d.r / nblk, nb = d.r % nblk, k0 = 64 * kb, n0 = 32 * nb;
#pragma unroll
    for (int i = 0; i < 32; ++i) wv[i] = __builtin_nontemporal_load(d.W + (size_t)(k0 + 2 * i + (lane >> 5)) * d.ldw + n0 + (lane & 31));
}
__device__ __forceinline__ void tr_finish(const TrDesc& d, float (&wv)[32], LAS float* scr, int lane) {
    const int nblk = d.ncols / 32, kb = d.r / nblk, nb = d.r % nblk, k0 = 64 * kb, n0 = 32 * nb;
    if (d.ksc) {
#pragma unroll
        for (int i = 0; i < 32; ++i) wv[i] *= d.ksc[k0 + 2 * i + (lane >> 5)];
    }
#pragma unroll
    for (int i = 0; i < 32; ++i) scr[(2 * i + (lane >> 5)) * 33 + (lane & 31)] = wv[i];
    LDS_WAIT();
    const int c = lane & 7;
#pragma unroll
    for (int j = 0; j < 4; ++j) { const int n = (lane >> 3) + 8 * j; const LAS float* s = scr + (8 * c) * 33 + n;
        u32x4 o; o.x = pk2(s[0 * 33], s[1 * 33]); o.y = pk2(s[2 * 33], s[3 * 33]); o.z = pk2(s[4 * 33], s[5 * 33]); o.w = pk2(s[6 * 33], s[7 * 33]);
        *(u32x4*)(d.WT + (size_t)(d.row_off + n0 + n) * d.K + k0 + 8 * c) = o; }
    LDS_WAIT();
}
__device__ __forceinline__ void comb_item(const float* Win, const float* Wgu, bf16_t* WT, LAS float* scr, int item, int lane) {
    const int nblk = 512 / 32, kb = item / nblk, nb = item % nblk, k0 = 64 * kb, n0 = 32 * nb;
    float g[16];
#pragma unroll
    for (int r = 0; r < 16; ++r) g[r] = Wgu[r * 512 + n0 + (lane & 31)];
#pragma unroll 8
    for (int i = 0; i < 32; ++i) { const int kk = 2 * i + (lane >> 5); const f32x4* wr_ = (const f32x4*)(Win + (size_t)(k0 + kk) * 6160 + 3072);
        const f32x4 a = wr_[0], b = wr_[1], c = wr_[2], d = wr_[3]; float s = 0.f;
#pragma unroll
        for (int r = 0; r < 4; ++r) s += a[r] * g[r] + b[r] * g[4 + r] + c[r] * g[8 + r] + d[r] * g[12 + r];
        scr[kk * 33 + (lane & 31)] = s; }
    LDS_WAIT();
    const int c = lane & 7;
#pragma unroll
    for (int j = 0; j < 4; ++j) { const int n = (lane >> 3) + 8 * j; const LAS float* s = scr + (8 * c) * 33 + n;
        u32x4 o; o.x = pk2(s[0 * 33], s[1 * 33]); o.y = pk2(s[2 * 33], s[3 * 33]); o.z = pk2(s[4 * 33], s[5 * 33]); o.w = pk2(s[6 * 33], s[7 * 33]);
        *(u32x4*)(WT + (size_t)(3072 + n0 + n) * 1024 + k0 + 8 * c) = o; }
    LDS_WAIT();
}

constexpr int I_IN1 = 16 * 96, I_IN2 = 16 * 96, I_A = 8 * 32, I_B = 16 * 32, I_O = 16 * 32, I_UP = 16 * 128, I_DN = 64 * 32, I_PG = 16 * 32, I_PP = 4 * 32;
constexpr int TR_EARLY = I_IN1 + I_IN2, TR_ALL = I_IN1 + I_IN2 + I_A + I_B + I_O + I_UP + I_DN + I_PG + I_PP;
__device__ __forceinline__ void tr_run(const Params& p, LAS float* scr, int lane, int first, int count, int w0, int nw) {
    unsigned char* ws = p.ws;
#define TR_DECODE(d, it_) do { int r = (it_); d.W = p.in[3]; d.ksc = nullptr; d.ldw = 6160; d.K = 1024; d.ncols = 3072; d.row_off = 0; size_t wto = WS_WIN; \
        if (r < I_IN1) { } \
        else if ((r -= I_IN1) < I_IN2) { d.W = p.in[3] + 3088; d.row_off = 3584; } \
        else if ((r -= I_IN2) < I_A) { d.W = p.in[8]; d.ldw = 1024; d.K = 512; d.ncols = 1024; wto = WS_WA; } \
        else if ((r -= I_A) < I_B) { d.W = p.in[12]; d.ldw = 1024; d.ncols = 1024; wto = WS_WB; } \
        else if ((r -= I_B) < I_O) { d.W = p.in[13]; d.ldw = 1024; d.ncols = 1024; wto = WS_WO; } \
        else if ((r -= I_O) < I_UP) { d.W = p.in[15]; d.ldw = 4096; d.ncols = 4096; wto = WS_WUP; d.ksc = p.in[14]; } \
        else if ((r -= I_UP) < I_DN) { d.W = p.in[16]; d.ldw = 1024; d.K = 4096; d.ncols = 1024; wto = WS_WDN; } \
        else if ((r -= I_DN) < I_PG) { d.W = p.in[18]; d.ldw = 1024; d.ncols = 1024; wto = WS_WPG; d.ksc = p.in[17]; } \
        else { r -= I_PG; d.W = p.in[19]; d.ldw = 1024; d.K = 256; d.ncols = 1024; wto = WS_WPP; } \
        d.r = r; d.WT = (bf16_t*)(ws + wto); } while (0)
    const int end = first + count;
    for (int it = first + w0; it < end; it += 2 * nw) {
        const int it1 = it + nw; const bool has1 = it1 < end;
        TrDesc d0, d1; TR_DECODE(d0, it); TR_DECODE(d1, has1 ? it1 : it);
        float a[32], b[32];
        tr_load(d0, a, lane); tr_load(d1, b, lane);
        tr_finish(d0, a, scr, lane);
        if (has1) tr_finish(d1, b, scr, lane);
    }
#undef TR_DECODE
}

__device__ __forceinline__ void phase_prologue(const Params& p, LAS unsigned char* lds) {
    int tid_ = threadIdx.x; asm volatile("" : "+v"(tid_)); const int tid = tid_, lane = tid & 63, wave = tid >> 6, G = gridDim.x;
    const int gw = blockIdx.x * 8 + wave, NGW = G * 8;
    const int gt = blockIdx.x * 512 + tid, NGT = G * 512;
    unsigned char* ws = p.ws;
    LAS float* scr = (LAS float*)(lds + wave * 16384);
    for (int i = gt; i < (int)(WS_ZERO_END / 4); i += NGT) ((float*)ws)[i] = 0.f;
    {
        const f32x4* gm = (const f32x4*)p.in[2] + lane;
        const f32x4 g0 = gm[0], g1 = gm[64], g2 = gm[128], g3 = gm[192];
        for (int m = gw; m < M; m += 4 * NGW) {
            f32x4 v[4][4]; int mr[4];
#pragma unroll
            for (int q = 0; q < 4; ++q) { mr[q] = m + q * NGW; const int ml = mr[q] < M ? mr[q] : m; const f32x4* xr = (const f32x4*)(p.in[0] + (size_t)ml * D) + lane;
                v[q][0] = __builtin_nontemporal_load(xr); v[q][1] = __builtin_nontemporal_load(xr + 64); v[q][2] = __builtin_nontemporal_load(xr + 128); v[q][3] = __builtin_nontemporal_load(xr + 192); }
#pragma unroll
            for (int q = 0; q < 4; ++q) {
                float s = 0.f;
#pragma unroll
                for (int j = 0; j < 4; ++j) s += v[q][0][j] * v[q][0][j] + v[q][1][j] * v[q][1][j] + v[q][2][j] * v[q][2][j] + v[q][3][j] * v[q][3][j];
                const float rs = rsqrtf(wave_sum(s) * (1.f / 1024.f) + EPS);
                if (mr[q] < M) { u32x2* o = (u32x2*)(ws + WS_H + (size_t)mr[q] * 2048) + lane;
                    o[0] = pack4(v[q][0] * rs * g0); o[64] = pack4(v[q][1] * rs * g1); o[128] = pack4(v[q][2] * rs * g2); o[192] = pack4(v[q][3] * rs * g3); }
            }
        }
    }
    for (int i = gt; i < M * PLE / 8; i += 4 * NGT) {
        f32x4 a[4], b[4];
#pragma unroll
        for (int q = 0; q < 4; ++q) { const int iq = i + q * NGT, il = iq < M * PLE / 8 ? iq : i; a[q] = __builtin_nontemporal_load((const f32x4*)p.in[1] + 2 * il); b[q] = __builtin_nontemporal_load((const f32x4*)p.in[1] + 2 * il + 1); }
#pragma unroll
        for (int q = 0; q < 4; ++q) { const int iq = i + q * NGT; if (iq < M * PLE / 8) ((u32x4*)(ws + WS_PB))[iq] = pack8(a[q], b[q]); }
    }
    tr_run(p, scr, lane, 0, TR_EARLY, gw, NGW);
    { const int cw = gw - (NGW > 1280 ? 1024 : 0); for (int it = cw; it >= 0 && it < 256; it += NGW) comb_item(p.in[3], p.in[9], (bf16_t*)(ws + WS_WIN), scr, it, lane); }
    for (int i = gt; i < 4 * 128 * 128; i += NGT) { const int t = (i >> 7) & 127, s = i & 127; ((bf16_t*)(ws + WS_WSB))[i] = (bf16_t)(s <= t ? f2bf(p.in[6][i]) : 0u); }
}

struct SgRegs { u32x4 w[4], v[4]; float s1[4], s2[4]; };
__device__ __forceinline__ void sg_load(SgRegs& R, const Params& p, int item, int tid) {
    const int g = item & 3, chunk = item >> 2, m0 = chunk * 128, c0 = g * 128;
    const bf16_t* WSB = (const bf16_t*)(p.ws + WS_WSB) + g * 16384; const bf16_t* VSG = (const bf16_t*)(p.ws + WS_VSG); const float* vstat = (const float*)(p.ws + WS_VSTAT);
#pragma unroll
    for (int k = 0; k < 4; ++k) { const int e = tid + 512 * k, t = e >> 4, sv = (e & 15) * 8; R.w[k] = *(const u32x4*)(WSB + t * 128 + sv);
        const int m = m0 + t; R.v[k] = *(const u32x4*)(VSG + (size_t)m * 512 + c0 + sv); R.s1[k] = vstat[2 * m]; R.s2[k] = vstat[2 * m + 1]; }
}
__device__ __forceinline__ void sg_item(const Params& p, LAS unsigned char* lds, int item, SgRegs& C, int item_next, SgRegs& N) {
    int tid_ = threadIdx.x; asm volatile("" : "+v"(tid_)); const int tid = tid_, lane = tid & 63, w = tid >> 6, fr = lane & 15, fq = lane >> 4;
    const int g = item & 3, chunk = item >> 2, m0 = chunk * 128, c0 = g * 128;
    unsigned char* ws = p.ws;
    LAS bf16_t* VNT = (LAS bf16_t*)lds;
    LAS bf16_t* WL = (LAS bf16_t*)(lds + 34816);
    bf16_t* U = (bf16_t*)(ws + WS_U);
    const float* lng = p.in[4] + c0; const float* lnb = p.in[5] + c0;
    const int tt = w, t = 16 * tt + fr;
    u32x4 ur[4];
#pragma unroll
    for (int k = 0; k < 4; ++k) { const int e = tid + 512 * k; ur[k] = *(const u32x4*)(U + (size_t)(m0 + (e >> 4)) * 512 + c0 + (e & 15) * 8); }
    const float bias = p.in[7][g * 128 + t];
#pragma unroll
    for (int k = 0; k < 4; ++k) { const int e = tid + 512 * k, tr = e >> 4, sv = (e & 15) * 8; *(LAS u32x4*)(WL + tr * 136 + sv) = C.w[k]; }
#pragma unroll
    for (int k = 0; k < 4; ++k) {
        const int e = tid + 512 * k, sr = e >> 4, cv = (e & 15) * 8;
        f32x4 a, b; unpack8(C.v[k], a, b);
        const float mu = C.s1[k] * (1.f / 512.f), var = fmaxf(C.s2[k] * (1.f / 512.f) - mu * mu, 0.f), rs = rsqrtf(var + EPS);
        const f32x4 ga = *(const f32x4*)(lng + cv), gb = *(const f32x4*)(lng + cv + 4), ba = *(const f32x4*)(lnb + cv), bb = *(const f32x4*)(lnb + cv + 4);
        a = (a - mu) * rs * ga + ba; b = (b - mu) * rs * gb + bb;
        const int ssw = ((((sr >> 3) ^ ((cv >> 3) & 15)) << 3) + (sr & 7));
#pragma unroll
        for (int j = 0; j < 4; ++j) { VNT[(cv + j) * 136 + ssw] = (bf16_t)f2bf(a[j]); VNT[(cv + 4 + j) * 136 + ssw] = (bf16_t)f2bf(b[j]); }
    }
    if (item_next >= 0) sg_load(N, p, item_next, tid);
    lds_barrier();
    f32x4 acc[8];
#pragma unroll
    for (int tc = 0; tc < 8; ++tc) acc[tc] = (f32x4){0.f, 0.f, 0.f, 0.f};
    const int ksn = (tt >> 1) + 1;
    for (int ks = 0; ks < ksn; ++ks) {
        const bf16x8 bf = *(const LAS bf16x8*)(WL + (16 * tt + fr) * 136 + 32 * ks + 8 * fq);
#pragma unroll
        for (int tc = 0; tc < 8; ++tc) { const bf16x8 af = *(const LAS bf16x8*)(VNT + (16 * tc + fr) * 136 + (((4 * ks + fq) ^ (2 * tc + (fr >> 3))) << 3)); acc[tc] = __builtin_amdgcn_mfma_f32_16x16x32_bf16(af, bf, acc[tc], 0, 0, 0); }
    }
    lds_barrier();
    LAS float* ZS = (LAS float*)lds;
#pragma unroll
    for (int tc = 0; tc < 8; ++tc) *(LAS f32x4*)(ZS + t * 132 + 16 * tc + 4 * fq) = acc[tc] + bias;
    lds_barrier();
#pragma unroll
    for (int k = 0; k < 4; ++k) { const int e = tid + 512 * k, tr = e >> 4, cv = (e & 15) * 8;
        const f32x4 z0 = *(const LAS f32x4*)(ZS + tr * 132 + cv), z1 = *(const LAS f32x4*)(ZS + tr * 132 + cv + 4);
        f32x4 u0, u1; unpack8(ur[k], u0, u1);
        *(u32x4*)(U + (size_t)(m0 + tr) * 512 + c0 + cv) = pack8(u0 * z0, u1 * z1); }
    lds_barrier();
}

struct PrepRegs { u32x4 la[2], q[2], k[2]; };
__device__ __forceinline__ void prep_load(PrepRegs& R, const Params& p, int it, int tid) {
    const unsigned char* dob = (const unsigned char*)p.out;
    const bf16_t* Qg = (const bf16_t*)(dob + DO_Q) + (size_t)it * 8192; const bf16_t* Kg = (const bf16_t*)(dob + DO_K) + (size_t)it * 8192; const bf16_t* Lg = (const bf16_t*)(dob + DO_LA) + (size_t)it * 8192;
#pragma unroll
    for (int k = 0; k < 2; ++k) { const int e = tid + 512 * k; R.la[k] = *(const u32x4*)(Lg + (size_t)e * 8); R.q[k] = *(const u32x4*)(Qg + (size_t)e * 8); R.k[k] = *(const u32x4*)(Kg + (size_t)e * 8); }
}
__device__ __forceinline__ void gla_prep_item(const Params& p, LAS unsigned char* lds, int it, PrepRegs& C, int it_next, PrepRegs& N) {
    int tid_ = threadIdx.x; asm volatile("" : "+v"(tid_)); const int tid = tid_, lane = tid & 63, w = tid >> 6, fr = lane & 15, fq = lane >> 4;
    LAS float* BC = (LAS float*)lds;
    LAS bf16_t* QI = (LAS bf16_t*)(lds + 32768);
    LAS bf16_t* KI = (LAS bf16_t*)(lds + 32768 + 17408);
    LAS bf16_t* KDT = (LAS bf16_t*)(lds + 32768 + 2 * 17408);
    unsigned char* dob = (unsigned char*)p.out;
    bf16_t* Qg = (bf16_t*)(dob + DO_Q) + (size_t)it * 8192;
    bf16_t* Kg = (bf16_t*)(dob + DO_K) + (size_t)it * 8192;
    bf16_t* Lg = (bf16_t*)(dob + DO_LA) + (size_t)it * 8192;
#pragma unroll
    for (int k = 0; k < 2; ++k) { const int e = tid + 512 * k, i = e >> 4, dv = (e & 15) * 8; f32x4 a, b; unpack8(C.la[k], a, b);
        *(LAS f32x4*)(BC + i * 128 + dv) = a; *(LAS f32x4*)(BC + i * 128 + dv + 4) = b; }
    if (it_next >= 0) prep_load(N, p, it_next, tid);
    lds_barrier();
    { const int d = tid & 127, seg = tid >> 7; float cv_[16]; float run = 0.f;
      LAS float* TOT = (LAS float*)(lds + 86016);
#pragma unroll
      for (int r = 0; r < 16; ++r) cv_[r] = BC[(16 * seg + r) * 128 + d];
#pragma unroll
      for (int r = 0; r < 16; ++r) { run += cv_[r]; cv_[r] = run; }
      TOT[seg * 128 + d] = run;
      lds_barrier();
      float offs = 0.f;
#pragma unroll
      for (int s = 0; s < 3; ++s) if (s < seg) offs += TOT[s * 128 + d];
#pragma unroll
      for (int r = 0; r < 16; ++r) BC[(16 * seg + r) * 128 + d] = cv_[r] + offs;
    }
    lds_barrier();
#pragma unroll
    for (int k = 0; k < 2; ++k) {
        const int e = tid + 512 * k, i = e >> 4, dv = (e & 15) * 8;
        f32x4 q0, q1, k0, k1; unpack8(C.q[k], q0, q1); unpack8(C.k[k], k0, k1);
        f32x4 qd0, qd1, qi0, qi1, ki0, ki1;
        const f32x4 bi0 = *(const LAS f32x4*)(BC + i * 128 + dv), bi1 = *(const LAS f32x4*)(BC + i * 128 + dv + 4);
        const f32x4 br0 = *(const LAS f32x4*)(BC + 31 * 128 + dv), br1 = *(const LAS f32x4*)(BC + 31 * 128 + dv + 4);
        const f32x4 bl0 = *(const LAS f32x4*)(BC + 63 * 128 + dv), bl1 = *(const LAS f32x4*)(BC + 63 * 128 + dv + 4);
        const int isw = ((((i >> 3) ^ ((dv >> 3) & 7)) << 3) + (i & 7));
#pragma unroll
        for (int j = 0; j < 4; ++j) {
            { const int d = dv + j; const float bi = bi0[j], br = br0[j], bl = bl0[j];
              qd0[j] = q0[j] * __expf(bi); qi0[j] = q0[j] * __expf(bi - br); ki0[j] = k0[j] * __expf(br - bi); KDT[d * 72 + isw] = (bf16_t)f2bf(k0[j] * __expf(bl - bi)); }
            { const int d = dv + 4 + j; const float bi = bi1[j], br = br1[j], bl = bl1[j];
              qd1[j] = q1[j] * __expf(bi); qi1[j] = q1[j] * __expf(bi - br); ki1[j] = k1[j] * __expf(br - bi); KDT[d * 72 + isw] = (bf16_t)f2bf(k1[j] * __expf(bl - bi)); }
        }
        *(u32x4*)(Qg + i * 128 + dv) = pack8(qd0, qd1);
        *(LAS u32x4*)(QI + i * 136 + dv) = pack8(qi0, qi1);
        *(LAS u32x4*)(KI + i * 136 + dv) = pack8(ki0, ki1);
    }
    if (tid < 128) ((float*)Lg)[2048 + tid] = __expf(BC[63 * 128 + tid]);
    lds_barrier();
    { const int ti = w >> 1;
#pragma unroll
      for (int tjj = 0; tjj < 2; ++tjj) {
          const int tj = 2 * (w & 1) + tjj; f32x4 acc = (f32x4){0.f, 0.f, 0.f, 0.f};
#pragma unroll
          for (int ks = 0; ks < 4; ++ks) { const bf16x8 af = *(const LAS bf16x8*)(KI + (16 * tj + fr) * 136 + 32 * ks + 8 * fq), bf = *(const LAS bf16x8*)(QI + (16 * ti + fr) * 136 + 32 * ks + 8 * fq);
              acc = __builtin_amdgcn_mfma_f32_16x16x32_bf16(af, bf, acc, 0, 0, 0); }
          const int i = 16 * ti + fr, j0 = 16 * tj + 4 * fq;
#pragma unroll
          for (int r = 0; r < 4; ++r) if (j0 + r > i) acc[r] = 0.f;
          *(u32x2*)(Lg + i * 64 + j0) = pack4(acc);
      } }
#pragma unroll
    for (int k = 0; k < 2; ++k) { const int e = tid + 512 * k, d = e >> 3, jb = e & 7; *(u32x4*)(Kg + d * 64 + jb * 8) = *(const LAS u32x4*)(KDT + d * 72 + ((jb ^ ((d >> 3) & 7)) << 3)); }
    lds_barrier();
}

struct GlaRegs { u32x4 P, Q0, Q1, K0, K1, V; float D; };
__device__ __forceinline__ void gla_load(GlaRegs& R, const bf16_t* Qb, const bf16_t* Kb, const bf16_t* Lb, const bf16_t* Vb, int b, int h, int vs, int n, int tid) {
    const size_t ib = ((size_t)(b * 32 + n) * 4 + h) * 8192;
    R.P = *(const u32x4*)(Lb + ib + (size_t)tid * 8);
    R.Q0 = *(const u32x4*)(Qb + ib + (size_t)tid * 8); R.Q1 = *(const u32x4*)(Qb + ib + (size_t)(tid + 512) * 8);
    R.K0 = *(const u32x4*)(Kb + ib + (size_t)tid * 8); R.K1 = *(const u32x4*)(Kb + ib + (size_t)(tid + 512) * 8);
    if (tid < 256) R.V = __builtin_nontemporal_load((const u32x4*)(Vb + (size_t)(b * 2048 + n * 64 + (tid >> 2)) * 1024 + h * 256 + vs * 32 + (tid & 3) * 8));
    if (tid < 128) R.D = ((const float*)(Lb + ib))[2048 + tid];
}
__device__ __forceinline__ void gla_fill(LAS unsigned char* B, const GlaRegs& C, int tid) {
    LAS bf16_t* PL = (LAS bf16_t*)B; LAS bf16_t* QD = (LAS bf16_t*)(B + 9216); LAS bf16_t* KD = (LAS bf16_t*)(B + 26624); LAS bf16_t* VT = (LAS bf16_t*)(B + 45056); LAS float* DC = (LAS float*)(B + 58368);
    *(LAS u32x4*)(PL + (tid >> 3) * 72 + (tid & 7) * 8) = C.P;
    *(LAS u32x4*)(QD + (tid >> 4) * 136 + (tid & 15) * 8) = C.Q0; *(LAS u32x4*)(QD + ((tid + 512) >> 4) * 136 + (tid & 15) * 8) = C.Q1;
    *(LAS u32x4*)(KD + (tid >> 3) * 72 + (tid & 7) * 8) = C.K0; *(LAS u32x4*)(KD + ((tid + 512) >> 3) * 72 + (tid & 7) * 8) = C.K1;
    if (tid < 256) { const int jr = tid >> 2, v0 = (tid & 3) * 8, j = (((jr >> 3) ^ (v0 >> 3)) << 3) + (jr & 7); const u32x4 rV = C.V;
        VT[(v0 + 0) * 72 + j] = (bf16_t)(rV.x & 0xffffu); VT[(v0 + 1) * 72 + j] = (bf16_t)(rV.x >> 16);
        VT[(v0 + 2) * 72 + j] = (bf16_t)(rV.y & 0xffffu); VT[(v0 + 3) * 72 + j] = (bf16_t)(rV.y >> 16);
        VT[(v0 + 4) * 72 + j] = (bf16_t)(rV.z & 0xffffu); VT[(v0 + 5) * 72 + j] = (bf16_t)(rV.z >> 16);
        VT[(v0 + 6) * 72 + j] = (bf16_t)(rV.w & 0xffffu); VT[(v0 + 7) * 72 + j] = (bf16_t)(rV.w >> 16); }
    if (tid < 128) DC[tid] = C.D;
}
__device__ __forceinline__ void gla_seq(const Params& p, LAS unsigned char* lds, int bh, int vs) {
    int tid_ = threadIdx.x; asm volatile("" : "+v"(tid_)); const int tid = tid_, lane = tid & 63, w = tid >> 6, fr = lane & 15, fq = lane >> 4;
    constexpr int SETB = 58880;
    const int b = bh >> 2, h = bh & 3;
    unsigned char* dob = (unsigned char*)p.out;
    const bf16_t* Qb = (const bf16_t*)(dob + DO_Q); const bf16_t* Kb = (const bf16_t*)(dob + DO_K); const bf16_t* Lb = (const bf16_t*)(dob + DO_LA);
    bf16_t* Vb = (bf16_t*)(p.ws + WS_V);
    float* gpart = (float*)(p.ws + WS_GPART);
    for (int e = tid; e < 32 * 136 / 2; e += 512) ((LAS unsigned*)(lds + 49664))[e] = 0u;
    f32x4 S[2]; S[0] = (f32x4){0.f, 0.f, 0.f, 0.f}; S[1] = S[0];
    GlaRegs R[2];
    R[0].V = (u32x4){0u, 0u, 0u, 0u}; R[1].V = R[0].V; R[0].D = 0.f; R[1].D = 0.f;
    gla_load(R[0], Qb, Kb, Lb, Vb, b, h, vs, 0, tid);
    gla_load(R[1], Qb, Kb, Lb, Vb, b, h, vs, 1, tid);
    gla_fill(lds, R[0], tid);
    gla_load(R[0], Qb, Kb, Lb, Vb, b, h, vs, 2, tid);
    lds_barrier();
    const int ti = w >> 1, tv = w & 1;
    for (int n2 = 0; n2 < 32; n2 += 2) {
#pragma unroll
        for (int u = 0; u < 2; ++u) {
            const int n = n2 + u;
            LAS unsigned char* Bc = lds + u * SETB; LAS unsigned char* Bn = lds + (u ^ 1) * SETB;
            if (n + 1 < 32) gla_fill(Bn, R[u ^ 1], tid);
            if (n + 3 < 32) gla_load(R[u ^ 1], Qb, Kb, Lb, Vb, b, h, vs, n + 3, tid);
            const LAS bf16_t* PL = (const LAS bf16_t*)Bc; const LAS bf16_t* QD = (const LAS bf16_t*)(Bc + 9216); const LAS bf16_t* KD = (const LAS bf16_t*)(Bc + 26624);
            const LAS bf16_t* VT = (const LAS bf16_t*)(Bc + 45056); const LAS bf16_t* ST = (const LAS bf16_t*)(Bc + 49664); const LAS float* DC = (const LAS float*)(Bc + 58368);
            f32x4 o = (f32x4){0.f, 0.f, 0.f, 0.f};
#pragma unroll
            for (int ks = 0; ks < 2; ++ks) { const bf16x8 af = *(const LAS bf16x8*)(VT + (16 * tv + fr) * 72 + (((4 * ks + fq) ^ (2 * tv + (fr >> 3))) << 3)), bf = *(const LAS bf16x8*)(PL + (16 * ti + fr) * 72 + 32 * ks + 8 * fq);
                o = __builtin_amdgcn_mfma_f32_16x16x32_bf16(af, bf, o, 0, 0, 0); }
#pragma unroll
            for (int ks = 0; ks < 4; ++ks) { const bf16x8 af = *(const LAS bf16x8*)(ST + (16 * tv + fr) * 136 + 32 * ks + 8 * fq), bf = *(const LAS bf16x8*)(QD + (16 * ti + fr) * 136 + 32 * ks + 8 * fq);
                o = __builtin_amdgcn_mfma_f32_16x16x32_bf16(af, bf, o, 0, 0, 0); }
            const f32x4 dec = *(const LAS f32x4*)(DC + 16 * w + 4 * fq);
#pragma unroll
            for (int tvv = 0; tvv < 2; ++tvv) { f32x4 kv = (f32x4){0.f, 0.f, 0.f, 0.f};
#pragma unroll
                for (int ks = 0; ks < 2; ++ks) { const bf16x8 af = *(const LAS bf16x8*)(KD + (16 * w + fr) * 72 + 32 * ks + 8 * fq), bf = *(const LAS bf16x8*)(VT + (16 * tvv + fr) * 72 + (((4 * ks + fq) ^ (2 * tvv + (fr >> 3))) << 3));
                    kv = __builtin_amdgcn_mfma_f32_16x16x32_bf16(af, bf, kv, 0, 0, 0); }
                S[tvv] = dec * S[tvv] + kv; }
            LAS bf16_t* STn = (LAS bf16_t*)(Bn + 49664);
#pragma unroll
            for (int tvv = 0; tvv < 2; ++tvv) *(LAS u32x2*)(STn + (16 * tvv + fr) * 136 + 16 * w + 4 * fq) = pack4(S[tvv]);
            const int m = b * 2048 + n * 64 + 16 * ti + fr;
            *(u32x2*)(Vb + (size_t)m * 1024 + h * 256 + vs * 32 + 16 * tv + 4 * fq) = pack4(o);
            float ss = o[0] * o[0] + o[1] * o[1] + o[2] * o[2] + o[3] * o[3];
            ss += __shfl_xor(ss, 16); ss += __shfl_xor(ss, 32);
            if (fq == 0) gpart[((size_t)bh * 2048 + n * 64 + 16 * ti + fr) * 16 + vs * 2 + tv] = ss;
            lds_barrier();
        }
    }
    __syncthreads();
}

__device__ __forceinline__ void gla_meet_arrive(const Params& p, int bh, bool same_xcd) {
    asm volatile("s_waitcnt vmcnt(0) lgkmcnt(0)" ::: "memory");
    __syncthreads();
    if (threadIdx.x == 0) {
        unsigned* c = (unsigned*)(p.ws + WS_BHC) + bh * 64;
        if (!same_xcd) { __builtin_amdgcn_fence(__ATOMIC_RELEASE, "agent"); asm volatile("s_waitcnt vmcnt(0)" ::: "memory"); }
        __hip_atomic_fetch_add(c, 1u, __ATOMIC_RELAXED, __HIP_MEMORY_SCOPE_AGENT);
    }
}
__device__ __forceinline__ void gla_norm_meet(const Params& p, int bh, int vs) {
    int tid_ = threadIdx.x; asm volatile("" : "+v"(tid_)); const int tid = tid_;
    const int b = bh >> 2, h = bh & 3;
    bf16_t* Vb = (bf16_t*)(p.ws + WS_V);
    const float* gpart = (const float*)(p.ws + WS_GPART);
    {
        if (tid == 0) {
            unsigned* c = (unsigned*)(p.ws + WS_BHC) + bh * 64;
            while (__hip_atomic_load(c, __ATOMIC_RELAXED, __HIP_MEMORY_SCOPE_AGENT) < 8u) __builtin_amdgcn_s_sleep(1);
            __builtin_amdgcn_fence(__ATOMIC_ACQUIRE, "agent");
            asm volatile("s_waitcnt vmcnt(0)" ::: "memory");
        }
        __syncthreads();
        const bf16_t* OGb = (const bf16_t*)(p.ws + WS_OG);
        const int cv = (tid & 31) * 8;
        const f32x4 n0 = *(const f32x4*)(p.in[11] + cv), n1 = *(const f32x4*)(p.in[11] + cv + 4);
#pragma unroll 4
        for (int r = tid >> 5; r < 256; r += 16) {
            const int row = vs * 256 + r, m = b * 2048 + row; const size_t off = (size_t)m * 1024 + h * 256 + cv;
            const f32x4* gp = (const f32x4*)(gpart + ((size_t)bh * 2048 + row) * 16);
            const f32x4 s4 = (gp[0] + gp[1]) + (gp[2] + gp[3]);
            const float rs = rsqrtf(((s4[0] + s4[1]) + (s4[2] + s4[3])) * (1.f / 256.f) + EPS);
            f32x4 o0, o1, g0, g1; unpack8(*(const u32x4*)(Vb + off), o0, o1); unpack8(__builtin_nontemporal_load((const u32x4*)(OGb + off)), g0, g1);
            *(u32x4*)(Vb + off) = pack8(o0 * rs * n0 * g0, o1 * rs * n1 * g1);
        }
    }
}

#define XB_TMO      128
#define XB_XCNT(j)  (256  + 64 * (j))
#define XB_XSUB(j)  (1280 + 64 * (j))
#define XB_XGEN(j)  (2304 + 64 * (j))
#define XB_TOP      3328
#define XB_TOPGEN   3392
#define XCD_BAR_WORDS 3456
#define XB_SPIN_CAP (1u << 18)

__device__ __forceinline__ unsigned xb_ld(unsigned* p)              { return __hip_atomic_load(p, __ATOMIC_RELAXED, __HIP_MEMORY_SCOPE_AGENT); }
__device__ __forceinline__ unsigned xb_add(unsigned* p, unsigned v) { return __hip_atomic_fetch_add(p, v, __ATOMIC_RELAXED, __HIP_MEMORY_SCOPE_AGENT); }
__device__ __forceinline__ unsigned xb_xcc_id() { return (unsigned)__builtin_amdgcn_s_getreg((3 << 11) | 20) & 0xFu; }
#define XB_SPIN(cond, bar) do { unsigned _sp = 0; while (cond) { __builtin_amdgcn_s_sleep(1); \
    if ((++_sp & 255u) == 0u) { if (xb_ld(&(bar)[XB_TMO])) break; if (_sp > XB_SPIN_CAP) { atomicAdd(&(bar)[XB_TMO], 1u); break; } } } } while (0)

struct XcdBarrier {
    unsigned* bar; unsigned x;
    volatile LAS unsigned* st;
};

__device__ __forceinline__ XcdBarrier xcd_barrier_post(unsigned* bar, volatile LAS unsigned* st) {
    XcdBarrier b; b.bar = bar; b.x = xb_xcc_id(); b.st = st;
    if (threadIdx.x == 0) (void)xb_add(&bar[XB_XCNT(b.x)], 1u);
    return b;
}
__device__ __forceinline__ void xcd_barrier_complete(unsigned* bar, unsigned x, unsigned& nloc, unsigned& nx) {
    const unsigned G = gridDim.x * gridDim.y * gridDim.z;
    unsigned sum, cnt, mine, sp = 0u;
    for (;;) {
        sum = 0u; cnt = 0u; mine = 0u;
#pragma unroll
        for (unsigned j = 0; j < 16; ++j) { const unsigned c = xb_ld(&bar[XB_XCNT(j)]); sum += c; cnt += (c > 0u) ? 1u : 0u; mine = (j == x) ? c : mine; }
        if (sum == G) break;
        __builtin_amdgcn_s_sleep(1);
        if ((++sp & 255u) == 0u) { if (xb_ld(&bar[XB_TMO])) break; if (sp > XB_SPIN_CAP) { atomicAdd(&bar[XB_TMO], 1u); break; } }
    }
    nloc = mine > 0u ? mine : 1u; nx = cnt > 0u ? cnt : 1u;
}

__device__ __forceinline__ void xcd_barrier(const XcdBarrier& b) {
    asm volatile("s_waitcnt vmcnt(0)" ::: "memory");
    __syncthreads();
    if (threadIdx.x == 0) {
        unsigned* bar = b.bar;
        __builtin_amdgcn_s_waitcnt(0);
        unsigned nloc = b.st[0], nx = b.st[1];
        if (nloc == 0u) { xcd_barrier_complete(bar, b.x, nloc, nx); b.st[0] = nloc; b.st[1] = nx; }
        const unsigned old = xb_add(&bar[XB_XSUB(b.x)], 1u);
        const unsigned gen = old / nloc;
        if (old + 1u == (gen + 1u) * nloc) {
            __builtin_amdgcn_fence(__ATOMIC_RELEASE, "agent");
            asm volatile("s_waitcnt vmcnt(0)" ::: "memory");
            const unsigned og = xb_add(&bar[XB_TOP], 1u);
            const unsigned tg = og / nx;
            if (og + 1u == (tg + 1u) * nx) xb_add(&bar[XB_TOPGEN], 1u);
            else XB_SPIN(xb_ld(&bar[XB_TOPGEN]) == tg, bar);
            __builtin_amdgcn_fence(__ATOMIC_ACQUIRE, "agent");
            xb_add(&bar[XB_XGEN(b.x)], 1u);
            asm volatile("s_waitcnt vmcnt(0)" ::: "memory");
        } else {
            XB_SPIN(xb_ld(&bar[XB_XGEN(b.x)]) == gen, bar);
            __builtin_amdgcn_fence(__ATOMIC_ACQUIRE, "agent");
            asm volatile("s_waitcnt vmcnt(0)" ::: "memory");
        }
    }
    __syncthreads();
}

__device__ __forceinline__ void grid_bar(unsigned* cnt, unsigned target) {
    asm volatile("s_waitcnt vmcnt(0) lgkmcnt(0)" ::: "memory");
    __syncthreads();
    if (threadIdx.x == 0) {
        __builtin_amdgcn_fence(__ATOMIC_RELEASE, "agent");
        asm volatile("s_waitcnt vmcnt(0)" ::: "memory");
        __hip_atomic_fetch_add(cnt, 1u, __ATOMIC_RELAXED, __HIP_MEMORY_SCOPE_AGENT);
        while (__hip_atomic_load(cnt, __ATOMIC_RELAXED, __HIP_MEMORY_SCOPE_AGENT) < target) __builtin_amdgcn_s_sleep(1);
        __builtin_amdgcn_fence(__ATOMIC_ACQUIRE, "agent");
        asm volatile("s_waitcnt vmcnt(0)" ::: "memory");
    }
    __syncthreads();
}
__device__ __forceinline__ void panel_meet(unsigned* cnt, bool same_xcd) {
    asm volatile("s_waitcnt vmcnt(0) lgkmcnt(0)" ::: "memory");
    __syncthreads();
    if (threadIdx.x == 0) {
        if (!same_xcd) { __builtin_amdgcn_fence(__ATOMIC_RELEASE, "agent"); asm volatile("s_waitcnt vmcnt(0)" ::: "memory"); }
        __hip_atomic_fetch_add(cnt, 1u, __ATOMIC_RELAXED, __HIP_MEMORY_SCOPE_AGENT);
        while (__hip_atomic_load(cnt, __ATOMIC_RELAXED, __HIP_MEMORY_SCOPE_AGENT) < 4u) __builtin_amdgcn_s_sleep(1);
        __builtin_amdgcn_fence(__ATOMIC_ACQUIRE, "agent");
        asm volatile("s_waitcnt vmcnt(0)" ::: "memory");
    }
    __syncthreads();
}
__global__ void __launch_bounds__(512, 2) mk_fwd(Params p) {
    extern __shared__ __attribute__((aligned(16))) unsigned char lds_raw[];
    LAS unsigned char* lds = (LAS unsigned char*)lds_raw;
    cg::grid_group grid = cg::this_grid();
    unsigned char* ws = p.ws; unsigned char* dob = (unsigned char*)p.out;
    const int G = gridDim.x;
    if (threadIdx.x < 2) ((volatile LAS unsigned*)(lds + 131072 + 512))[threadIdx.x] = 0u;
    __syncthreads();
#ifndef MK_PHASE_MASK
#define MK_PHASE_MASK 0x7ff
#endif
#define IN(k) ((((MK_PHASE_MASK) >> (k)) & 1) != 0)
#define GBAR() xcd_barrier(xbar)
#ifndef MK_DELAY_MASK
#define MK_DELAY_MASK 0
#endif
    unsigned long long t_ph = 0;
#define TBEG() do { if (MK_DELAY_MASK) t_ph = __builtin_amdgcn_s_memrealtime(); } while (0)
#define TEND(k) do { if ((MK_DELAY_MASK >> (k)) & 1) { const unsigned long long t1_ = __builtin_amdgcn_s_memrealtime(), dt_ = t1_ - t_ph; while (__builtin_amdgcn_s_memrealtime() - t1_ < dt_) __builtin_amdgcn_s_sleep(8); __syncthreads(); } } while (0)
    const unsigned long long t_k0 = MK_DELAY_MASK ? __builtin_amdgcn_s_memrealtime() : 0ull;
    for (int i = blockIdx.x * 512 + threadIdx.x; i < 4096; i += G * 512) ((unsigned*)(ws + WS_XBAR))[i] = 0u;
    grid.sync();
    XcdBarrier xbar = xcd_barrier_post((unsigned*)(ws + WS_XBAR), (volatile LAS unsigned*)(lds + 131072 + 512));
    const bool chain = (G == 256);
    int my_pm = 0; { pg8::StaticOrder S0; S0.init(M, 1024, G, (int)blockIdx.x); pg8::Unit u0; if (S0.next(0, u0)) my_pm = u0.pm; }
    unsigned* pmask = (unsigned*)(ws + WS_XBAR) + 3584 + my_pm;
    if (chain && threadIdx.x == 0) __hip_atomic_fetch_or(pmask, 1u << xb_xcc_id(), __ATOMIC_RELAXED, __HIP_MEMORY_SCOPE_AGENT);
    const int my_it = blockIdx.x, my_b = my_it & 7, my_bh = 4 * my_b + ((my_it >> 3) & 3), my_vs = (my_it >> 5) & 7;
    unsigned* bmask0 = (unsigned*)(ws + WS_XBAR) + 3584 + 128;
    if (chain && threadIdx.x == 0) __hip_atomic_fetch_or(bmask0 + my_b, 1u << xb_xcc_id(), __ATOMIC_RELAXED, __HIP_MEMORY_SCOPE_AGENT);
    unsigned* bhmask = (unsigned*)(ws + WS_XBAR) + 3584 + 64 + (my_bh & 31);
    if (G >= 256 && my_it < 256 && threadIdx.x == 0) __hip_atomic_fetch_or(bhmask, 1u << xb_xcc_id(), __ATOMIC_RELAXED, __HIP_MEMORY_SCOPE_AGENT);
    TBEG();
    if (IN(0)) phase_prologue(p, lds);
    GBAR();
    TEND(0);
    TBEG();
    if (IN(1)) {
        EpiIn E{(bf16_t*)(ws + WS_U), (bf16_t*)(ws + WS_VSG), (bf16_t*)(dob + DO_Q), (bf16_t*)(dob + DO_K), (bf16_t*)(ws + WS_V), (bf16_t*)(dob + DO_LA),
                (bf16_t*)(ws + WS_OG), (bf16_t*)(ws + WS_BGA), (bf16_t*)(ws + WS_BGB), (float*)(ws + WS_VSTAT), p.in[10]};
        run_gemm(lds, (const bf16_t*)(ws + WS_H), (const bf16_t*)(ws + WS_WIN), NIN, 1024, E);
        { const int nwg = (M / 256) * (NIN / 256), rem = nwg % G, c = blockIdx.x; const bool light = rem == 0 || c >= rem; const int nlight = rem == 0 ? G : G - rem, li = rem == 0 ? c : c - rem;
          if (light) { int tid_ = threadIdx.x; asm volatile("" : "+v"(tid_)); const int wv = tid_ >> 6;
              tr_run(p, (LAS float*)(lds + wv * 16384), tid_ & 63, TR_EARLY, TR_ALL - TR_EARLY, li * 8 + wv, nlight * 8); } }
    }
    GBAR();
    TEND(1);
    TBEG();
    if (IN(2)) {
        int tid = threadIdx.x; asm volatile("" : "+v"(tid));
        { PrepRegs A, B; if ((int)blockIdx.x < 1024) prep_load(A, p, blockIdx.x, tid);
          for (int it = blockIdx.x; it < 1024; it += G) { const int itn = it + G < 1024 ? it + G : -1; gla_prep_item(p, lds, it, A, itn, B); A = B; } }
        { SgRegs A, B; if ((int)blockIdx.x < 512) sg_load(A, p, blockIdx.x, tid);
          for (int it = blockIdx.x; it < 512; it += G) { const int itn = it + G < 512 ? it + G : -1; sg_item(p, lds, it, A, itn, B); A = B; } }
    }
    GBAR();
    TEND(2);
    TBEG();
    const bool fuse_norm = (G >= 256);
    bool fuse35 = chain && fuse_norm;
    if (fuse35) { unsigned ok = 1u;
#pragma unroll
        for (int j = 0; j < 8; ++j) ok &= (__builtin_popcount(__hip_atomic_load(bmask0 + j, __ATOMIC_RELAXED, __HIP_MEMORY_SCOPE_AGENT)) == 1) ? 1u : 0u;
        fuse35 = ok != 0u; }
    if (IN(3)) {
        for (int it = blockIdx.x; it < 256; it += G) gla_seq(p, lds, 4 * (it & 7) + ((it >> 3) & 3), (it >> 5) & 7);
        TEND(11); TBEG();
        if (fuse_norm && my_it < 256) { const bool bh_same = __builtin_popcount(__hip_atomic_load(bhmask, __ATOMIC_RELAXED, __HIP_MEMORY_SCOPE_AGENT)) == 1; gla_meet_arrive(p, my_bh, bh_same); }
        EpiMerge<false> E{(bf16_t*)(ws + WS_H), (const bf16_t*)(ws + WS_BGA)};
        run_gemm(lds, (const bf16_t*)(ws + WS_U), (const bf16_t*)(ws + WS_WA), 1024, 512, E);
        TEND(13); TBEG();
        if (fuse_norm && my_it < 256) gla_norm_meet(p, my_bh, my_vs);
        TEND(12); TBEG();
    }
    if (fuse35) {
        asm volatile("s_waitcnt vmcnt(0) lgkmcnt(0)" ::: "memory");
        __syncthreads();
        if (threadIdx.x == 0) __hip_atomic_fetch_add((unsigned*)(ws + WS_P35) + (8 * my_b + my_vs) * 16, 1u, __ATOMIC_RELAXED, __HIP_MEMORY_SCOPE_AGENT);
    } else GBAR();
    TEND(3);
    if (!fuse_norm) {
        int tid = threadIdx.x; asm volatile("" : "+v"(tid));
        for (int e = blockIdx.x * 512 + tid; e < M * 128; e += G * 512) {
            const int m = e >> 7, c = (e & 127) * 8, h = c >> 8;
            const f32x4* gp = (const f32x4*)((const float*)(ws + WS_GPART) + ((size_t)((m >> 11) * 4 + h) * 2048 + (m & 2047)) * 16);
            const f32x4 s4 = (gp[0] + gp[1]) + (gp[2] + gp[3]);
            const float rs = rsqrtf(((s4[0] + s4[1]) + (s4[2] + s4[3])) * (1.f / 256.f) + EPS);
            f32x4 o0, o1, g0, g1; unpack8(*(const u32x4*)((bf16_t*)(ws + WS_V) + (size_t)e * 8), o0, o1); unpack8(*(const u32x4*)((const bf16_t*)(ws + WS_OG) + (size_t)e * 8), g0, g1);
            const f32x4 n0 = *(const f32x4*)(p.in[11] + (c & 255)), n1 = *(const f32x4*)(p.in[11] + (c & 255) + 4);
            *(u32x4*)((bf16_t*)(ws + WS_V) + (size_t)e * 8) = pack8(o0 * rs * n0 * g0, o1 * rs * n1 * g1);
        }
        GBAR();
    }
    TBEG();
    const bool same_xcd = chain && __builtin_popcount(__hip_atomic_load(pmask, __ATOMIC_RELAXED, __HIP_MEMORY_SCOPE_AGENT)) == 1;
#define PSEAM(k) do { if (chain) panel_meet((unsigned*)(ws + WS_PCNT) + ((k) * 64 + my_pm) * 32, same_xcd); else GBAR(); } while (0)
    if (fuse35) {
        if (threadIdx.x == 0) { unsigned* c35 = (unsigned*)(ws + WS_P35) + my_pm * 16;
            while (__hip_atomic_load(c35, __ATOMIC_RELAXED, __HIP_MEMORY_SCOPE_AGENT) < 4u) __builtin_amdgcn_s_sleep(1);
            __builtin_amdgcn_fence(__ATOMIC_ACQUIRE, "agent"); asm volatile("s_waitcnt vmcnt(0)" ::: "memory"); }
        __syncthreads();
    }
    if (IN(5)) {
        EpiMerge<true> E{(bf16_t*)(ws + WS_H), (const bf16_t*)(ws + WS_BGB)};
        run_gemm(lds, (const bf16_t*)(ws + WS_V), (const bf16_t*)(ws + WS_WB), 1024, 1024, E);
    }
    PSEAM(3);
    if (chain && threadIdx.x == 0) __hip_atomic_fetch_add((unsigned*)(ws + WS_BAR), 1u, __ATOMIC_RELAXED, __HIP_MEMORY_SCOPE_AGENT);
    TEND(5);
    TBEG();
    if (IN(6)) {
        EpiRes<false> E{p.in[0], (bf16_t*)(ws + WS_XB), (float*)(ws + WS_RSS2)};
        run_gemm(lds, (const bf16_t*)(ws + WS_H), (const bf16_t*)(ws + WS_WO), 1024, 1024, E);
    }
    PSEAM(0);
    TEND(6);
    TBEG();
    if (chain) { if (threadIdx.x == 0) { while (__hip_atomic_load((unsigned*)(ws + WS_BAR), __ATOMIC_RELAXED, __HIP_MEMORY_SCOPE_AGENT) < (unsigned)G) __builtin_amdgcn_s_sleep(1); } __syncthreads(); }
    if (IN(7)) {
        EpiUp E{(bf16_t*)(ws + WS_UP), (const float*)(ws + WS_RSS2)};
        run_gemm(lds, (const bf16_t*)(ws + WS_XB), (const bf16_t*)(ws + WS_WUP), FF, 1024, E);
    }
    PSEAM(1);
    TEND(7);
    TBEG();
    if (IN(8)) {
        EpiRes<true> E{nullptr, (bf16_t*)(ws + WS_XB), (float*)(ws + WS_RSS3)};
        run_gemm(lds, (const bf16_t*)(ws + WS_UP), (const bf16_t*)(ws + WS_WDN), 1024, FF, E);
        EpiPlain E2{(bf16_t*)(ws + WS_H)};
        run_gemm(lds, (const bf16_t*)(ws + WS_PB), (const bf16_t*)(ws + WS_WPP), 1024, PLE, E2);
    }
    PSEAM(2);
    TEND(8);
    TBEG();
    const bool fuse_final = (G == 256);
    TBEG();
    if (IN(9)) {
        if (fuse_final) {
            EpiPleFinal E{p.out, (const bf16_t*)(ws + WS_XB), (const bf16_t*)(ws + WS_H), (const float*)(ws + WS_RSS3), (float*)(ws + WS_RSS4), (unsigned*)(ws + WS_PCNT) + 4 * 64 * 32, p.in[20], same_xcd};
            run_gemm<EpiPleFinal, false>(lds, (const bf16_t*)(ws + WS_XB), (const bf16_t*)(ws + WS_WPG), 1024, 1024, E);
        } else {
            EpiPleGate E{p.out, (const bf16_t*)(ws + WS_XB), (const bf16_t*)(ws + WS_H), (const float*)(ws + WS_RSS3), (float*)(ws + WS_RSS4)};
            run_gemm(lds, (const bf16_t*)(ws + WS_XB), (const bf16_t*)(ws + WS_WPG), 1024, 1024, E);
        }
    }
    if (!fuse_final) {
        GBAR();
        const float* rss4 = (const float*)(ws + WS_RSS4);
        int tid = threadIdx.x; asm volatile("" : "+v"(tid));
        for (int e = blockIdx.x * 512 + tid; e < M * 256; e += G * 512) {
            const int m = e >> 8, c = (e & 255) * 4;
            const float rs = rsqrtf(rss4[m] * (1.f / 1024.f) + EPS);
            const f32x4 v = *(const f32x4*)(p.out + (size_t)e * 4), g = *(const f32x4*)(p.in[20] + c);
            *(f32x4*)(p.out + (size_t)e * 4) = v * rs * g;
        }
    }
    if ((MK_DELAY_MASK >> 10) & 1) { asm volatile("s_waitcnt vmcnt(0)" ::: "memory"); __syncthreads(); }
    TEND(9);
    if ((MK_DELAY_MASK >> 14) & 1) { asm volatile("s_waitcnt vmcnt(0)" ::: "memory"); __syncthreads(); t_ph = t_k0; }
    TEND(14);
#undef IN
#undef GBAR
#undef PSEAM
}
}

extern "C" void kernel_launch(void* const* d_in, const int* in_sizes, int n_in, void* d_out, int out_size, void* d_ws, size_t ws_size, hipStream_t stream) {
    static int grid = 0;
    if (grid == 0) {
        if (n_in != 21 || out_size != mk::M * mk::D || ws_size < mk::WS_END) { fprintf(stderr, "kernel_launch: unexpected shapes (n_in %d out %d ws %zu)\n", n_in, out_size, ws_size); grid = -1; return; }
        int dev = 0, cus = 0, per_cu = 0;
        if (hipGetDevice(&dev) != hipSuccess || hipDeviceGetAttribute(&cus, hipDeviceAttributeMultiprocessorCount, dev) != hipSuccess) { grid = -1; return; }
        if (hipFuncSetAttribute((const void*)mk::mk_fwd, hipFuncAttributeMaxDynamicSharedMemorySize, mk::LDS_BYTES) != hipSuccess) { fprintf(stderr, "kernel_launch: hipFuncSetAttribute failed\n"); grid = -1; return; }
        if (hipOccupancyMaxActiveBlocksPerMultiprocessor(&per_cu, (const void*)mk::mk_fwd, 512, mk::LDS_BYTES) != hipSuccess || per_cu < 1) { fprintf(stderr, "kernel_launch: occupancy query says %d\n", per_cu); per_cu = 1; }
        (void)hipGetLastError();
        grid = cus * per_cu;
    }
    if (grid < 0) return;
    mk::Params p{};
    for (int i = 0; i < 21; ++i) p.in[i] = (const float*)d_in[i];
    p.out = (float*)d_out; p.ws = (unsigned char*)d_ws;
    void* args[] = {&p};
    hipError_t e = hipLaunchCooperativeKernel((const void*)mk::mk_fwd, dim3(grid), dim3(512), args, mk::LDS_BYTES, stream);
    if (e != hipSuccess) fprintf(stderr, "kernel_launch: cooperative launch failed: %s (grid %d)\n", hipGetErrorString(e), grid);

}
```

```cpp
#include <hip/hip_runtime.h>
#include <hip/hip_cooperative_groups.h>
#include <cstdio>
#include <cstdint>
namespace cg = cooperative_groups;
namespace pg8 {
#define PG8_LAS __attribute__((address_space(3)))
typedef unsigned short bf16_t;
typedef short bf16x8 __attribute__((ext_vector_type(8)));
typedef float f32x4 __attribute__((ext_vector_type(4)));
typedef unsigned u32x4 __attribute__((ext_vector_type(4)));
constexpr int BM = 256, BK = 64, HALF = 128, HTB = HALF * BK * 2  , STAGE_BYTES = 8 * HTB, NXCD = 8, WGM = 8;

__host__ __device__ __forceinline__ int lds_byte(int r, int c) { const int st = (r >> 4) * 2 + (c >> 5), rr = r & 15, cc = c & 31, ob = rr * 64 + cc * 2; return st * 1024 + (ob ^ (((ob >> 9) & 1) << 5)); }
__host__ __device__ __forceinline__ void stage_rc(int b, int& R, int& C) { const int st = b / 1024, sb = b % 1024, swz = sb ^ (((sb >> 9) & 1) << 5); R = (st >> 1) * 16 + swz / 64; C = (st & 1) * 32 + (swz % 64) / 2; }
__host__ __device__ __forceinline__ int perm32(int rho) { const int n = rho >> 4, i = rho & 15; return 8 * (i >> 2) + 4 * n + (i & 3); }

struct Unit { int pm, pn; };
struct Gemm { const bf16_t* A; const bf16_t* Bt; int M, N, K; };

struct StaticOrder {
    int nM, nN, nwg, G, c;
    __host__ __device__ void init(int M, int N, int G_, int c_) { nM = M / BM; nN = N / BM; nwg = nM * nN; G = G_; c = c_; }
    __host__ __device__ bool next(int i, Unit& u) const {
        const long L = (long)i * G + c; if (L >= nwg) return false;
        int wgid = (int)L; { const int q = nwg / NXCD, r = nwg % NXCD, xcd = wgid % NXCD, off = wgid / NXCD; wgid = (xcd < r ? xcd * (q + 1) : r * (q + 1) + (xcd - r) * q) + off; }
        const int nig = WGM * nN, gid = wgid / nig, fm = gid * WGM, gsz = (nM - fm) < WGM ? (nM - fm) : WGM;
        u.pm = fm + ((wgid % nig) % gsz); u.pn = (wgid % nig) / gsz; return true;
    }
    __device__ __forceinline__ void a_ready(const Unit&) const {}
    __device__ __forceinline__ void done(const Unit&) const {}
};
typedef float f32x2 __attribute__((ext_vector_type(2)));
typedef __bf16 bf16x2_t __attribute__((ext_vector_type(2)));
__device__ __forceinline__ unsigned cvt_pk_bf16(float lo, float hi) { f32x2 v = {lo, hi}; bf16x2_t b = __builtin_convertvector(v, bf16x2_t); return __builtin_bit_cast(unsigned, b); }
template <class Epi, class Sched, bool ALIGN_EPI = false, bool SP2 = false>
__device__ __forceinline__ void gemm_phase(PG8_LAS unsigned char* lds, const Gemm g, const Sched& S, const Epi& E) {
    int tid_ = threadIdx.x; asm volatile("" : "+v"(tid_));
    const int tid = tid_, wid = __builtin_amdgcn_readfirstlane(tid >> 6), lane = tid & 63, wr = wid >> 2, wc = wid & 3, fr = lane & 15, fq = lane >> 4;
    const int K = g.K, nt = K / BK;
    unsigned voffA[2], voffB[2];
#pragma unroll
    for (int i = 0; i < 2; ++i) { int R, C; stage_rc(tid * 16 + i * 8192, R, C); const int Rb = Epi::PERM ? ((R & ~31) + perm32(R & 31)) : R;
        voffA[i] = (unsigned)(R * K + C) * 2u; voffB[i] = (unsigned)(Rb * K + C) * 2u; }
    const size_t kstep = (size_t)(BK * 2);
    const size_t hstep = (size_t)HALF * K * 2;
    const size_t tstep = 2 * hstep;
    const unsigned ldsw = (unsigned)wid * 1024u;
    const int aoff = lds_byte(wr * 64 + fr, fq * 8), boff = lds_byte(wc * 32 + fr, fq * 8);
#define PG8_SA(b, h) (((b) * 2 + (h)) * HTB)
#define PG8_SB(b, h) ((4 + (b) * 2 + (h)) * HTB)
#define PG8_STAGE(bufoff, gbase, voff) do { _Pragma("unroll") for (int _i = 0; _i < 2; ++_i) \
        __builtin_amdgcn_global_load_lds((const unsigned*)((const char*)(gbase) + (voff)[_i]), (PG8_LAS unsigned*)(lds + (bufoff) + ldsw + _i * 8192), 16, 0, 0); } while (0)
#define PG8_LDA(dst, b, h) do { _Pragma("unroll") for (int m = 0; m < 4; ++m) _Pragma("unroll") for (int k = 0; k < 2; ++k) dst[m][k] = *(const PG8_LAS bf16x8*)(lds + PG8_SA(b, h) + aoff + m * 2048 + k * 1024); } while (0)
#define PG8_LDB(dst, b, h) do { _Pragma("unroll") for (int n = 0; n < 2; ++n) _Pragma("unroll") for (int k = 0; k < 2; ++k) dst[n][k] = *(const PG8_LAS bf16x8*)(lds + PG8_SB(b, h) + boff + n * 2048 + k * 1024); } while (0)
#define PG8_MMA(ai, bj, At, Bt) do { __builtin_amdgcn_s_setprio(1); _Pragma("unroll") for (int m = 0; m < 4; ++m) _Pragma("unroll") for (int n = 0; n < 2; ++n) _Pragma("unroll") for (int k = 0; k < 2; ++k) \
        acc[ai][bj][m][n] = __builtin_amdgcn_mfma_f32_16x16x32_bf16(Bt[n][k], At[m][k], acc[ai][bj][m][n], 0, 0, 0); __builtin_amdgcn_s_setprio(0); } while (0)
#define PG8_WAIT_V(n) asm volatile("s_waitcnt vmcnt(" #n ")" ::: "memory")
#define PG8_WAIT_L(n) asm volatile("s_waitcnt lgkmcnt(" #n ")" ::: "memory")
#define PG8_BAR __builtin_amdgcn_s_barrier()
#define PG8_SCHED __builtin_amdgcn_sched_barrier(0)
    Unit cur, nxt; int ui = 0;
    if (!S.next(0, cur)) return;
    f32x4 acc[2][2][4][2];
#pragma unroll
    for (int a = 0; a < 2; ++a)
#pragma unroll
        for (int b = 0; b < 2; ++b)
#pragma unroll
            for (int m = 0; m < 4; ++m)
#pragma unroll
                for (int n = 0; n < 2; ++n) acc[a][b][m][n] = (f32x4){0.f, 0.f, 0.f, 0.f};
    bf16x8 At[4][2], B0[2][2], B1[2][2];
    const char* cA = (const char*)g.A + (size_t)cur.pm * tstep; const char* cB = (const char*)g.Bt + (size_t)cur.pn * tstep;
    S.a_ready(cur);
    if constexpr (SP2) {
        PG8_STAGE(PG8_SB(0, 0), cB, voffB); PG8_STAGE(PG8_SB(0, 1), cB + hstep, voffB); PG8_STAGE(PG8_SA(0, 0), cA, voffA); PG8_STAGE(PG8_SA(0, 1), cA + hstep, voffA);
        if (wr == 1) PG8_BAR;
        PG8_WAIT_V(2); PG8_BAR;
        PG8_STAGE(PG8_SB(1, 0), cB + kstep, voffB); PG8_STAGE(PG8_SA(1, 0), cA + kstep, voffA); PG8_STAGE(PG8_SB(1, 1), cB + hstep + kstep, voffB);
        PG8_WAIT_V(6); PG8_BAR;
    } else {
        PG8_STAGE(PG8_SB(0, 0), cB, voffB); PG8_STAGE(PG8_SA(0, 0), cA, voffA); PG8_STAGE(PG8_SB(0, 1), cB + hstep, voffB); PG8_STAGE(PG8_SA(0, 1), cA + hstep, voffA);
        if (wr == 1) PG8_BAR;
        PG8_WAIT_V(4); PG8_BAR;
        PG8_STAGE(PG8_SB(1, 0), cB + kstep, voffB); PG8_STAGE(PG8_SA(1, 0), cA + kstep, voffA); PG8_STAGE(PG8_SB(1, 1), cB + hstep + kstep, voffB);
        PG8_WAIT_V(6); PG8_BAR;
    }
    for (;;) {
        const bool has_next = S.next(ui + 1, nxt);
        const char* nA = has_next ? (const char*)g.A + (size_t)nxt.pm * tstep : cA; const char* nB = has_next ? (const char*)g.Bt + (size_t)nxt.pn * tstep : cB;
        for (int t = 0; t < nt; t += 2) {
            const bool last = (t == nt - 2);
            const char* a1 = cA + (size_t)(t + 1) * kstep;
            const char* a2 = last ? nA : cA + (size_t)(t + 2) * kstep; const char* b2 = last ? nB : cB + (size_t)(t + 2) * kstep;
            const char* a3 = a2 + kstep; const char* b3 = b2 + kstep;
            if (last && has_next) S.a_ready(nxt);
            if constexpr (SP2) {
            PG8_LDB(B0, 0, 0); PG8_LDB(B1, 0, 1); PG8_SCHED; PG8_LDA(At, 0, 0); PG8_STAGE(PG8_SA(1, 1), a1 + hstep, voffA);
            PG8_WAIT_V(8); PG8_WAIT_L(0); PG8_BAR; PG8_MMA(0, 0, At, B0); PG8_MMA(0, 1, At, B1); PG8_BAR; PG8_SCHED;
            PG8_LDA(At, 0, 1); PG8_STAGE(PG8_SB(0, 0), b2, voffB); PG8_STAGE(PG8_SB(0, 1), b2 + hstep, voffB); PG8_STAGE(PG8_SA(0, 0), a2, voffA);
            PG8_WAIT_V(8); PG8_WAIT_L(0); PG8_BAR; PG8_MMA(1, 0, At, B0); PG8_MMA(1, 1, At, B1); PG8_BAR; PG8_SCHED;
            PG8_LDB(B0, 1, 0); PG8_LDB(B1, 1, 1); PG8_SCHED; PG8_LDA(At, 1, 0); PG8_STAGE(PG8_SA(0, 1), a2 + hstep, voffA);
            PG8_WAIT_V(8); PG8_WAIT_L(0); PG8_BAR; PG8_MMA(0, 0, At, B0); PG8_MMA(0, 1, At, B1); PG8_BAR; PG8_SCHED;
            PG8_LDA(At, 1, 1); PG8_STAGE(PG8_SB(1, 0), b3, voffB); PG8_STAGE(PG8_SB(1, 1), b3 + hstep, voffB); PG8_STAGE(PG8_SA(1, 0), a3, voffA);
            PG8_WAIT_V(8); PG8_WAIT_L(0); PG8_BAR; PG8_MMA(1, 0, At, B0); PG8_MMA(1, 1, At, B1); PG8_BAR; PG8_SCHED;
            } else {
            PG8_LDB(B0, 0, 0); PG8_SCHED; PG8_LDA(At, 0, 0); PG8_STAGE(PG8_SA(1, 1), a1 + hstep, voffA);
            PG8_WAIT_L(8); PG8_BAR; PG8_WAIT_L(0); PG8_MMA(0, 0, At, B0); PG8_BAR; PG8_SCHED;
            PG8_LDB(B1, 0, 1); PG8_STAGE(PG8_SB(0, 0), b2, voffB);
            PG8_BAR; PG8_WAIT_L(0); PG8_MMA(0, 1, At, B1); PG8_BAR;
            PG8_LDA(At, 0, 1); PG8_STAGE(PG8_SA(0, 0), a2, voffA);
            PG8_BAR; PG8_WAIT_L(0); PG8_MMA(1, 0, At, B0); PG8_BAR; PG8_SCHED;
            PG8_STAGE(PG8_SB(0, 1), b2 + hstep, voffB);
            PG8_WAIT_V(6); PG8_BAR; PG8_MMA(1, 1, At, B1); PG8_BAR;
            PG8_LDB(B0, 1, 0); PG8_SCHED; PG8_LDA(At, 1, 0); PG8_STAGE(PG8_SA(0, 1), a2 + hstep, voffA);
            PG8_WAIT_L(8); PG8_BAR; PG8_WAIT_L(0); PG8_MMA(0, 0, At, B0); PG8_BAR; PG8_SCHED;
            PG8_LDB(B1, 1, 1); PG8_STAGE(PG8_SB(1, 0), b3, voffB);
            PG8_BAR; PG8_WAIT_L(0); PG8_MMA(0, 1, At, B1); PG8_BAR;
            PG8_LDA(At, 1, 1); PG8_STAGE(PG8_SA(1, 0), a3, voffA);
            PG8_BAR; PG8_WAIT_L(0); PG8_MMA(1, 0, At, B0); PG8_BAR; PG8_SCHED;
            PG8_STAGE(PG8_SB(1, 1), b3 + hstep, voffB);
            PG8_WAIT_V(6); PG8_BAR; PG8_MMA(1, 1, At, B1); PG8_BAR;
            }
        }
        if constexpr (ALIGN_EPI) { if (wr == 0) PG8_BAR; }
        if constexpr (!Epi::AFTER_DRAIN) { E(acc, cur, wr, wc, fr, fq); S.done(cur); }
        if (!has_next) break;
#pragma unroll
        for (int a = 0; a < 2; ++a)
#pragma unroll
            for (int b = 0; b < 2; ++b)
#pragma unroll
                for (int m = 0; m < 4; ++m)
#pragma unroll
                    for (int n = 0; n < 2; ++n) acc[a][b][m][n] = (f32x4){0.f, 0.f, 0.f, 0.f};
        cur = nxt; cA = nA; cB = nB; ++ui;
        if constexpr (ALIGN_EPI) { if (wr == 1) PG8_BAR; }
    }
    PG8_WAIT_V(0);
    if constexpr (!ALIGN_EPI) { if (wr == 0) PG8_BAR; }
    PG8_BAR;
    if constexpr (Epi::AFTER_DRAIN) { E.fused(acc, cur, wr, wc, fr, fq, lds, wid, lane); S.done(cur); }
#undef PG8_SA
#undef PG8_SB
#undef PG8_STAGE
#undef PG8_LDA
#undef PG8_LDB
#undef PG8_MMA
#undef PG8_WAIT_V
#undef PG8_WAIT_L
#undef PG8_BAR
#undef PG8_SCHED
}
}

#define LAS __attribute__((address_space(3)))
namespace mk {
using pg8::bf16_t; using pg8::bf16x8; using pg8::f32x4; using pg8::u32x4; using pg8::Unit;
typedef unsigned u32x2 __attribute__((ext_vector_type(2)));

constexpr int M = 16384, D = 1024, SEQ = 2048, FF = 4096, PLE = 256, NIN = 6656;
constexpr float EPS = 1e-6f;
constexpr size_t MiB = 1u << 20;
constexpr size_t WS_VSTAT = 0;
constexpr size_t WS_RSS2 = 128 * 1024;
constexpr size_t WS_RSS3 = 192 * 1024;
constexpr size_t WS_RSS4 = 256 * 1024;
constexpr size_t WS_RGLA = 320 * 1024;
constexpr size_t WS_BAR = 576 * 1024;
constexpr size_t WS_BHC = 576 * 1024 + 256;
constexpr size_t WS_P35 = 576 * 1024 + 256 + 8192;
constexpr size_t WS_PCNT = 592 * 1024;
constexpr size_t WS_ZERO_END = 640 * 1024;
constexpr size_t WS_XBAR = 640 * 1024;
constexpr size_t WS_WSB = 1 * MiB;
constexpr size_t WS_WIN = 2 * MiB;
constexpr size_t WS_WA = 15 * MiB;
constexpr size_t WS_WB = 16 * MiB;
constexpr size_t WS_WO = 18 * MiB;
constexpr size_t WS_WUP = 20 * MiB;
constexpr size_t WS_WDN = 28 * MiB;
constexpr size_t WS_WPG = 36 * MiB;
constexpr size_t WS_WPP = 38 * MiB;
constexpr size_t WS_PB = 39 * MiB;
constexpr size_t WS_H = 47 * MiB;
constexpr size_t WS_U = 79 * MiB;
constexpr size_t WS_VSG = 95 * MiB;
constexpr size_t WS_V = 111 * MiB;
constexpr size_t WS_OG = 143 * MiB;
constexpr size_t WS_BGA = 175 * MiB;
constexpr size_t WS_BGB = 207 * MiB;
constexpr size_t WS_UP = 79 * MiB;
constexpr size_t WS_XB = 207 * MiB;
constexpr size_t WS_GPART = 239 * MiB;
constexpr size_t WS_END = 243 * MiB;
constexpr size_t DO_Q = 0, DO_K = 16 * MiB, DO_LA = 32 * MiB;

constexpr int LDS_BYTES = 147456;

struct Params { const float* in[21]; float* out; unsigned char* ws; };

__device__ __forceinline__ unsigned f2bf(float f) { unsigned u = __builtin_bit_cast(unsigned, f); return (u + 0x7fffu + ((u >> 16) & 1u)) >> 16; }
__device__ __forceinline__ unsigned pk2(float lo, float hi) { return pg8::cvt_pk_bf16(lo, hi); }
__device__ __forceinline__ float bf_lo(unsigned u) { return __uint_as_float(u << 16); }
__device__ __forceinline__ float bf_hi(unsigned u) { return __uint_as_float(u & 0xffff0000u); }
__device__ __forceinline__ u32x4 pack8(f32x4 a, f32x4 b) { u32x4 w; w.x = pk2(a[0], a[1]); w.y = pk2(a[2], a[3]); w.z = pk2(b[0], b[1]); w.w = pk2(b[2], b[3]); return w; }
__device__ __forceinline__ u32x2 pack4(f32x4 a) { u32x2 w; w.x = pk2(a[0], a[1]); w.y = pk2(a[2], a[3]); return w; }
__device__ __forceinline__ void unpack8(u32x4 w, f32x4& a, f32x4& b) { a[0] = bf_lo(w.x); a[1] = bf_hi(w.x); a[2] = bf_lo(w.y); a[3] = bf_hi(w.y); b[0] = bf_lo(w.z); b[1] = bf_hi(w.z); b[2] = bf_lo(w.w); b[3] = bf_hi(w.w); }
__device__ __forceinline__ f32x4 unpack4(u32x2 w) { f32x4 a; a[0] = bf_lo(w.x); a[1] = bf_hi(w.x); a[2] = bf_lo(w.y); a[3] = bf_hi(w.y); return a; }
__device__ __forceinline__ float sigmoid_f(float x) { return __builtin_amdgcn_rcpf(1.f + __expf(-x)); }
__device__ __forceinline__ float gelu_f(float x) { const float t = 1.5957691216057308f * (x + 0.044715f * x * x * x); return x * sigmoid_f(t); }
__device__ __forceinline__ float silu_f(float x) { return x * sigmoid_f(x); }
__device__ __forceinline__ float logsig_f(float x) { return fminf(x, 0.f) - __logf(1.f + __expf(-fabsf(x))); }
__device__ __forceinline__ float wave_sum(float v) {
#pragma unroll
    for (int o = 1; o < 64; o <<= 1) v += __shfl_xor(v, o);
    return v;
}
__device__ __forceinline__ void atomic_add_agent(float* p, float v) { (void)__hip_atomic_fetch_add(p, v, __ATOMIC_RELAXED, __HIP_MEMORY_SCOPE_AGENT); }
__device__ __forceinline__ void lds_barrier() { asm volatile("s_waitcnt lgkmcnt(0)" ::: "memory"); __builtin_amdgcn_s_barrier(); asm volatile("" ::: "memory"); }
#define LDS_WAIT() asm volatile("s_waitcnt lgkmcnt(0)" ::: "memory")

enum { ACT_NONE = 0, ACT_GELU, ACT_SILU, ACT_SIGM, ACT_SCALE, ACT_LOGSIG };
enum { LAY_512 = 0, LAY_1024, LAY_BLK };
template <int ACT> __device__ __forceinline__ float act1(float x) {
    if (ACT == ACT_GELU) return gelu_f(x);
    if (ACT == ACT_SILU) return silu_f(x);
    if (ACT == ACT_SIGM) return sigmoid_f(x);
    if (ACT == ACT_SCALE) return x * 0.08838834764831845f;
    if (ACT == ACT_LOGSIG) return logsig_f(x) * 0.0625f;
    return x;
}
struct EpiIn {
    static constexpr bool PERM = true, AFTER_DRAIN = false;
    bf16_t *U, *VSG, *Q, *K, *V, *LA, *OG, *BGA, *BGB; float* vstat; const float* bgate;
    template <int ACT, int LAY, bool STATS, bool BIAS> __device__ __forceinline__ void run(const f32x4 (&acc)[2][2][4][2], bf16_t* base, int rowb, int colb, int fq) const {
        f32x4 b0[2], b1[2];
#pragma unroll
        for (int bj = 0; bj < 2; ++bj) { if (BIAS) { b0[bj] = *(const f32x4*)(bgate + colb + bj * 128); b1[bj] = *(const f32x4*)(bgate + colb + bj * 128 + 4); } else { b0[bj] = (f32x4){0.f, 0.f, 0.f, 0.f}; b1[bj] = b0[bj]; } }
#pragma unroll
        for (int ai = 0; ai < 2; ++ai)
#pragma unroll
            for (int m = 0; m < 4; ++m) {
                const int row = rowb + ai * 128 + m * 16; float s1 = 0.f, s2 = 0.f;
#pragma unroll
                for (int bj = 0; bj < 2; ++bj) {
                    const int col = colb + bj * 128; f32x4 v0 = acc[ai][bj][m][0] + b0[bj], v1 = acc[ai][bj][m][1] + b1[bj];
#pragma unroll
                    for (int j = 0; j < 4; ++j) { v0[j] = act1<ACT>(v0[j]); v1[j] = act1<ACT>(v1[j]); }
                    const u32x4 w = pack8(v0, v1);
                    if (STATS) { f32x4 r0, r1; unpack8(w, r0, r1);
#pragma unroll
                        for (int j = 0; j < 4; ++j) { s1 += r0[j] + r1[j]; s2 += r0[j] * r0[j] + r1[j] * r1[j]; } }
                    size_t off;
                    if (LAY == LAY_512) off = (size_t)row * 512 + col;
                    else if (LAY == LAY_1024) off = (size_t)row * 1024 + col;
                    else off = ((size_t)(row >> 6) * 4 + (col >> 7)) * 8192 + (size_t)(row & 63) * 128 + (col & 127);
                    *(u32x4*)(base + off) = w;
                }
                asm volatile("" ::: "memory");
                if (STATS) { s1 += __shfl_xor(s1, 16); s1 += __shfl_xor(s1, 32); s2 += __shfl_xor(s2, 16); s2 += __shfl_xor(s2, 32);
                    if (fq == 0) { atomic_add_agent(vstat + 2 * row, s1); atomic_add_agent(vstat + 2 * row + 1, s2); } }
            }
    }
    __device__ __forceinline__ void operator()(const f32x4 (&acc)[2][2][4][2], const Unit& u, int wr, int wc, int fr, int fq) const {
        const int rowb = u.pm * 256 + wr * 64 + fr, cw = wc * 32 + 8 * fq, pn = u.pn;
        if (pn < 2) run<ACT_GELU, LAY_512, false, false>(acc, U, rowb, pn * 256 + cw, fq);
        else if (pn < 4) run<ACT_GELU, LAY_512, true, false>(acc, VSG, rowb, (pn - 2) * 256 + cw, fq);
        else if (pn < 6) run<ACT_SCALE, LAY_BLK, false, false>(acc, Q, rowb, (pn - 4) * 256 + cw, fq);
        else if (pn < 8) run<ACT_NONE, LAY_BLK, false, false>(acc, K, rowb, (pn - 6) * 256 + cw, fq);
        else if (pn < 12) run<ACT_NONE, LAY_1024, false, false>(acc, V, rowb, (pn - 8) * 256 + cw, fq);
        else if (pn < 14) run<ACT_LOGSIG, LAY_BLK, false, true>(acc, LA, rowb, (pn - 12) * 256 + cw, fq);
        else if (pn < 18) run<ACT_SILU, LAY_1024, false, false>(acc, OG, rowb, (pn - 14) * 256 + cw, fq);
        else if (pn < 22) run<ACT_SIGM, LAY_1024, false, false>(acc, BGA, rowb, (pn - 18) * 256 + cw, fq);
        else run<ACT_SIGM, LAY_1024, false, false>(acc, BGB, rowb, (pn - 22) * 256 + cw, fq);
    }
};
template <bool ACCUM> struct EpiMerge {
    static constexpr bool PERM = true, AFTER_DRAIN = false;
    bf16_t* MG; const bf16_t* G;
    __device__ __forceinline__ void operator()(const f32x4 (&acc)[2][2][4][2], const Unit& u, int wr, int wc, int fr, int fq) const {
        const int rowb = u.pm * 256 + wr * 64 + fr, colb = u.pn * 256 + wc * 32 + 8 * fq;
#pragma unroll
        for (int ai = 0; ai < 2; ++ai)
#pragma unroll
            for (int m = 0; m < 4; ++m)
#pragma unroll
                for (int bj = 0; bj < 2; ++bj) {
                    const size_t off = (size_t)(rowb + ai * 128 + m * 16) * 1024 + colb + bj * 128;
                    f32x4 g0, g1; unpack8(__builtin_nontemporal_load((const u32x4*)(G + off)), g0, g1);
                    f32x4 v0 = acc[ai][bj][m][0] * g0, v1 = acc[ai][bj][m][1] * g1;
                    if (ACCUM) { f32x4 p0, p1; unpack8(*(const u32x4*)(MG + off), p0, p1); v0 += p0; v1 += p1; }
                    *(u32x4*)(MG + off) = pack8(v0, v1);
                    asm volatile("" ::: "memory");
                }
    }
};
template <bool BF16_BASE> struct EpiRes {
    static constexpr bool PERM = true, AFTER_DRAIN = false;
    const float* base; bf16_t* xb; float* rss;
    __device__ __forceinline__ void operator()(const f32x4 (&acc)[2][2][4][2], const Unit& u, int wr, int wc, int fr, int fq) const {
        const int rowb = u.pm * 256 + wr * 64 + fr, colb = u.pn * 256 + wc * 32 + 8 * fq;
#pragma unroll
        for (int ai = 0; ai < 2; ++ai)
#pragma unroll
            for (int m = 0; m < 4; ++m) {
                const int row = rowb + ai * 128 + m * 16; float ss = 0.f;
#pragma unroll
                for (int bj = 0; bj < 2; ++bj) {
                    const size_t off = (size_t)row * 1024 + colb + bj * 128;
                    f32x4 v0, v1;
                    if (BF16_BASE) unpack8(*(const u32x4*)(xb + off), v0, v1); else { v0 = __builtin_nontemporal_load((const f32x4*)(base + off)); v1 = __builtin_nontemporal_load((const f32x4*)(base + off + 4)); }
                    v0 += acc[ai][bj][m][0]; v1 += acc[ai][bj][m][1];
                    *(u32x4*)(xb + off) = pack8(v0, v1);
#pragma unroll
                    for (int j = 0; j < 4; ++j) ss += v0[j] * v0[j] + v1[j] * v1[j];
                }
                ss += __shfl_xor(ss, 16); ss += __shfl_xor(ss, 32);
                if (fq == 0) atomic_add_agent(rss + row, ss);
                asm volatile("" ::: "memory");
            }
    }
};
struct EpiUp {
    static constexpr bool PERM = true, AFTER_DRAIN = false;
    bf16_t* UPB; const float* rss;
    __device__ __forceinline__ void operator()(const f32x4 (&acc)[2][2][4][2], const Unit& u, int wr, int wc, int fr, int fq) const {
        const int rowb = u.pm * 256 + wr * 64 + fr, colb = u.pn * 256 + wc * 32 + 8 * fq;
#pragma unroll
        for (int ai = 0; ai < 2; ++ai)
#pragma unroll
            for (int m = 0; m < 4; ++m) {
                const int row = rowb + ai * 128 + m * 16; const float rs = rsqrtf(rss[row] * (1.f / 1024.f) + EPS);
#pragma unroll
                for (int bj = 0; bj < 2; ++bj) {
                    f32x4 v0 = acc[ai][bj][m][0] * rs, v1 = acc[ai][bj][m][1] * rs;
#pragma unroll
                    for (int j = 0; j < 4; ++j) { const float a = fmaxf(v0[j], 0.f), b = fmaxf(v1[j], 0.f); v0[j] = a * a; v1[j] = b * b; }
                    *(u32x4*)(UPB + (size_t)row * 4096 + colb + bj * 128) = pack8(v0, v1);
                }
                asm volatile("" ::: "memory");
            }
    }
};
struct EpiPlain {
    static constexpr bool PERM = true, AFTER_DRAIN = false;
    bf16_t* O;
    __device__ __forceinline__ void operator()(const f32x4 (&acc)[2][2][4][2], const Unit& u, int wr, int wc, int fr, int fq) const {
        const int rowb = u.pm * 256 + wr * 64 + fr, colb = u.pn * 256 + wc * 32 + 8 * fq;
#pragma unroll
        for (int ai = 0; ai < 2; ++ai)
#pragma unroll
            for (int m = 0; m < 4; ++m)
#pragma unroll
                for (int bj = 0; bj < 2; ++bj)
                    *(u32x4*)(O + (size_t)(rowb + ai * 128 + m * 16) * 1024 + colb + bj * 128) = pack8(acc[ai][bj][m][0], acc[ai][bj][m][1]);
    }
};
struct EpiPleGate {
    static constexpr bool PERM = true, AFTER_DRAIN = false;
    float* x; const bf16_t* xb; const bf16_t* PLEB; const float* rss_in; float* rss_out;
    __device__ __forceinline__ void operator()(const f32x4 (&acc)[2][2][4][2], const Unit& u, int wr, int wc, int fr, int fq) const {
        const int rowb = u.pm * 256 + wr * 64 + fr, colb = u.pn * 256 + wc * 32 + 8 * fq;
#pragma unroll
        for (int ai = 0; ai < 2; ++ai)
#pragma unroll
            for (int m = 0; m < 4; ++m) {
                const int row = rowb + ai * 128 + m * 16; const float rs = rsqrtf(rss_in[row] * (1.f / 1024.f) + EPS); float ss = 0.f;
#pragma unroll
                for (int bj = 0; bj < 2; ++bj) {
                    const size_t off = (size_t)row * 1024 + colb + bj * 128;
                    f32x4 p0, p1; unpack8(*(const u32x4*)(PLEB + off), p0, p1);
                    f32x4 v0, v1; unpack8(*(const u32x4*)(xb + off), v0, v1);
#pragma unroll
                    for (int j = 0; j < 4; ++j) { v0[j] += sigmoid_f(acc[ai][bj][m][0][j] * rs) * p0[j]; v1[j] += sigmoid_f(acc[ai][bj][m][1][j] * rs) * p1[j]; ss += v0[j] * v0[j] + v1[j] * v1[j]; }
                    *(f32x4*)(x + off) = v0; *(f32x4*)(x + off + 4) = v1;
                }
                ss += __shfl_xor(ss, 16); ss += __shfl_xor(ss, 32);
                if (fq == 0) atomic_add_agent(rss_out + row, ss);
                asm volatile("" ::: "memory");
            }
    }
};

struct EpiPleFinal {
    static constexpr bool PERM = true, AFTER_DRAIN = true;
    float* out; const bf16_t* xb; const bf16_t* PLEB; const float* rss_in; float* rss_out; unsigned* pcnt; const float* gfin; bool same_xcd;
    __device__ __forceinline__ void fused(f32x4 (&acc)[2][2][4][2], const Unit& u, int wr, int wc, int fr, int fq, PG8_LAS unsigned char* lds, int wid, int lane) const {
        const int rowb = u.pm * 256 + wr * 64 + fr, colb = u.pn * 256 + wc * 32 + 8 * fq;
#pragma unroll
        for (int ai = 0; ai < 2; ++ai)
#pragma unroll
            for (int m = 0; m < 4; ++m) {
                const int row = rowb + ai * 128 + m * 16; const float rs = rsqrtf(rss_in[row] * (1.f / 1024.f) + EPS); float ss = 0.f;
#pragma unroll
                for (int bj = 0; bj < 2; ++bj) {
                    const size_t off = (size_t)row * 1024 + colb + bj * 128;
                    f32x4 p0, p1; unpack8(*(const u32x4*)(PLEB + off), p0, p1);
                    f32x4 v0, v1; unpack8(*(const u32x4*)(xb + off), v0, v1);
#pragma unroll
                    for (int j = 0; j < 4; ++j) { v0[j] += sigmoid_f(acc[ai][bj][m][0][j] * rs) * p0[j]; v1[j] += sigmoid_f(acc[ai][bj][m][1][j] * rs) * p1[j]; ss += v0[j] * v0[j] + v1[j] * v1[j]; }
                    acc[ai][bj][m][0] = v0; acc[ai][bj][m][1] = v1;
                }
                ss += __shfl_xor(ss, 16); ss += __shfl_xor(ss, 32);
                if (fq == 0) atomic_add_agent(rss_out + row, ss);
                asm volatile("" ::: "memory");
            }
        asm volatile("s_waitcnt vmcnt(0)" ::: "memory");
        __syncthreads();
        if (wid == 0 && lane == 0) {
            unsigned* c = pcnt + 32 * u.pm;
            if (!same_xcd) { __builtin_amdgcn_fence(__ATOMIC_RELEASE, "agent"); asm volatile("s_waitcnt vmcnt(0)" ::: "memory"); }
            __hip_atomic_fetch_add(c, 1u, __ATOMIC_RELAXED, __HIP_MEMORY_SCOPE_AGENT);
            while (__hip_atomic_load(c, __ATOMIC_RELAXED, __HIP_MEMORY_SCOPE_AGENT) < 4u) __builtin_amdgcn_s_sleep(1);
            __builtin_amdgcn_fence(__ATOMIC_ACQUIRE, "agent"); asm volatile("s_waitcnt vmcnt(0)" ::: "memory");
        }
        __syncthreads();
        f32x4 g0[2], g1[2];
#pragma unroll
        for (int bj = 0; bj < 2; ++bj) { g0[bj] = *(const f32x4*)(gfin + colb + bj * 128); g1[bj] = *(const f32x4*)(gfin + colb + bj * 128 + 4); }
        float rf[2][4];
#pragma unroll
        for (int ai = 0; ai < 2; ++ai)
#pragma unroll
            for (int m = 0; m < 4; ++m) rf[ai][m] = __hip_atomic_load(rss_out + rowb + ai * 128 + m * 16, __ATOMIC_RELAXED, __HIP_MEMORY_SCOPE_AGENT);
        const int tid = wid * 64 + lane;
#pragma unroll
        for (int ai = 0; ai < 2; ++ai) {
#pragma unroll
            for (int m = 0; m < 4; ++m) {
                const float rs = rsqrtf(rf[ai][m] * (1.f / 1024.f) + EPS);
                const int rowl = wr * 64 + m * 16 + fr;
#pragma unroll
                for (int bj = 0; bj < 2; ++bj) {
                    const int c = bj * 32 + wc * 8 + 2 * fq;
                    *(PG8_LAS f32x4*)(lds + rowl * 1024 + (((c) ^ (rowl & 63)) << 4)) = acc[ai][bj][m][0] * rs * g0[bj];
                    *(PG8_LAS f32x4*)(lds + rowl * 1024 + (((c + 1) ^ (rowl & 63)) << 4)) = acc[ai][bj][m][1] * rs * g1[bj];
                }
            }
            lds_barrier();
#pragma unroll
            for (int k = 0; k < 16; ++k) { const int e = tid + 512 * k, rowl = e >> 6, c = e & 63;
                const f32x4 v = *(const PG8_LAS f32x4*)(lds + rowl * 1024 + ((c ^ (rowl & 63)) << 4));
                *(f32x4*)(out + (size_t)(u.pm * 256 + ai * 128 + rowl) * 1024 + u.pn * 256 + c * 4) = v; }
            lds_barrier();
        }
    }
};

template <class Epi, bool ALIGN = true> __device__ __forceinline__ void run_gemm(LAS unsigned char* lds, const bf16_t* A, const bf16_t* Bt, int N, int K, const Epi& E) {
    asm volatile("" : "+s"(K));
    pg8::Gemm g{A, Bt, M, N, K}; pg8::StaticOrder S; S.init(M, N, (int)gridDim.x, (int)blockIdx.x);
    pg8::gemm_phase<Epi, pg8::StaticOrder, ALIGN, true>(lds, g, S, E);
}

struct TrDesc { const float* W; const float* ksc; bf16_t* WT; int ldw, K, ncols, row_off, r; };
__device__ __forceinline__ void tr_load(const TrDesc& d, float (&wv)[32], int lane) {
    const int nblk = d.ncols / 32, kb = d.r / nblk, nb = d.r % nblk, k0 = 64 * kb, n0 = 32 * nb;
#pragma unroll
    for (int i = 0; i < 32; ++i) wv[i] = __builtin_nontemporal_load(d.W + (size_t)(k0 + 2 * i + (lane >> 5)) * d.ldw + n0 + (lane & 31));
}
__device__ __forceinline__ void tr_finish(const TrDesc& d, float (&wv)[32], LAS float* scr, int lane) {
    const int nblk = d.ncols / 32, kb = d.r / nblk, nb = d.r % nblk, k0 = 64 * kb, n0 = 32 * nb;
    if (d.ksc) {
#pragma unroll
        for (int i = 0; i < 32; ++i) wv[i] *= d.ksc[k0 + 2 * i + (lane >> 5)];
    }
#pragma unroll
    for (int i = 0; i < 32; ++i) scr[(2 * i + (lane >> 5)) * 33 + (lane & 31)] = wv[i];
    LDS_WAIT();
    const int c = lane & 7;
#pragma unroll
    for (int j = 0; j < 4; ++j) { const int n = (lane >> 3) + 8 * j; const LAS float* s = scr + (8 * c) * 33 + n;
        u32x4 o; o.x = pk2(s[0 * 33], s[1 * 33]); o.y = pk2(s[2 * 33], s[3 * 33]); o.z = pk2(s[4 * 33], s[5 * 33]); o.w = pk2(s[6 * 33], s[7 * 33]);
        *(u32x4*)(d.WT + (size_t)(d.row_off + n0 + n) * d.K + k0 + 8 * c) = o; }
    LDS_WAIT();
}
__device__ __forceinline__ void comb_item(const float* Win, const float* Wgu, bf16_t* WT, LAS float* scr, int item, int lane) {
    const int nblk = 512 / 32, kb = item / nblk, nb = item % nblk, k0 = 64 * kb, n0 = 32 * nb;
    float g[16];
#pragma unroll
    for (int r = 0; r < 16; ++r) g[r] = Wgu[r * 512 + n0 + (lane & 31)];
#pragma unroll 8
    for (int i = 0; i < 32; ++i) { const int kk = 2 * i + (lane >> 5); const f32x4* wr_ = (const f32x4*)(Win + (size_t)(k0 + kk) * 6160 + 3072);
        const f32x4 a = wr_[0], b = wr_[1], c = wr_[2], d = wr_[3]; float s = 0.f;
#pragma unroll
        for (int r = 0; r < 4; ++r) s += a[r] * g[r] + b[r] * g[4 + r] + c[r] * g[8 + r] + d[r] * g[12 + r];
        scr[kk * 33 + (lane & 31)] = s; }
    LDS_WAIT();
    const int c = lane & 7;
#pragma unroll
    for (int j = 0; j < 4; ++j) { const int n = (lane >> 3) + 8 * j; const LAS float* s = scr + (8 * c) * 33 + n;
        u32x4 o; o.x = pk2(s[0 * 33], s[1 * 33]); o.y = pk2(s[2 * 33], s[3 * 33]); o.z = pk2(s[4 * 33], s[5 * 33]); o.w = pk2(s[6 * 33], s[7 * 33]);
        *(u32x4*)(WT + (size_t)(3072 + n0 + n) * 1024 + k0 + 8 * c) = o; }
    LDS_WAIT();
}

constexpr int I_IN1 = 16 * 96, I_IN2 = 16 * 96, I_A = 8 * 32, I_B = 16 * 32, I_O = 16 * 32, I_UP = 16 * 128, I_DN = 64 * 32, I_PG = 16 * 32, I_PP = 4 * 32;
constexpr int TR_EARLY = I_IN1 + I_IN2, TR_ALL = I_IN1 + I_IN2 + I_A + I_B + I_O + I_UP + I_DN + I_PG + I_PP;
__device__ __forceinline__ void tr_run(const Params& p, LAS float* scr, int lane, int first, int count, int w0, int nw) {
    unsigned char* ws = p.ws;
#define TR_DECODE(d, it_) do { int r = (it_); d.W = p.in[3]; d.ksc = nullptr; d.ldw = 6160; d.K = 1024; d.ncols = 3072; d.row_off = 0; size_t wto = WS_WIN; \
        if (r < I_IN1) { } \
        else if ((r -= I_IN1) < I_IN2) { d.W = p.in[3] + 3088; d.row_off = 3584; } \
        else if ((r -= I_IN2) < I_A) { d.W = p.in[8]; d.ldw = 1024; d.K = 512; d.ncols = 1024; wto = WS_WA; } \
        else if ((r -= I_A) < I_B) { d.W = p.in[12]; d.ldw = 1024; d.ncols = 1024; wto = WS_WB; } \
        else if ((r -= I_B) < I_O) { d.W = p.in[13]; d.ldw = 1024; d.ncols = 1024; wto = WS_WO; } \
        else if ((r -= I_O) < I_UP) { d.W = p.in[15]; d.ldw = 4096; d.ncols = 4096; wto = WS_WUP; d.ksc = p.in[14]; } \
        else if ((r -= I_UP) < I_DN) { d.W = p.in[16]; d.ldw = 1024; d.K = 4096; d.ncols = 1024; wto = WS_WDN; } \
        else if ((r -= I_DN) < I_PG) { d.W = p.in[18]; d.ldw = 1024; d.ncols = 1024; wto = WS_WPG; d.ksc = p.in[17]; } \
        else { r -= I_PG; d.W = p.in[19]; d.ldw = 1024; d.K = 256; d.ncols = 1024; wto = WS_WPP; } \
        d.r = r; d.WT = (bf16_t*)(ws + wto); } while (0)
    const int end = first + count;
    for (int it = first + w0; it < end; it += 2 * nw) {
        const int it1 = it + nw; const bool has1 = it1 < end;
        TrDesc d0, d1; TR_DECODE(d0, it); TR_DECODE(d1, has1 ? it1 : it);
        float a[32], b[32];
        tr_load(d0, a, lane); tr_load(d1, b, lane);
        tr_finish(d0, a, scr, lane);
        if (has1) tr_finish(d1, b, scr, lane);
    }
#undef TR_DECODE
}

__device__ __forceinline__ void phase_prologue(const Params& p, LAS unsigned char* lds) {
    int tid_ = threadIdx.x; asm volatile("" : "+v"(tid_)); const int tid = tid_, lane = tid & 63, wave = tid >> 6, G = gridDim.x;
    const int gw = blockIdx.x * 8 + wave, NGW = G * 8;
    const int gt = blockIdx.x * 512 + tid, NGT = G * 512;
    unsigned char* ws = p.ws;
    LAS float* scr = (LAS float*)(lds + wave * 16384);
    for (int i = gt; i < (int)(WS_ZERO_END / 4); i += NGT) ((float*)ws)[i] = 0.f;
    {
        const f32x4* gm = (const f32x4*)p.in[2] + lane;
        const f32x4 g0 = gm[0], g1 = gm[64], g2 = gm[128], g3 = gm[192];
        for (int m = gw; m < M; m += 4 * NGW) {
            f32x4 v[4][4]; int mr[4];
#pragma unroll
            for (int q = 0; q < 4; ++q) { mr[q] = m + q * NGW; const int ml = mr[q] < M ? mr[q] : m; const f32x4* xr = (const f32x4*)(p.in[0] + (size_t)ml * D) + lane;
                v[q][0] = __builtin_nontemporal_load(xr); v[q][1] = __builtin_nontemporal_load(xr + 64); v[q][2] = __builtin_nontemporal_load(xr + 128); v[q][3] = __builtin_nontemporal_load(xr + 192); }
#pragma unroll
            for (int q = 0; q < 4; ++q) {
                float s = 0.f;
#pragma unroll
                for (int j = 0; j < 4; ++j) s += v[q][0][j] * v[q][0][j] + v[q][1][j] * v[q][1][j] + v[q][2][j] * v[q][2][j] + v[q][3][j] * v[q][3][j];
                const float rs = rsqrtf(wave_sum(s) * (1.f / 1024.f) + EPS);
                if (mr[q] < M) { u32x2* o = (u32x2*)(ws + WS_H + (size_t)mr[q] * 2048) + lane;
                    o[0] = pack4(v[q][0] * rs * g0); o[64] = pack4(v[q][1] * rs * g1); o[128] = pack4(v[q][2] * rs * g2); o[192] = pack4(v[q][3] * rs * g3); }
            }
        }
    }
    for (int i = gt; i < M * PLE / 8; i += 4 * NGT) {
        f32x4 a[4], b[4];
#pragma unroll
        for (int q = 0; q < 4; ++q) { const int iq = i + q * NGT, il = iq < M * PLE / 8 ? iq : i; a[q] = __builtin_nontemporal_load((const f32x4*)p.in[1] + 2 * il); b[q] = __builtin_nontemporal_load((const f32x4*)p.in[1] + 2 * il + 1); }
#pragma unroll
        for (int q = 0; q < 4; ++q) { const int iq = i + q * NGT; if (iq < M * PLE / 8) ((u32x4*)(ws + WS_PB))[iq] = pack8(a[q], b[q]); }
    }
    tr_run(p, scr, lane, 0, TR_EARLY, gw, NGW);
    { const int cw = gw - (NGW > 1280 ? 1024 : 0); for (int it = cw; it >= 0 && it < 256; it += NGW) comb_item(p.in[3], p.in[9], (bf16_t*)(ws + WS_WIN), scr, it, lane); }
    for (int i = gt; i < 4 * 128 * 128; i += NGT) { const int t = (i >> 7) & 127, s = i & 127; ((bf16_t*)(ws + WS_WSB))[i] = (bf16_t)(s <= t ? f2bf(p.in[6][i]) : 0u); }
}

struct SgRegs { u32x4 w[4], v[4]; float s1[4], s2[4]; };
__device__ __forceinline__ void sg_load(SgRegs& R, const Params& p, int item, int tid) {
    const int g = item & 3, chunk = item >> 2, m0 = chunk * 128, c0 = g * 128;
    const bf16_t* WSB = (const bf16_t*)(p.ws + WS_WSB) + g * 16384; const bf16_t* VSG = (const bf16_t*)(p.ws + WS_VSG); const float* vstat = (const float*)(p.ws + WS_VSTAT);
#pragma unroll
    for (int k = 0; k < 4; ++k) { const int e = tid + 512 * k, t = e >> 4, sv = (e & 15) * 8; R.w[k] = *(const u32x4*)(WSB + t * 128 + sv);
        const int m = m0 + t; R.v[k] = *(const u32x4*)(VSG + (size_t)m * 512 + c0 + sv); R.s1[k] = vstat[2 * m]; R.s2[k] = vstat[2 * m + 1]; }
}
__device__ __forceinline__ void sg_item(const Params& p, LAS unsigned char* lds, int item, SgRegs& C, int item_next, SgRegs& N) {
    int tid_ = threadIdx.x; asm volatile("" : "+v"(tid_)); const int tid = tid_, lane = tid & 63, w = tid >> 6, fr = lane & 15, fq = lane >> 4;
    const int g = item & 3, chunk = item >> 2, m0 = chunk * 128, c0 = g * 128;
    unsigned char* ws = p.ws;
    LAS bf16_t* VNT = (LAS bf16_t*)lds;
    LAS bf16_t* WL = (LAS bf16_t*)(lds + 34816);
    bf16_t* U = (bf16_t*)(ws + WS_U);
    const float* lng = p.in[4] + c0; const float* lnb = p.in[5] + c0;
    const int tt = w, t = 16 * tt + fr;
    u32x4 ur[4];
#pragma unroll
    for (int k = 0; k < 4; ++k) { const int e = tid + 512 * k; ur[k] = *(const u32x4*)(U + (size_t)(m0 + (e >> 4)) * 512 + c0 + (e & 15) * 8); }
    const float bias = p.in[7][g * 128 + t];
#pragma unroll
    for (int k = 0; k < 4; ++k) { const int e = tid + 512 * k, tr = e >> 4, sv = (e & 15) * 8; *(LAS u32x4*)(WL + tr * 136 + sv) = C.w[k]; }
#pragma unroll
    for (int k = 0; k < 4; ++k) {
        const int e = tid + 512 * k, sr = e >> 4, cv = (e & 15) * 8;
        f32x4 a, b; unpack8(C.v[k], a, b);
        const float mu = C.s1[k] * (1.f / 512.f), var = fmaxf(C.s2[k] * (1.f / 512.f) - mu * mu, 0.f), rs = rsqrtf(var + EPS);
        const f32x4 ga = *(const f32x4*)(lng + cv), gb = *(const f32x4*)(lng + cv + 4), ba = *(const f32x4*)(lnb + cv), bb = *(const f32x4*)(lnb + cv + 4);
        a = (a - mu) * rs * ga + ba; b = (b - mu) * rs * gb + bb;
        const int ssw = ((((sr >> 3) ^ ((cv >> 3) & 15)) << 3) + (sr & 7));
#pragma unroll
        for (int j = 0; j < 4; ++j) { VNT[(cv + j) * 136 + ssw] = (bf16_t)f2bf(a[j]); VNT[(cv + 4 + j) * 136 + ssw] = (bf16_t)f2bf(b[j]); }
    }
    if (item_next >= 0) sg_load(N, p, item_next, tid);
    lds_barrier();
    f32x4 acc[8];
#pragma unroll
    for (int tc = 0; tc < 8; ++tc) acc[tc] = (f32x4){0.f, 0.f, 0.f, 0.f};
    const int ksn = (tt >> 1) + 1;
    for (int ks = 0; ks < ksn; ++ks) {
        const bf16x8 bf = *(const LAS bf16x8*)(WL + (16 * tt + fr) * 136 + 32 * ks + 8 * fq);
#pragma unroll
        for (int tc = 0; tc < 8; ++tc) { const bf16x8 af = *(const LAS bf16x8*)(VNT + (16 * tc + fr) * 136 + (((4 * ks + fq) ^ (2 * tc + (fr >> 3))) << 3)); acc[tc] = __builtin_amdgcn_mfma_f32_16x16x32_bf16(af, bf, acc[tc], 0, 0, 0); }
    }
    lds_barrier();
    LAS float* ZS = (LAS float*)lds;
#pragma unroll
    for (int tc = 0; tc < 8; ++tc) *(LAS f32x4*)(ZS + t * 132 + 16 * tc + 4 * fq) = acc[tc] + bias;
    lds_barrier();
#pragma unroll
    for (int k = 0; k < 4; ++k) { const int e = tid + 512 * k, tr = e >> 4, cv = (e & 15) * 8;
        const f32x4 z0 = *(const LAS f32x4*)(ZS + tr * 132 + cv), z1 = *(const LAS f32x4*)(ZS + tr * 132 + cv + 4);
        f32x4 u0, u1; unpack8(ur[k], u0, u1);
        *(u32x4*)(U + (size_t)(m0 + tr) * 512 + c0 + cv) = pack8(u0 * z0, u1 * z1); }
    lds_barrier();
}

struct PrepRegs { u32x4 la[2], q[2], k[2]; };
__device__ __forceinline__ void prep_load(PrepRegs& R, const Params& p, int it, int tid) {
    const unsigned char* dob = (const unsigned char*)p.out;
    const bf16_t* Qg = (const bf16_t*)(dob + DO_Q) + (size_t)it * 8192; const bf16_t* Kg = (const bf16_t*)(dob + DO_K) + (size_t)it * 8192; const bf16_t* Lg = (const bf16_t*)(dob + DO_LA) + (size_t)it * 8192;
#pragma unroll
    for (int k = 0; k < 2; ++k) { const int e = tid + 512 * k; R.la[k] = *(const u32x4*)(Lg + (size_t)e * 8); R.q[k] = *(const u32x4*)(Qg + (size_t)e * 8); R.k[k] = *(const u32x4*)(Kg + (size_t)e * 8); }
}
__device__ __forceinline__ void gla_prep_item(const Params& p, LAS unsigned char* lds, int it, PrepRegs& C, int it_next, PrepRegs& N) {
    int tid_ = threadIdx.x; asm volatile("" : "+v"(tid_)); const int tid = tid_, lane = tid & 63, w = tid >> 6, fr = lane & 15, fq = lane >> 4;
    LAS float* BC = (LAS float*)lds;
    LAS bf16_t* QI = (LAS bf16_t*)(lds + 32768);
    LAS bf16_t* KI = (LAS bf16_t*)(lds + 32768 + 17408);
    LAS bf16_t* KDT = (LAS bf16_t*)(lds + 32768 + 2 * 17408);
    unsigned char* dob = (unsigned char*)p.out;
    bf16_t* Qg = (bf16_t*)(dob + DO_Q) + (size_t)it * 8192;
    bf16_t* Kg = (bf16_t*)(dob + DO_K) + (size_t)it * 8192;
    bf16_t* Lg = (bf16_t*)(dob + DO_LA) + (size_t)it * 8192;
#pragma unroll
    for (int k = 0; k < 2; ++k) { const int e = tid + 512 * k, i = e >> 4, dv = (e & 15) * 8; f32x4 a, b; unpack8(C.la[k], a, b);
        *(LAS f32x4*)(BC + i * 128 + dv) = a; *(LAS f32x4*)(BC + i * 128 + dv + 4) = b; }
    if (it_next >= 0) prep_load(N, p, it_next, tid);
    lds_barrier();
    { const int d = tid & 127, seg = tid >> 7; float cv_[16]; float run = 0.f;
      LAS float* TOT = (LAS float*)(lds + 86016);
#pragma unroll
      for (int r = 0; r < 16; ++r) cv_[r] = BC[(16 * seg + r) * 128 + d];
#pragma unroll
      for (int r = 0; r < 16; ++r) { run += cv_[r]; cv_[r] = run; }
      TOT[seg * 128 + d] = run;
      lds_barrier();
      float offs = 0.f;
#pragma unroll
      for (int s = 0; s < 3; ++s) if (s < seg) offs += TOT[s * 128 + d];
#pragma unroll
      for (int r = 0; r < 16; ++r) BC[(16 * seg + r) * 128 + d] = cv_[r] + offs;
    }
    lds_barrier();
#pragma unroll
    for (int k = 0; k < 2; ++k) {
        const int e = tid + 512 * k, i = e >> 4, dv = (e & 15) * 8;
        f32x4 q0, q1, k0, k1; unpack8(C.q[k], q0, q1); unpack8(C.k[k], k0, k1);
        f32x4 qd0, qd1, qi0, qi1, ki0, ki1;
        const f32x4 bi0 = *(const LAS f32x4*)(BC + i * 128 + dv), bi1 = *(const LAS f32x4*)(BC + i * 128 + dv + 4);
        const f32x4 br0 = *(const LAS f32x4*)(BC + 31 * 128 + dv), br1 = *(const LAS f32x4*)(BC + 31 * 128 + dv + 4);
        const f32x4 bl0 = *(const LAS f32x4*)(BC + 63 * 128 + dv), bl1 = *(const LAS f32x4*)(BC + 63 * 128 + dv + 4);
        const int isw = ((((i >> 3) ^ ((dv >> 3) & 7)) << 3) + (i & 7));
#pragma unroll
        for (int j = 0; j < 4; ++j) {
            { const int d = dv + j; const float bi = bi0[j], br = br0[j], bl = bl0[j];
              qd0[j] = q0[j] * __expf(bi); qi0[j] = q0[j] * __expf(bi - br); ki0[j] = k0[j] * __expf(br - bi); KDT[d * 72 + isw] = (bf16_t)f2bf(k0[j] * __expf(bl - bi)); }
            { const int d = dv + 4 + j; const float bi = bi1[j], br = br1[j], bl = bl1[j];
              qd1[j] = q1[j] * __expf(bi); qi1[j] = q1[j] * __expf(bi - br); ki1[j] = k1[j] * __expf(br - bi); KDT[d * 72 + isw] = (bf16_t)f2bf(k1[j] * __expf(bl - bi)); }
        }
        *(u32x4*)(Qg + i * 128 + dv) = pack8(qd0, qd1);
        *(LAS u32x4*)(QI + i * 136 + dv) = pack8(qi0, qi1);
        *(LAS u32x4*)(KI + i * 136 + dv) = pack8(ki0, ki1);
    }
    if (tid < 128) ((float*)Lg)[2048 + tid] = __expf(BC[63 * 128 + tid]);
    lds_barrier();
    { const int ti = w >> 1;
#pragma unroll
      for (int tjj = 0; tjj < 2; ++tjj) {
          const int tj = 2 * (w & 1) + tjj; f32x4 acc = (f32x4){0.f, 0.f, 0.f, 0.f};
#pragma unroll
          for (int ks = 0; ks < 4; ++ks) { const bf16x8 af = *(const LAS bf16x8*)(KI + (16 * tj + fr) * 136 + 32 * ks + 8 * fq), bf = *(const LAS bf16x8*)(QI + (16 * ti + fr) * 136 + 32 * ks + 8 * fq);
              acc = __builtin_amdgcn_mfma_f32_16x16x32_bf16(af, bf, acc, 0, 0, 0); }
          const int i = 16 * ti + fr, j0 = 16 * tj + 4 * fq;
#pragma unroll
          for (int r = 0; r < 4; ++r) if (j0 + r > i) acc[r] = 0.f;
          *(u32x2*)(Lg + i * 64 + j0) = pack4(acc);
      } }
#pragma unroll
    for (int k = 0; k < 2; ++k) { const int e = tid + 512 * k, d = e >> 3, jb = e & 7; *(u32x4*)(Kg + d * 64 + jb * 8) = *(const LAS u32x4*)(KDT + d * 72 + ((jb ^ ((d >> 3) & 7)) << 3)); }
    lds_barrier();
}

struct GlaRegs { u32x4 P, Q0, Q1, K0, K1, V; float D; };
__device__ __forceinline__ void gla_load(GlaRegs& R, const bf16_t* Qb, const bf16_t* Kb, const bf16_t* Lb, const bf16_t* Vb, int b, int h, int vs, int n, int tid) {
    const size_t ib = ((size_t)(b * 32 + n) * 4 + h) * 8192;
    R.P = *(const u32x4*)(Lb + ib + (size_t)tid * 8);
    R.Q0 = *(const u32x4*)(Qb + ib + (size_t)tid * 8); R.Q1 = *(const u32x4*)(Qb + ib + (size_t)(tid + 512) * 8);
    R.K0 = *(const u32x4*)(Kb + ib + (size_t)tid * 8); R.K1 = *(const u32x4*)(Kb + ib + (size_t)(tid + 512) * 8);
    if (tid < 256) R.V = __builtin_nontemporal_load((const u32x4*)(Vb + (size_t)(b * 2048 + n * 64 + (tid >> 2)) * 1024 + h * 256 + vs * 32 + (tid & 3) * 8));
    if (tid < 128) R.D = ((const float*)(Lb + ib))[2048 + tid];
}
__device__ __forceinline__ void gla_fill(LAS unsigned char* B, const GlaRegs& C, int tid) {
    LAS bf16_t* PL = (LAS bf16_t*)B; LAS bf16_t* QD = (LAS bf16_t*)(B + 9216); LAS bf16_t* KD = (LAS bf16_t*)(B + 26624); LAS bf16_t* VT = (LAS bf16_t*)(B + 45056); LAS float* DC = (LAS float*)(B + 58368);
    *(LAS u32x4*)(PL + (tid >> 3) * 72 + (tid & 7) * 8) = C.P;
    *(LAS u32x4*)(QD + (tid >> 4) * 136 + (tid & 15) * 8) = C.Q0; *(LAS u32x4*)(QD + ((tid + 512) >> 4) * 136 + (tid & 15) * 8) = C.Q1;
    *(LAS u32x4*)(KD + (tid >> 3) * 72 + (tid & 7) * 8) = C.K0; *(LAS u32x4*)(KD + ((tid + 512) >> 3) * 72 + (tid & 7) * 8) = C.K1;
    if (tid < 256) { const int jr = tid >> 2, v0 = (tid & 3) * 8, j = (((jr >> 3) ^ (v0 >> 3)) << 3) + (jr & 7); const u32x4 rV = C.V;
        VT[(v0 + 0) * 72 + j] = (bf16_t)(rV.x & 0xffffu); VT[(v0 + 1) * 72 + j] = (bf16_t)(rV.x >> 16);
        VT[(v0 + 2) * 72 + j] = (bf16_t)(rV.y & 0xffffu); VT[(v0 + 3) * 72 + j] = (bf16_t)(rV.y >> 16);
        VT[(v0 + 4) * 72 + j] = (bf16_t)(rV.z & 0xffffu); VT[(v0 + 5) * 72 + j] = (bf16_t)(rV.z >> 16);
        VT[(v0 + 6) * 72 + j] = (bf16_t)(rV.w & 0xffffu); VT[(v0 + 7) * 72 + j] = (bf16_t)(rV.w >> 16); }
    if (tid < 128) DC[tid] = C.D;
}
__device__ __forceinline__ void gla_seq(const Params& p, LAS unsigned char* lds, int bh, int vs) {
    int tid_ = threadIdx.x; asm volatile("" : "+v"(tid_)); const int tid = tid_, lane = tid & 63, w = tid >> 6, fr = lane & 15, fq = lane >> 4;
    constexpr int SETB = 58880;
    const int b = bh >> 2, h = bh & 3;
    unsigned char* dob = (unsigned char*)p.out;
    const bf16_t* Qb = (const bf16_t*)(dob + DO_Q); const bf16_t* Kb = (const bf16_t*)(dob + DO_K); const bf16_t* Lb = (const bf16_t*)(dob + DO_LA);
    bf16_t* Vb = (bf16_t*)(p.ws + WS_V);
    float* gpart = (float*)(p.ws + WS_GPART);
    for (int e = tid; e < 32 * 136 / 2; e += 512) ((LAS unsigned*)(lds + 49664))[e] = 0u;
    f32x4 S[2]; S[0] = (f32x4){0.f, 0.f, 0.f, 0.f}; S[1] = S[0];
    GlaRegs R[2];
    R[0].V = (u32x4){0u, 0u, 0u, 0u}; R[1].V = R[0].V; R[0].D = 0.f; R[1].D = 0.f;
    gla_load(R[0], Qb, Kb, Lb, Vb, b, h, vs, 0, tid);
    gla_load(R[1], Qb, Kb, Lb, Vb, b, h, vs, 1, tid);
    gla_fill(lds, R[0], tid);
    gla_load(R[0], Qb, Kb, Lb, Vb, b, h, vs, 2, tid);
    lds_barrier();
    const int ti = w >> 1, tv = w & 1;
    for (int n2 = 0; n2 < 32; n2 += 2) {
#pragma unroll
        for (int u = 0; u < 2; ++u) {
            const int n = n2 + u;
            LAS unsigned char* Bc = lds + u * SETB; LAS unsigned char* Bn = lds + (u ^ 1) * SETB;
            if (n + 1 < 32) gla_fill(Bn, R[u ^ 1], tid);
            if (n + 3 < 32) gla_load(R[u ^ 1], Qb, Kb, Lb, Vb, b, h, vs, n + 3, tid);
            const LAS bf16_t* PL = (const LAS bf16_t*)Bc; const LAS bf16_t* QD = (const LAS bf16_t*)(Bc + 9216); const LAS bf16_t* KD = (const LAS bf16_t*)(Bc + 26624);
            const LAS bf16_t* VT = (const LAS bf16_t*)(Bc + 45056); const LAS bf16_t* ST = (const LAS bf16_t*)(Bc + 49664); const LAS float* DC = (const LAS float*)(Bc + 58368);
            f32x4 o = (f32x4){0.f, 0.f, 0.f, 0.f};
#pragma unroll
            for (int ks = 0; ks < 2; ++ks) { const bf16x8 af = *(const LAS bf16x8*)(VT + (16 * tv + fr) * 72 + (((4 * ks + fq) ^ (2 * tv + (fr >> 3))) << 3)), bf = *(const LAS bf16x8*)(PL + (16 * ti + fr) * 72 + 32 * ks + 8 * fq);
                o = __builtin_amdgcn_mfma_f32_16x16x32_bf16(af, bf, o, 0, 0, 0); }
#pragma unroll
            for (int ks = 0; ks < 4; ++ks) { const bf16x8 af = *(const LAS bf16x8*)(ST + (16 * tv + fr) * 136 + 32 * ks + 8 * fq), bf = *(const LAS bf16x8*)(QD + (16 * ti + fr) * 136 + 32 * ks + 8 * fq);
                o = __builtin_amdgcn_mfma_f32_16x16x32_bf16(af, bf, o, 0, 0, 0); }
            const f32x4 dec = *(const LAS f32x4*)(DC + 16 * w + 4 * fq);
#pragma unroll
            for (int tvv = 0; tvv < 2; ++tvv) { f32x4 kv = (f32x4){0.f, 0.f, 0.f, 0.f};
#pragma unroll
                for (int ks = 0; ks < 2; ++ks) { const bf16x8 af = *(const LAS bf16x8*)(KD + (16 * w + fr) * 72 + 32 * ks + 8 * fq), bf = *(const LAS bf16x8*)(VT + (16 * tvv + fr) * 72 + (((4 * ks + fq) ^ (2 * tvv + (fr >> 3))) << 3));
                    kv = __builtin_amdgcn_mfma_f32_16x16x32_bf16(af, bf, kv, 0, 0, 0); }
                S[tvv] = dec * S[tvv] + kv; }
            LAS bf16_t* STn = (LAS bf16_t*)(Bn + 49664);
#pragma unroll
            for (int tvv = 0; tvv < 2; ++tvv) *(LAS u32x2*)(STn + (16 * tvv + fr) * 136 + 16 * w + 4 * fq) = pack4(S[tvv]);
            const int m = b * 2048 + n * 64 + 16 * ti + fr;
            *(u32x2*)(Vb + (size_t)m * 1024 + h * 256 + vs * 32 + 16 * tv + 4 * fq) = pack4(o);
            float ss = o[0] * o[0] + o[1] * o[1] + o[2] * o[2] + o[3] * o[3];
            ss += __shfl_xor(ss, 16); ss += __shfl_xor(ss, 32);
            if (fq == 0) gpart[((size_t)bh * 2048 + n * 64 + 16 * ti + fr) * 16 + vs * 2 + tv] = ss;
            lds_barrier();
        }
    }
    __syncthreads();
}

__device__ __forceinline__ void gla_meet_arrive(const Params& p, int bh, bool same_xcd) {
    asm volatile("s_waitcnt vmcnt(0) lgkmcnt(0)" ::: "memory");
    __syncthreads();
    if (threadIdx.x == 0) {
        unsigned* c = (unsigned*)(p.ws + WS_BHC) + bh * 64;
        if (!same_xcd) { __builtin_amdgcn_fence(__ATOMIC_RELEASE, "agent"); asm volatile("s_waitcnt vmcnt(0)" ::: "memory"); }
        __hip_atomic_fetch_add(c, 1u, __ATOMIC_RELAXED, __HIP_MEMORY_SCOPE_AGENT);
    }
}
__device__ __forceinline__ void gla_norm_meet(const Params& p, int bh, int vs) {
    int tid_ = threadIdx.x; asm volatile("" : "+v"(tid_)); const int tid = tid_;
    const int b = bh >> 2, h = bh & 3;
    bf16_t* Vb = (bf16_t*)(p.ws + WS_V);
    const float* gpart = (const float*)(p.ws + WS_GPART);
    {
        if (tid == 0) {
            unsigned* c = (unsigned*)(p.ws + WS_BHC) + bh * 64;
            while (__hip_atomic_load(c, __ATOMIC_RELAXED, __HIP_MEMORY_SCOPE_AGENT) < 8u) __builtin_amdgcn_s_sleep(1);
            __builtin_amdgcn_fence(__ATOMIC_ACQUIRE, "agent");
            asm volatile("s_waitcnt vmcnt(0)" ::: "memory");
        }
        __syncthreads();
        const bf16_t* OGb = (const bf16_t*)(p.ws + WS_OG);
        const int cv = (tid & 31) * 8;
        const f32x4 n0 = *(const f32x4*)(p.in[11] + cv), n1 = *(const f32x4*)(p.in[11] + cv + 4);
#pragma unroll 4
        for (int r = tid >> 5; r < 256; r += 16) {
            const int row = vs * 256 + r, m = b * 2048 + row; const size_t off = (size_t)m * 1024 + h * 256 + cv;
            const f32x4* gp = (const f32x4*)(gpart + ((size_t)bh * 2048 + row) * 16);
            const f32x4 s4 = (gp[0] + gp[1]) + (gp[2] + gp[3]);
            const float rs = rsqrtf(((s4[0] + s4[1]) + (s4[2] + s4[3])) * (1.f / 256.f) + EPS);
            f32x4 o0, o1, g0, g1; unpack8(*(const u32x4*)(Vb + off), o0, o1); unpack8(__builtin_nontemporal_load((const u32x4*)(OGb + off)), g0, g1);
            *(u32x4*)(Vb + off) = pack8(o0 * rs * n0 * g0, o1 * rs * n1 * g1);
        }
    }
}

#define XB_TMO      128
#define XB_XCNT(j)  (256  + 64 * (j))
#define XB_XSUB(j)  (1280 + 64 * (j))
#define XB_XGEN(j)  (2304 + 64 * (j))
#define XB_TOP      3328
#define XB_TOPGEN   3392
#define XCD_BAR_WORDS 3456
#define XB_SPIN_CAP (1u << 18)

__device__ __forceinline__ unsigned xb_ld(unsigned* p)              { return __hip_atomic_load(p, __ATOMIC_RELAXED, __HIP_MEMORY_SCOPE_AGENT); }
__device__ __forceinline__ unsigned xb_add(unsigned* p, unsigned v) { return __hip_atomic_fetch_add(p, v, __ATOMIC_RELAXED, __HIP_MEMORY_SCOPE_AGENT); }
__device__ __forceinline__ unsigned xb_xcc_id() { return (unsigned)__builtin_amdgcn_s_getreg((3 << 11) | 20) & 0xFu; }
#define XB_SPIN(cond, bar) do { unsigned _sp = 0; while (cond) { __builtin_amdgcn_s_sleep(1); \
    if ((++_sp & 255u) == 0u) { if (xb_ld(&(bar)[XB_TMO])) break; if (_sp > XB_SPIN_CAP) { atomicAdd(&(bar)[XB_TMO], 1u); break; } } } } while (0)

struct XcdBarrier {
    unsigned* bar; unsigned x;
    volatile LAS unsigned* st;
};

__device__ __forceinline__ XcdBarrier xcd_barrier_post(unsigned* bar, volatile LAS unsigned* st) {
    XcdBarrier b; b.bar = bar; b.x = xb_xcc_id(); b.st = st;
    if (threadIdx.x == 0) (void)xb_add(&bar[XB_XCNT(b.x)], 1u);
    return b;
}
__device__ __forceinline__ void xcd_barrier_complete(unsigned* bar, unsigned x, unsigned& nloc, unsigned& nx) {
    const unsigned G = gridDim.x * gridDim.y * gridDim.z;
    unsigned sum, cnt, mine, sp = 0u;
    for (;;) {
        sum = 0u; cnt = 0u; mine = 0u;
#pragma unroll
        for (unsigned j = 0; j < 16; ++j) { const unsigned c = xb_ld(&bar[XB_XCNT(j)]); sum += c; cnt += (c > 0u) ? 1u : 0u; mine = (j == x) ? c : mine; }
        if (sum == G) break;
        __builtin_amdgcn_s_sleep(1);
        if ((++sp & 255u) == 0u) { if (xb_ld(&bar[XB_TMO])) break; if (sp > XB_SPIN_CAP) { atomicAdd(&bar[XB_TMO], 1u); break; } }
    }
    nloc = mine > 0u ? mine : 1u; nx = cnt > 0u ? cnt : 1u;
}

__device__ __forceinline__ void xcd_barrier(const XcdBarrier& b) {
    asm volatile("s_waitcnt vmcnt(0)" ::: "memory");
    __syncthreads();
    if (threadIdx.x == 0) {
        unsigned* bar = b.bar;
        __builtin_amdgcn_s_waitcnt(0);
        unsigned nloc = b.st[0], nx = b.st[1];
        if (nloc == 0u) { xcd_barrier_complete(bar, b.x, nloc, nx); b.st[0] = nloc; b.st[1] = nx; }
        const unsigned old = xb_add(&bar[XB_XSUB(b.x)], 1u);
        const unsigned gen = old / nloc;
        if (old + 1u == (gen + 1u) * nloc) {
            __builtin_amdgcn_fence(__ATOMIC_RELEASE, "agent");
            asm volatile("s_waitcnt vmcnt(0)" ::: "memory");
            const unsigned og = xb_add(&bar[XB_TOP], 1u);
            const unsigned tg = og / nx;
            if (og + 1u == (tg + 1u) * nx) xb_add(&bar[XB_TOPGEN], 1u);
            else XB_SPIN(xb_ld(&bar[XB_TOPGEN]) == tg, bar);
            __builtin_amdgcn_fence(__ATOMIC_ACQUIRE, "agent");
            xb_add(&bar[XB_XGEN(b.x)], 1u);
            asm volatile("s_waitcnt vmcnt(0)" ::: "memory");
        } else {
            XB_SPIN(xb_ld(&bar[XB_XGEN(b.x)]) == gen, bar);
            __builtin_amdgcn_fence(__ATOMIC_ACQUIRE, "agent");
            asm volatile("s_waitcnt vmcnt(0)" ::: "memory");
        }
    }
    __syncthreads();
}

__device__ __forceinline__ void grid_bar(unsigned* cnt, unsigned target) {
    asm volatile("s_waitcnt vmcnt(0) lgkmcnt(0)" ::: "memory");
    __syncthreads();
    if (threadIdx.x == 0) {
        __builtin_amdgcn_fence(__ATOMIC_RELEASE, "agent");
        asm volatile("s_waitcnt vmcnt(0)" ::: "memory");
        __hip_atomic_fetch_add(cnt, 1u, __ATOMIC_RELAXED, __HIP_MEMORY_SCOPE_AGENT);
        while (__hip_atomic_load(cnt, __ATOMIC_RELAXED, __HIP_MEMORY_SCOPE_AGENT) < target) __builtin_amdgcn_s_sleep(1);
        __builtin_amdgcn_fence(__ATOMIC_ACQUIRE, "agent");
        asm volatile("s_waitcnt vmcnt(0)" ::: "memory");
    }
    __syncthreads();
}
__device__ __forceinline__ void panel_meet(unsigned* cnt, bool same_xcd) {
    asm volatile("s_waitcnt vmcnt(0) lgkmcnt(0)" ::: "memory");
    __syncthreads();
    if (threadIdx.x == 0) {
        if (!same_xcd) { __builtin_amdgcn_fence(__ATOMIC_RELEASE, "agent"); asm volatile("s_waitcnt vmcnt(0)" ::: "memory"); }
        __hip_atomic_fetch_add(cnt, 1u, __ATOMIC_RELAXED, __HIP_MEMORY_SCOPE_AGENT);
        while (__hip_atomic_load(cnt, __ATOMIC_RELAXED, __HIP_MEMORY_SCOPE_AGENT) < 4u) __builtin_amdgcn_s_sleep(1);
        __builtin_amdgcn_fence(__ATOMIC_ACQUIRE, "agent");
        asm volatile("s_waitcnt vmcnt(0)" ::: "memory");
    }
    __syncthreads();
}
__global__ void __launch_bounds__(512, 2) mk_fwd(Params p) {
    extern __shared__ __attribute__((aligned(16))) unsigned char lds_raw[];
    LAS unsigned char* lds = (LAS unsigned char*)lds_raw;
    cg::grid_group grid = cg::this_grid();
    unsigned char* ws = p.ws; unsigned char* dob = (unsigned char*)p.out;
    const int G = gridDim.x;
    if (threadIdx.x < 2) ((volatile LAS unsigned*)(lds + 131072 + 512))[threadIdx.x] = 0u;
    __syncthreads();
#ifndef MK_PHASE_MASK
#define MK_PHASE_MASK 0x7ff
#endif
#define IN(k) ((((MK_PHASE_MASK) >> (k)) & 1) != 0)
#define GBAR() xcd_barrier(xbar)
#ifndef MK_DELAY_MASK
#define MK_DELAY_MASK 0
#endif
    unsigned long long t_ph = 0;
#define TBEG() do { if (MK_DELAY_MASK) t_ph = __builtin_amdgcn_s_memrealtime(); } while (0)
#define TEND(k) do { if ((MK_DELAY_MASK >> (k)) & 1) { const unsigned long long t1_ = __builtin_amdgcn_s_memrealtime(), dt_ = t1_ - t_ph; while (__builtin_amdgcn_s_memrealtime() - t1_ < dt_) __builtin_amdgcn_s_sleep(8); __syncthreads(); } } while (0)
    const unsigned long long t_k0 = MK_DELAY_MASK ? __builtin_amdgcn_s_memrealtime() : 0ull;
    for (int i = blockIdx.x * 512 + threadIdx.x; i < 4096; i += G * 512) ((unsigned*)(ws + WS_XBAR))[i] = 0u;
    grid.sync();
    XcdBarrier xbar = xcd_barrier_post((unsigned*)(ws + WS_XBAR), (volatile LAS unsigned*)(lds + 131072 + 512));
    const bool chain = (G == 256);
    int my_pm = 0; { pg8::StaticOrder S0; S0.init(M, 1024, G, (int)blockIdx.x); pg8::Unit u0; if (S0.next(0, u0)) my_pm = u0.pm; }
    unsigned* pmask = (unsigned*)(ws + WS_XBAR) + 3584 + my_pm;
    if (chain && threadIdx.x == 0) __hip_atomic_fetch_or(pmask, 1u << xb_xcc_id(), __ATOMIC_RELAXED, __HIP_MEMORY_SCOPE_AGENT);
    const int my_it = blockIdx.x, my_b = my_it & 7, my_bh = 4 * my_b + ((my_it >> 3) & 3), my_vs = (my_it >> 5) & 7;
    unsigned* bmask0 = (unsigned*)(ws + WS_XBAR) + 3584 + 128;
    if (chain && threadIdx.x == 0) __hip_atomic_fetch_or(bmask0 + my_b, 1u << xb_xcc_id(), __ATOMIC_RELAXED, __HIP_MEMORY_SCOPE_AGENT);
    unsigned* bhmask = (unsigned*)(ws + WS_XBAR) + 3584 + 64 + (my_bh & 31);
    if (G >= 256 && my_it < 256 && threadIdx.x == 0) __hip_atomic_fetch_or(bhmask, 1u << xb_xcc_id(), __ATOMIC_RELAXED, __HIP_MEMORY_SCOPE_AGENT);
    TBEG();
    if (IN(0)) phase_prologue(p, lds);
    GBAR();
    TEND(0);
    TBEG();
    if (IN(1)) {
        EpiIn E{(bf16_t*)(ws + WS_U), (bf16_t*)(ws + WS_VSG), (bf16_t*)(dob + DO_Q), (bf16_t*)(dob + DO_K), (bf16_t*)(ws + WS_V), (bf16_t*)(dob + DO_LA),
                (bf16_t*)(ws + WS_OG), (bf16_t*)(ws + WS_BGA), (bf16_t*)(ws + WS_BGB), (float*)(ws + WS_VSTAT), p.in[10]};
        run_gemm(lds, (const bf16_t*)(ws + WS_H), (const bf16_t*)(ws + WS_WIN), NIN, 1024, E);
        { const int nwg = (M / 256) * (NIN / 256), rem = nwg % G, c = blockIdx.x; const bool light = rem == 0 || c >= rem; const int nlight = rem == 0 ? G : G - rem, li = rem == 0 ? c : c - rem;
          if (light) { int tid_ = threadIdx.x; asm volatile("" : "+v"(tid_)); const int wv = tid_ >> 6;
              tr_run(p, (LAS float*)(lds + wv * 16384), tid_ & 63, TR_EARLY, TR_ALL - TR_EARLY, li * 8 + wv, nlight * 8); } }
    }
    GBAR();
    TEND(1);
    TBEG();
    const bool fuse_norm = (G >= 256);
    bool fuse35 = chain && fuse_norm;
    if (fuse35) { unsigned ok = 1u;
#pragma unroll
        for (int j = 0; j < 8; ++j) ok &= (__builtin_popcount(__hip_atomic_load(bmask0 + j, __ATOMIC_RELAXED, __HIP_MEMORY_SCOPE_AGENT)) == 1) ? 1u : 0u;
        fuse35 = ok != 0u; }
    if (IN(2)) {
        int tid = threadIdx.x; asm volatile("" : "+v"(tid));
        if (fuse35) {
            const int q = blockIdx.x >> 6;
            { PrepRegs A, B; const int it0 = (4 * my_pm + q) * 4; prep_load(A, p, it0, tid);
#pragma unroll 1
              for (int h = 0; h < 4; ++h) { gla_prep_item(p, lds, it0 + h, A, h < 3 ? it0 + h + 1 : -1, B); A = B; } }
            { SgRegs A, B; const int it0 = (2 * my_pm + (q >> 1)) * 4 + 2 * (q & 1); sg_load(A, p, it0, tid);
              sg_item(p, lds, it0, A, it0 + 1, B); A = B; sg_item(p, lds, it0 + 1, A, -1, B); }
        } else {
        { PrepRegs A, B; if ((int)blockIdx.x < 1024) prep_load(A, p, blockIdx.x, tid);
          for (int it = blockIdx.x; it < 1024; it += G) { const int itn = it + G < 1024 ? it + G : -1; gla_prep_item(p, lds, it, A, itn, B); A = B; } }
        { SgRegs A, B; if ((int)blockIdx.x < 512) sg_load(A, p, blockIdx.x, tid);
          for (int it = blockIdx.x; it < 512; it += G) { const int itn = it + G < 512 ? it + G : -1; sg_item(p, lds, it, A, itn, B); A = B; } }
        }
    }
    if (fuse35) {
        asm volatile("s_waitcnt vmcnt(0) lgkmcnt(0)" ::: "memory");
        __syncthreads();
        if (threadIdx.x == 0) { unsigned* cb = (unsigned*)(ws + WS_P35) + (64 + my_b) * 16;
            __hip_atomic_fetch_add(cb, 1u, __ATOMIC_RELAXED, __HIP_MEMORY_SCOPE_AGENT);
            while (__hip_atomic_load(cb, __ATOMIC_RELAXED, __HIP_MEMORY_SCOPE_AGENT) < 32u) __builtin_amdgcn_s_sleep(1);
            __builtin_amdgcn_fence(__ATOMIC_ACQUIRE, "agent"); asm volatile("s_waitcnt vmcnt(0)" ::: "memory"); }
        __syncthreads();
    } else GBAR();
    TEND(2);
    TBEG();
    if (IN(3)) {
        for (int it = blockIdx.x; it < 256; it += G) gla_seq(p, lds, 4 * (it & 7) + ((it >> 3) & 3), (it >> 5) & 7);
        TEND(11); TBEG();
        if (fuse_norm && my_it < 256) { const bool bh_same = __builtin_popcount(__hip_atomic_load(bhmask, __ATOMIC_RELAXED, __HIP_MEMORY_SCOPE_AGENT)) == 1; gla_meet_arrive(p, my_bh, bh_same); }
        EpiMerge<false> E{(bf16_t*)(ws + WS_H), (const bf16_t*)(ws + WS_BGA)};
        run_gemm(lds, (const bf16_t*)(ws + WS_U), (const bf16_t*)(ws + WS_WA), 1024, 512, E);
        TEND(13); TBEG();
        if (fuse_norm && my_it < 256) gla_norm_meet(p, my_bh, my_vs);
        TEND(12); TBEG();
    }
    if (fuse35) {
        asm volatile("s_waitcnt vmcnt(0) lgkmcnt(0)" ::: "memory");
        __syncthreads();
        if (threadIdx.x == 0) __hip_atomic_fetch_add((unsigned*)(ws + WS_P35) + (8 * my_b + my_vs) * 16, 1u, __ATOMIC_RELAXED, __HIP_MEMORY_SCOPE_AGENT);
    } else GBAR();
    TEND(3);
    if (!fuse_norm) {
        int tid = threadIdx.x; asm volatile("" : "+v"(tid));
        for (int e = blockIdx.x * 512 + tid; e < M * 128; e += G * 512) {
            const int m = e >> 7, c = (e & 127) * 8, h = c >> 8;
            const f32x4* gp = (const f32x4*)((const float*)(ws + WS_GPART) + ((size_t)((m >> 11) * 4 + h) * 2048 + (m & 2047)) * 16);
            const f32x4 s4 = (gp[0] + gp[1]) + (gp[2] + gp[3]);
            const float rs = rsqrtf(((s4[0] + s4[1]) + (s4[2] + s4[3])) * (1.f / 256.f) + EPS);
            f32x4 o0, o1, g0, g1; unpack8(*(const u32x4*)((bf16_t*)(ws + WS_V) + (size_t)e * 8), o0, o1); unpack8(*(const u32x4*)((const bf16_t*)(ws + WS_OG) + (size_t)e * 8), g0, g1);
            const f32x4 n0 = *(const f32x4*)(p.in[11] + (c & 255)), n1 = *(const f32x4*)(p.in[11] + (c & 255) + 4);
            *(u32x4*)((bf16_t*)(ws + WS_V) + (size_t)e * 8) = pack8(o0 * rs * n0 * g0, o1 * rs * n1 * g1);
        }
        GBAR();
    }
    TBEG();
    const bool same_xcd = chain && __builtin_popcount(__hip_atomic_load(pmask, __ATOMIC_RELAXED, __HIP_MEMORY_SCOPE_AGENT)) == 1;
#define PSEAM(k) do { if (chain) panel_meet((unsigned*)(ws + WS_PCNT) + ((k) * 64 + my_pm) * 32, same_xcd); else GBAR(); } while (0)
    if (fuse35) {
        if (threadIdx.x == 0) { unsigned* c35 = (unsigned*)(ws + WS_P35) + my_pm * 16;
            while (__hip_atomic_load(c35, __ATOMIC_RELAXED, __HIP_MEMORY_SCOPE_AGENT) < 4u) __builtin_amdgcn_s_sleep(1);
            __builtin_amdgcn_fence(__ATOMIC_ACQUIRE, "agent"); asm volatile("s_waitcnt vmcnt(0)" ::: "memory"); }
        __syncthreads();
    }
    if (IN(5)) {
        EpiMerge<true> E{(bf16_t*)(ws + WS_H), (const bf16_t*)(ws + WS_BGB)};
        run_gemm(lds, (const bf16_t*)(ws + WS_V), (const bf16_t*)(ws + WS_WB), 1024, 1024, E);
    }
    PSEAM(3);
    if (chain && threadIdx.x == 0) __hip_atomic_fetch_add((unsigned*)(ws + WS_BAR), 1u, __ATOMIC_RELAXED, __HIP_MEMORY_SCOPE_AGENT);
    TEND(5);
    TBEG();
    if (IN(6)) {
        EpiRes<false> E{p.in[0], (bf16_t*)(ws + WS_XB), (float*)(ws + WS_RSS2)};
        run_gemm(lds, (const bf16_t*)(ws + WS_H), (const bf16_t*)(ws + WS_WO), 1024, 1024, E);
    }
    PSEAM(0);
    TEND(6);
    TBEG();
    if (chain) { if (threadIdx.x == 0) { while (__hip_atomic_load((unsigned*)(ws + WS_BAR), __ATOMIC_RELAXED, __HIP_MEMORY_SCOPE_AGENT) < (unsigned)G) __builtin_amdgcn_s_sleep(1); } __syncthreads(); }
    if (IN(7)) {
        EpiUp E{(bf16_t*)(ws + WS_UP), (const float*)(ws + WS_RSS2)};
        run_gemm(lds, (const bf16_t*)(ws + WS_XB), (const bf16_t*)(ws + WS_WUP), FF, 1024, E);
    }
    PSEAM(1);
    TEND(7);
    TBEG();
    if (IN(8)) {
        EpiRes<true> E{nullptr, (bf16_t*)(ws + WS_XB), (float*)(ws + WS_RSS3)};
        run_gemm(lds, (const bf16_t*)(ws + WS_UP), (const bf16_t*)(ws + WS_WDN), 1024, FF, E);
        EpiPlain E2{(bf16_t*)(ws + WS_H)};
        run_gemm(lds, (const bf16_t*)(ws + WS_PB), (const bf16_t*)(ws + WS_WPP), 1024, PLE, E2);
    }
    PSEAM(2);
    TEND(8);
    TBEG();
    const bool fuse_final = (G == 256);
    TBEG();
    if (IN(9)) {
        if (fuse_final) {
            EpiPleFinal E{p.out, (const bf16_t*)(ws + WS_XB), (const bf16_t*)(ws + WS_H), (const float*)(ws + WS_RSS3), (float*)(ws + WS_RSS4), (unsigned*)(ws + WS_PCNT) + 4 * 64 * 32, p.in[20], same_xcd};
            run_gemm<EpiPleFinal, false>(lds, (const bf16_t*)(ws + WS_XB), (const bf16_t*)(ws + WS_WPG), 1024, 1024, E);
        } else {
            EpiPleGate E{p.out, (const bf16_t*)(ws + WS_XB), (const bf16_t*)(ws + WS_H), (const float*)(ws + WS_RSS3), (float*)(ws + WS_RSS4)};
            run_gemm(lds, (const bf16_t*)(ws + WS_XB), (const bf16_t*)(ws + WS_WPG), 1024, 1024, E);
        }
    }
    if (!fuse_final) {
        GBAR();
        const float* rss4 = (const float*)(ws + WS_RSS4);
        int tid = threadIdx.x; asm volatile("" : "+v"(tid));
        for (int e = blockIdx.x * 512 + tid; e < M * 256; e += G * 512) {
            const int m = e >> 8, c = (e & 255) * 4;
            const float rs = rsqrtf(rss4[m] * (1.f / 1024.f) + EPS);
            const f32x4 v = *(const f32x4*)(p.out + (size_t)e * 4), g = *(const f32x4*)(p.in[20] + c);
            *(f32x4*)(p.out + (size_t)e * 4) = v * rs * g;
        }
    }
    if ((MK_DELAY_MASK >> 10) & 1) { asm volatile("s_waitcnt vmcnt(0)" ::: "memory"); __syncthreads(); }
    TEND(9);
    if ((MK_DELAY_MASK >> 14) & 1) { asm volatile("s_waitcnt vmcnt(0)" ::: "memory"); __syncthreads(); t_ph = t_k0; }
    TEND(14);
#undef IN
#undef GBAR
#undef PSEAM
}
}

extern "C" void kernel_launch(void* const* d_in, const int* in_sizes, int n_in, void* d_out, int out_size, void* d_ws, size_t ws_size, hipStream_t stream) {
    static int grid = 0;
    if (grid == 0) {
        if (n_in != 21 || out_size != mk::M * mk::D || ws_size < mk::WS_END) { fprintf(stderr, "kernel_launch: unexpected shapes (n_in %d out %d ws %zu)\n", n_in, out_size, ws_size); grid = -1; return; }
        int dev = 0, cus = 0, per_cu = 0;
        if (hipGetDevice(&dev) != hipSuccess || hipDeviceGetAttribute(&cus, hipDeviceAttributeMultiprocessorCount, dev) != hipSuccess) { grid = -1; return; }
        if (hipFuncSetAttribute((const void*)mk::mk_fwd, hipFuncAttributeMaxDynamicSharedMemorySize, mk::LDS_BYTES) != hipSuccess) { fprintf(stderr, "kernel_launch: hipFuncSetAttribute failed\n"); grid = -1; return; }
        if (hipOccupancyMaxActiveBlocksPerMultiprocessor(&per_cu, (const void*)mk::mk_fwd, 512, mk::LDS_BYTES) != hipSuccess || per_cu < 1) { fprintf(stderr, "kernel_launch: occupancy query says %d\n", per_cu); per_cu = 1; }
        (void)hipGetLastError();
        grid = cus * per_cu;
    }
    if (grid < 0) return;
    mk::Params p{};
    for (int i = 0; i < 21; ++i) p.in[i] = (const float*)d_in[i];
    p.out = (float*)d_out; p.ws = (unsigned char*)d_ws;
    void* args[] = {&p};
    hipError_t e = hipLaunchCooperativeKernel((const void*)mk::mk_fwd, dim3(grid), dim3(512), args, mk::LDS_BYTES, stream);
    if (e != hipSuccess) fprintf(stderr, "kernel_launch: cooperative launch failed: %s (grid %d)\n", hipGetErrorString(e), grid);

}
```
